# Optimizing an MI355X kernel written in HIP

```python
import math
import jax
import jax.numpy as jnp
from jax import lax
import numpy as np

D_MODEL = 1024
BATCH = 16
SEQ = 2048
DEPTH = 2

GRID_W = 64
CTX_LEN = 256

DA_HEADS = 4
DA_QK_DIM = 64
DA_V_DIM = 2 * DA_QK_DIM
DA_WIDTH = DA_HEADS * DA_V_DIM
DA_QK_COLS = DA_HEADS * 2 * DA_QK_DIM
Q_BLOCK = 128
ROPE_BASE = 10000.0
DA_EPS = 1e-5

RW_HEAD = 64
RW_HEADS = 8
RW_WIDTH = RW_HEADS * RW_HEAD
RW_DECAY_LORA = 64
RW_AAA_LORA = 64
RW_GATE_LORA = 128
RW_COLS = 3 * RW_WIDTH + RW_DECAY_LORA + RW_AAA_LORA + RW_GATE_LORA
RW_SPLITS = (RW_WIDTH, 2 * RW_WIDTH, 3 * RW_WIDTH, 3 * RW_WIDTH + RW_DECAY_LORA,
             3 * RW_WIDTH + RW_DECAY_LORA + RW_AAA_LORA)
RW_GN_EPS = 64e-5

SG_CHUNK = 128
SG_GROUPS = 4
SG_WIDTH = 512
SG_GROUP_DIM = SG_WIDTH // SG_GROUPS

N_BRANCH = 3
MIX_WIDTH = DA_WIDTH + RW_WIDTH + SG_WIDTH
DA_Q0 = 0
DA_K0 = DA_Q0 + DA_QK_COLS
DA_V0 = DA_K0 + DA_QK_COLS
RW_0 = DA_V0 + DA_WIDTH
SG_0 = RW_0 + RW_COLS
GATE_0 = SG_0 + 2 * SG_WIDTH
IN_COLS = GATE_0 + N_BRANCH * D_MODEL

N_EXPERTS = 16
EXPERT_FF = 2048
EC_CAPACITY = 2

LN_EPS = 1e-5
DN_ALPHA = (2 * DEPTH) ** 0.25
DN_BETA = (8 * DEPTH) ** -0.25

kernel_name = 'hybrid_diffattn_rwkv7_chunkgmlp_ecmoe_trunk'


def layer_norm(z, g, b, eps=LN_EPS):
    zf = z.astype(jnp.float32)
    mu = jnp.mean(zf, -1, keepdims=True)
    var = jnp.mean(jnp.square(zf - mu), -1, keepdims=True)
    return ((zf - mu) * lax.rsqrt(var + eps) * g + b).astype(z.dtype)


def rms_norm(z, g, eps):
    zf = z.astype(jnp.float32)
    return (zf * lax.rsqrt(jnp.mean(jnp.square(zf), -1, keepdims=True) + eps) * g).astype(z.dtype)


def axial_rope_tables(n_tokens):
    rows = n_tokens // GRID_W
    row = jnp.repeat(jnp.arange(rows, dtype=jnp.float32), GRID_W)
    col = jnp.tile(jnp.arange(GRID_W, dtype=jnp.float32), rows)
    half = DA_QK_DIM // 2
    inv_freq = ROPE_BASE ** (-jnp.arange(0, half, 2, dtype=jnp.float32) / half)
    ar = row[:, None] * inv_freq
    ac = col[:, None] * inv_freq
    ang = jnp.concatenate([ar, ar, ac, ac], axis=-1)
    return jnp.cos(ang), jnp.sin(ang)


def rotate_half(z):
    z1, z2 = jnp.split(z, 2, axis=-1)
    return jnp.concatenate([-z2, z1], axis=-1)


def apply_axial_rope(z, cos, sin):
    zr, zc = jnp.split(z, 2, axis=-1)
    rot = jnp.concatenate([rotate_half(zr), rotate_half(zc)], axis=-1)
    cb = cos[None, :, None, None, :]
    sb = sin[None, :, None, None, :]
    return (z * cb + rot * sb).astype(z.dtype)


def diff_lambda(lam, lam_init):
    lf = lam.astype(jnp.float32)
    return jnp.exp(jnp.sum(lf[0] * lf[1])) - jnp.exp(jnp.sum(lf[2] * lf[3])) + lam_init


def diff_attn_probs(q, k, lam):
    s = jnp.einsum('bqhmd,bkhmd->bhmqk', q, k).astype(jnp.float32)
    p = jax.nn.softmax(s, axis=-1)
    return p[:, :, 0] - lam * p[:, :, 1]


def diff_attn_finish(o, norm_g, lam_init):
    B, T = o.shape[:2]
    return (rms_norm(o, norm_g, DA_EPS) * (1.0 - lam_init)).reshape(B, T, DA_WIDTH)


def diff_attention_latent(q, k, v, kc, vc, lam, norm_g, lam_init):
    B, T = q.shape[:2]
    k_all = jnp.concatenate([kc, k], axis=1)
    v_all = jnp.concatenate([vc, v], axis=1)
    nb = T // Q_BLOCK
    qb = q.reshape(B, nb, Q_BLOCK, DA_HEADS, 2, DA_QK_DIM).transpose(1, 0, 2, 3, 4, 5)

    def block(q_blk):
        a = diff_attn_probs(q_blk, k_all, lam)
        return jnp.einsum('bhqk,bkhe->bqhe', a.astype(v_all.dtype), v_all)

    o = lax.map(block, qb)
    o = o.transpose(1, 0, 2, 3, 4).reshape(B, T, DA_HEADS, DA_V_DIM)
    return diff_attn_finish(o, norm_g, lam_init)


def diff_attention_context(qc, kc, vc, lam, norm_g, lam_init):
    a = diff_attn_probs(qc, kc, lam)
    o = jnp.einsum('bhqk,bkhe->bqhe', a.astype(vc.dtype), vc)
    return diff_attn_finish(o, norm_g, lam_init)


def centred_token_shift(p, mu):
    prev = jnp.pad(p[:, :-1], ((0, 0), (1, 0), (0, 0)))
    nxt = jnp.pad(p[:, 1:], ((0, 0), (0, 1), (0, 0)))
    return p + mu[0] * (prev - p) + mu[1] * (nxt - p)


def heads_l2_normalize(z):
    B, T, C = z.shape
    zh = z.reshape(B, T, RW_HEADS, RW_HEAD).astype(jnp.float32)
    n = jnp.sqrt(jnp.sum(jnp.square(zh), -1, keepdims=True))
    return (zh / jnp.maximum(n, 1e-12)).reshape(B, T, C)


def rwkv7_features(p, mu, w0, w2, a0, a2, k_k, k_a):
    p = centred_token_shift(p, mu)
    r, k, v, xw, xa, xg = jnp.split(p, RW_SPLITS, axis=-1)
    w_pre = w0[:, None, None, :] + jnp.einsum('btr,zrc->zbtc', jnp.tanh(xw), w2)
    w_log = -jax.nn.softplus(-w_pre.astype(jnp.float32)) - 0.5
    decay = jnp.exp(-jnp.exp(w_log))
    a = jax.nn.sigmoid((a0[:, None, None, :] + jnp.einsum('btr,zrc->zbtc', xa, a2)).astype(jnp.float32))
    kk = heads_l2_normalize(k * k_k)
    k_dir = k[None].astype(jnp.float32) * (1.0 + (a - 1.0) * k_a)
    return r, k_dir, v, xg, decay, a, kk


def to_heads_tm(z):
    B, T, _ = z.shape
    return z.reshape(B, T, RW_HEADS, RW_HEAD).transpose(1, 0, 2, 3).astype(jnp.float32)


def from_heads_tm(z):
    T, B = z.shape[:2]
    return z.transpose(1, 0, 2, 3).reshape(B, T, RW_WIDTH)


def wkv7_scan(s0, xs):
    def step(S, inp):
        w_t, k_t, v_t, kk_t, a_t = inp[:5]
        sa = jnp.einsum('bhij,bhj->bhi', S, -kk_t)
        S = (S * w_t[:, :, None, :] + sa[..., None] * (kk_t * a_t)[:, :, None, :]
             + v_t[..., None] * k_t[:, :, None, :])
        y = jnp.einsum('bhij,bhj->bhi', S, inp[5]) if len(inp) == 6 else None
        return S, y
    return lax.scan(step, s0, xs)


def rwkv7_direction(s0, feats, z, reverse, emit):
    r, k_dir, v, xg, decay, a, kk = feats
    xs = [decay[z], k_dir[z], v, kk, a[z]] + ([r] if emit else [])
    xs = [to_heads_tm(t) for t in xs]
    if reverse:
        xs = [jnp.flip(t, axis=0) for t in xs]
    s, ys = wkv7_scan(s0, tuple(xs))
    if not emit:
        return s, None
    if reverse:
        ys = jnp.flip(ys, axis=0)
    return s, from_heads_tm(ys)


def rwkv7_output(y, feats, ln_g, ln_b, r_k, g2, dtype):
    r, k_dir, v, xg, decay, a, kk = feats
    B, T, C = y.shape
    yh = y.reshape(B, T, RW_HEADS, RW_HEAD)
    mu = jnp.mean(yh, -1, keepdims=True)
    var = jnp.mean(jnp.square(yh - mu), -1, keepdims=True)
    gn = ((yh - mu) * lax.rsqrt(var + RW_GN_EPS)).reshape(B, T, C) * ln_g + ln_b
    k_b = 0.5 * (k_dir[0] + k_dir[1])
    bonus = (jnp.sum((r * k_b).reshape(B, T, RW_HEADS, RW_HEAD) * r_k, -1, keepdims=True)
             * v.reshape(B, T, RW_HEADS, RW_HEAD))
    g = jax.nn.sigmoid(xg) @ g2
    return ((gn + bonus.reshape(B, T, C)) * g).astype(dtype)


def rwkv7_mixer(p_lat, p_ctx, mu, w0, w2, a0, a2, k_k, k_a, r_k, ln_g, ln_b, g2, emit_ctx):
    B = p_lat.shape[0]
    f_lat = rwkv7_features(p_lat, mu, w0, w2, a0, a2, k_k, k_a)
    f_ctx = rwkv7_features(p_ctx, mu, w0, w2, a0, a2, k_k, k_a)
    s_zero = jnp.zeros((B, RW_HEADS, RW_HEAD, RW_HEAD), jnp.float32)
    y_lat, y_ctx = [], []
    for z, reverse in ((0, False), (1, True)):
        s_ctx, yc = rwkv7_direction(s_zero, f_ctx, z, reverse, emit_ctx)
        _, yl = rwkv7_direction(s_ctx, f_lat, z, reverse, True)
        y_lat.append(yl)
        y_ctx.append(yc)
    out_lat = rwkv7_output(y_lat[0] + y_lat[1], f_lat, ln_g, ln_b, r_k, g2, p_lat.dtype)
    out_ctx = rwkv7_output(y_ctx[0] + y_ctx[1], f_ctx, ln_g, ln_b, r_k, g2, p_ctx.dtype) if emit_ctx else None
    return out_lat, out_ctx


def spatial_gating(p, norm_g, norm_b, w_s, b_s):
    B, T, _ = p.shape
    u, v = jnp.split(jax.nn.gelu(p), 2, axis=-1)
    v = layer_norm(v, norm_g, norm_b)
    vc = v.reshape(B, T // SG_CHUNK, SG_CHUNK, SG_GROUPS, SG_GROUP_DIM)
    vm = jnp.einsum('gpq,bnqgc->bnpgc', w_s, vc) + b_s.T[None, None, :, :, None]
    return u * vm.reshape(B, T, SG_WIDTH)


def gated_merge(y_da, y_rw, y_sg, gate_logits, w_branch, w_out):
    g_da, g_rw, g_sg = jnp.split(jax.nn.sigmoid(gate_logits), N_BRANCH, axis=-1)
    wb_da, wb_rw, wb_sg = jnp.split(w_branch, (DA_WIDTH, DA_WIDTH + RW_WIDTH), axis=0)
    m = g_da * (y_da @ wb_da) + g_rw * (y_rw @ wb_rw) + g_sg * (y_sg @ wb_sg)
    return m @ w_out


def expert_choice_ffn(h, w_router, w_gate, w_up, w_down):
    B, T, D = h.shape
    cap = EC_CAPACITY * T // N_EXPERTS
    aff = jax.nn.softmax(jnp.einsum('btd,de->bte', h, w_router).astype(jnp.float32), axis=-1)
    gate, idx = lax.top_k(jnp.swapaxes(aff, 1, 2), cap)
    xe = jax.vmap(lambda hb, ib: hb[ib])(h, idx)
    hid = jax.nn.silu(jnp.einsum('becd,edf->becf', xe, w_gate)) * jnp.einsum('becd,edf->becf', xe, w_up)
    ye = jnp.einsum('becf,efd->becd', hid, w_down) * gate[..., None].astype(h.dtype)

    def scatter(ib, yb):
        return jnp.zeros((T, D), yb.dtype).at[ib.reshape(-1)].add(yb.reshape(-1, D))

    return jax.vmap(scatter)(idx, ye)


def setup_inputs(seed: int = 0) -> dict:
    key = jax.random.key(seed)
    ks = iter(jax.random.split(key, 40))
    L, D = DEPTH, D_MODEL

    def nrm(shape, scale):
        return jax.random.normal(next(ks), shape, jnp.float32) * scale

    def uni(shape, lo, hi):
        return jax.random.uniform(next(ks), shape, jnp.float32, lo, hi)

    return {
        'x': nrm((BATCH, SEQ, D), 1.0),
        'c': nrm((BATCH, D), 1.0),
        'ctx': nrm((BATCH, CTX_LEN, D), 1.0),
        'c_ctx': nrm((D,), 1.0),
        'w_mod': nrm((L, D, 6 * D), 0.5 * D ** -0.5),
        'b_mod': nrm((L, 6 * D), 0.02),
        'w_in': nrm((L, D, IN_COLS), D ** -0.5),
        'da_lambda': nrm((L, 4, DA_QK_DIM), 0.1),
        'da_norm_g': 1.0 + nrm((L, DA_V_DIM), 0.05),
        'rw_shift_mu': uni((L, 2, RW_COLS), 0.0, 0.5),
        'rw_w0': uni((L, 2, RW_WIDTH), -6.5, -1.5),
        'rw_w2': nrm((L, 2, RW_DECAY_LORA, RW_WIDTH), 0.1 * RW_DECAY_LORA ** -0.5),
        'rw_a0': nrm((L, 2, RW_WIDTH), 0.1),
        'rw_a2': nrm((L, 2, RW_AAA_LORA, RW_WIDTH), 0.5 * RW_AAA_LORA ** -0.5),
        'rw_k_k': 0.85 + nrm((L, RW_WIDTH), 0.02),
        'rw_k_a': 1.0 + nrm((L, RW_WIDTH), 0.02),
        'rw_r_k': nrm((L, RW_HEADS, RW_HEAD), 0.1),
        'rw_ln_g': 1.0 + nrm((L, RW_WIDTH), 0.05),
        'rw_ln_b': nrm((L, RW_WIDTH), 0.02),
        'rw_g2': nrm((L, RW_GATE_LORA, RW_WIDTH), RW_GATE_LORA ** -0.5),
        'sg_norm_g': 1.0 + nrm((L, SG_WIDTH), 0.05),
        'sg_norm_b': nrm((L, SG_WIDTH), 0.02),
        'sg_w': nrm((L, SG_GROUPS, SG_CHUNK, SG_CHUNK), 0.5 * SG_CHUNK ** -0.5),
        'sg_b': 1.0 + nrm((L, SG_GROUPS, SG_CHUNK), 0.1),
        'w_branch': nrm((L, MIX_WIDTH, D), DA_WIDTH ** -0.5),
        'w_out': nrm((L, D, D), DN_BETA * D ** -0.5),
        'ln1_g': 1.0 + nrm((L, D), 0.05),
        'ln1_b': nrm((L, D), 0.02),
        'w_router': nrm((L, D, N_EXPERTS), D ** -0.5),
        'w_e_gate': nrm((L, N_EXPERTS, D, EXPERT_FF), D ** -0.5),
        'w_e_up': nrm((L, N_EXPERTS, D, EXPERT_FF), D ** -0.5),
        'w_e_down': nrm((L, N_EXPERTS, EXPERT_FF, D), DN_BETA * EXPERT_FF ** -0.5),
        'ln2_g': 1.0 + nrm((L, D), 0.05),
        'ln2_b': nrm((L, D), 0.02),
    }


def reference(x, c, ctx, c_ctx, w_mod, b_mod, w_in, da_lambda, da_norm_g,
              rw_shift_mu, rw_w0, rw_w2, rw_a0, rw_a2, rw_k_k, rw_k_a, rw_r_k,
              rw_ln_g, rw_ln_b, rw_g2, sg_norm_g, sg_norm_b, sg_w, sg_b,
              w_branch, w_out, ln1_g, ln1_b, w_router, w_e_gate, w_e_up, w_e_down,
              ln2_g, ln2_b):
    B, T, _ = x.shape
    cos, sin = axial_rope_tables(T)
    xc = ctx
    for l in range(DEPTH):
        last = l == DEPTH - 1
        Tc = xc.shape[1]
        lam_init = 0.8 - 0.6 * math.exp(-0.3 * l)
        lam = diff_lambda(da_lambda[l], lam_init)
        w_in_l = w_in[l]

        mod = (jax.nn.silu(c) @ w_mod[l] + b_mod[l])[:, None, :]
        sh1, sc1, g1, sh2, sc2, g2 = jnp.split(mod, 6, axis=-1)
        modc = jax.nn.silu(c_ctx) @ w_mod[l] + b_mod[l]
        sh1c, sc1c, g1c, sh2c, sc2c, g2c = jnp.split(modc, 6)

        h = x * (1.0 + sc1) + sh1
        hc = xc * (1.0 + sc1c) + sh1c
        p = h @ w_in_l

        q = apply_axial_rope(p[..., DA_Q0:DA_K0].reshape(B, T, DA_HEADS, 2, DA_QK_DIM) * DA_QK_DIM ** -0.5, cos, sin)
        k = apply_axial_rope(p[..., DA_K0:DA_V0].reshape(B, T, DA_HEADS, 2, DA_QK_DIM), cos, sin)
        v = p[..., DA_V0:RW_0].reshape(B, T, DA_HEADS, DA_V_DIM)
        pc_kv = hc @ w_in_l[:, DA_K0:RW_0]
        kc = pc_kv[..., :DA_QK_COLS].reshape(B, Tc, DA_HEADS, 2, DA_QK_DIM)
        vc = pc_kv[..., DA_QK_COLS:].reshape(B, Tc, DA_HEADS, DA_V_DIM)
        y_da = diff_attention_latent(q, k, v, kc, vc, lam, da_norm_g[l], lam_init)

        pc_rw = hc @ w_in_l[:, RW_0:SG_0]
        y_rw, y_rw_c = rwkv7_mixer(p[..., RW_0:SG_0], pc_rw, rw_shift_mu[l], rw_w0[l], rw_w2[l],
                                   rw_a0[l], rw_a2[l], rw_k_k[l], rw_k_a[l], rw_r_k[l],
                                   rw_ln_g[l], rw_ln_b[l], rw_g2[l], not last)

        y_sg = spatial_gating(p[..., SG_0:GATE_0], sg_norm_g[l], sg_norm_b[l], sg_w[l], sg_b[l])

        mix = gated_merge(y_da, y_rw, y_sg, p[..., GATE_0:], w_branch[l], w_out[l])
        x_mid = layer_norm(DN_ALPHA * x + g1 * mix, ln1_g[l], ln1_b[l])
        f = expert_choice_ffn(x_mid * (1.0 + sc2) + sh2, w_router[l], w_e_gate[l], w_e_up[l], w_e_down[l])
        x_new = layer_norm(DN_ALPHA * x_mid + g2 * f, ln2_g[l], ln2_b[l])

        if not last:
            qc = (hc @ w_in_l[:, DA_Q0:DA_K0]).reshape(B, Tc, DA_HEADS, 2, DA_QK_DIM) * DA_QK_DIM ** -0.5
            y_da_c = diff_attention_context(qc, kc, vc, lam, da_norm_g[l], lam_init)
            pc_rest = hc @ w_in_l[:, SG_0:]
            y_sg_c = spatial_gating(pc_rest[..., :2 * SG_WIDTH], sg_norm_g[l], sg_norm_b[l], sg_w[l], sg_b[l])
            mix_c = gated_merge(y_da_c, y_rw_c, y_sg_c, pc_rest[..., 2 * SG_WIDTH:], w_branch[l], w_out[l])
            xc_mid = layer_norm(DN_ALPHA * xc + g1c * mix_c, ln1_g[l], ln1_b[l])
            fc = expert_choice_ffn(xc_mid * (1.0 + sc2c) + sh2c, w_router[l], w_e_gate[l], w_e_up[l], w_e_down[l])
            xc = layer_norm(DN_ALPHA * xc_mid + g2c * fc, ln2_g[l], ln2_b[l])
        x = x_new
    return x
```

```cpp
#include <hip/hip_runtime.h>

#ifndef SPLIT_K
#define SPLIT_K 0
#endif
#include <cstdio>
#include <cstdint>
#include <cmath>

#define LAS __attribute__((address_space(3)))
#define GAS __attribute__((address_space(1)))
typedef unsigned short bf16_t;
typedef short bf16x8 __attribute__((ext_vector_type(8)));
typedef float f32x4 __attribute__((ext_vector_type(4)));
typedef float f32x2 __attribute__((ext_vector_type(2)));
typedef float f32x16 __attribute__((ext_vector_type(16)));
typedef unsigned u32x4 __attribute__((ext_vector_type(4)));
typedef unsigned u32x2 __attribute__((ext_vector_type(2)));

constexpr int NB = 16, T_LAT = 2048, T_CTX = 256, T_ALL = 2304, DM = 1024, DEPTH = 2;
constexpr int ROWS = NB * T_ALL;
constexpr int NPM = ROWS / 256;
constexpr int IN_COLS = 7424, RW_COLS = 1792, MIXW = 1536;
constexpr int NEXP = 16, FF = 2048, CAP_L = 256, CAP_C = 32;
constexpr int EROWS = NB * CAP_L + NB * CAP_C;
constexpr float LN_EPS = 1e-5f, DA_EPS = 1e-5f, RW_GN_EPS = 64e-5f;
constexpr float DN_ALPHA = 1.4142135623730951f;
constexpr float QSCALE = 0.125f * 1.4426950408889634f;

constexpr size_t MiB = 1u << 20;
constexpr size_t WS_CTL = 0;
constexpr size_t CTL_ZERO_BYTES = 64 * 1024;
constexpr size_t WS_MODF = 1 * MiB;
constexpr size_t WS_SMALL = 2 * MiB;
constexpr size_t WS_AFF = 3 * MiB;
constexpr size_t WS_SLOT = 6 * MiB;
constexpr size_t WS_GATEE = 8 * MiB;
constexpr size_t WS_BONUS = 9 * MiB;
constexpr size_t WS_X = 16 * MiB;
constexpr size_t WS_H = 160 * MiB;
constexpr size_t WS_WIN = 232 * MiB;
constexpr size_t WS_WB = 247 * MiB;
constexpr size_t WS_WOUT = 250 * MiB;
constexpr size_t WS_G2T = 252 * MiB;
constexpr size_t WS_WLO = 253 * MiB;
constexpr size_t WS_WE1 = 254 * MiB;
constexpr size_t WS_WE2 = 382 * MiB;
constexpr size_t WS_R = 446 * MiB;
constexpr size_t R_Q = WS_R + 0 * MiB;
constexpr size_t R_K = WS_R + 36 * MiB;
constexpr size_t R_VT = WS_R + 72 * MiB;
constexpr size_t R_SG = WS_R + 108 * MiB;
constexpr size_t R_KLO = WS_R + 180 * MiB;
constexpr size_t R_GATE = WS_R + 0 * MiB;
constexpr size_t R_PRW = WS_R + 216 * MiB;
constexpr size_t R_YFB = WS_R + 342 * MiB;
constexpr size_t R_M = WS_R + 216 * MiB;
constexpr size_t R_MACC = WS_R + 342 * MiB;
constexpr size_t R_MODP = WS_R + 0 * MiB;
constexpr size_t R_HID = WS_R + 0 * MiB;
constexpr size_t R_XE = WS_R + 288 * MiB;
constexpr size_t R_YE = WS_R + 288 * MiB;
constexpr size_t WS_END = WS_R + 576 * MiB;

constexpr int LDS_MAIN = 155648;
constexpr int LDS_MISC = LDS_MAIN;
constexpr int LDS_BYTES = LDS_MAIN + 64 + 34 * 8 + 48;

__device__ __forceinline__ unsigned f2bf(float f) { unsigned u = __builtin_bit_cast(unsigned, f); return (u + 0x7fffu + ((u >> 16) & 1u)) >> 16; }
__device__ __forceinline__ unsigned pk2(float lo, float hi) { return f2bf(lo) | (f2bf(hi) << 16); }
typedef __bf16 bf16x2_t __attribute__((ext_vector_type(2)));
__device__ __forceinline__ unsigned cvt_pk_bf16(float lo, float hi) { const f32x2 v = {lo, hi}; const bf16x2_t b = __builtin_convertvector(v, bf16x2_t); return __builtin_bit_cast(unsigned, b); }
__device__ __forceinline__ float bf2f(bf16_t b) { return __builtin_bit_cast(float, ((unsigned)b) << 16); }
__device__ __forceinline__ float bflo(unsigned w) { return __builtin_bit_cast(float, w << 16); }
__device__ __forceinline__ float bfhi(unsigned w) { return __builtin_bit_cast(float, w & 0xffff0000u); }
__device__ __forceinline__ float fast_exp2(float x) { return __builtin_amdgcn_exp2f(x); }
__device__ __forceinline__ float fast_rcp(float x) { return __builtin_amdgcn_rcpf(x); }
__device__ __forceinline__ float sigmoidf_(float x) { return fast_rcp(1.0f + fast_exp2(-1.4426950408889634f * x)); }
__device__ __forceinline__ float siluf_(float x) { return x * sigmoidf_(x); }
__device__ __forceinline__ float gelu_tanh(float x) { const float u = 0.7978845608028654f * (x + 0.044715f * x * x * x); return x * sigmoidf_(2.0f * u); }
__device__ __forceinline__ float tanhf_(float x) { return 2.0f * sigmoidf_(2.0f * x) - 1.0f; }
template <int CTRL> __device__ __forceinline__ float dppf(float v) { return __builtin_bit_cast(float, __builtin_amdgcn_mov_dpp(__builtin_bit_cast(int, v), CTRL, 0xF, 0xF, true)); }
__device__ __forceinline__ float sum16(float v) {
#ifdef PROBE_NAIVE_RW
    v += __shfl_xor(v, 1); v += __shfl_xor(v, 2); v += __shfl_xor(v, 4); v += __shfl_xor(v, 8); return v;
#endif
    v += dppf<0xB1>(v);
    v += dppf<0x4E>(v);
    v += dppf<0x141>(v);
    v += dppf<0x140>(v);
    return v;
}
__device__ __forceinline__ float sum8(float v) {
    v += dppf<0xB1>(v); v += dppf<0x4E>(v); v += dppf<0x141>(v); return v;
}
__device__ __forceinline__ void xhalf_swap(float& a, float& b) { asm volatile("s_nop 1\n\tv_permlane32_swap_b32 %0, %1\n\ts_nop 1" : "+v"(a), "+v"(b)); }
__device__ __forceinline__ float xhalf_max(float m) { float a = m, b = m; xhalf_swap(a, b); return fmaxf(a, b); }
__device__ __forceinline__ float xhalf_sum(float m) { float a = m, b = m; xhalf_swap(a, b); return a + b; }
__device__ __forceinline__ float wave_sum(float v) { v = sum16(v); v += __shfl_xor(v, 16); return xhalf_sum(v); }
__device__ __forceinline__ float wave_max(float v) {
    v = fmaxf(v, dppf<0xB1>(v)); v = fmaxf(v, dppf<0x4E>(v)); v = fmaxf(v, dppf<0x141>(v)); v = fmaxf(v, dppf<0x140>(v)); v = fmaxf(v, __shfl_xor(v, 16)); return xhalf_max(v); }
__device__ __forceinline__ int crow(int r, int hi) { return (r & 3) + 8 * (r >> 2) + 4 * hi; }
#define LDS_WAIT() asm volatile("s_waitcnt lgkmcnt(0)" ::: "memory")
#define VM_WAIT() asm volatile("s_waitcnt vmcnt(0)" ::: "memory")

#define XB_TMO      128
#define XB_XCNT(j)  (256  + 64 * (j))
#define XB_XSUB(j)  (1280 + 64 * (j))
#define XB_XGEN(j)  (2304 + 64 * (j))
#define XB_TOP      3328
#define XB_TOPGEN   3392
#define XCD_BAR_WORDS 3456
#define XB_SPIN_CAP (1u << 20)
__device__ __forceinline__ unsigned xb_ld(unsigned* p)              { return __hip_atomic_load(p, __ATOMIC_RELAXED, __HIP_MEMORY_SCOPE_AGENT); }
__device__ __forceinline__ unsigned xb_add(unsigned* p, unsigned v) { return __hip_atomic_fetch_add(p, v, __ATOMIC_RELAXED, __HIP_MEMORY_SCOPE_AGENT); }
__device__ __forceinline__ unsigned xb_xcc_id() { return (unsigned)__builtin_amdgcn_s_getreg((3 << 11) | 20) & 0xFu; }
#define XB_SPIN(cond, bar) do { unsigned _sp = 0; while (cond) { __builtin_amdgcn_s_sleep(1); \
    if ((++_sp & 255u) == 0u) { if (xb_ld(&(bar)[XB_TMO])) break; if (_sp > XB_SPIN_CAP) { atomicAdd(&(bar)[XB_TMO], 1u); break; } } } } while (0)
struct XcdBarrier { unsigned* bar; unsigned x; volatile LAS unsigned* st; };
__device__ __forceinline__ XcdBarrier xcd_barrier_post(unsigned* bar, volatile LAS unsigned* st) {
    XcdBarrier b; b.bar = bar; b.x = xb_xcc_id(); b.st = st;
    if (threadIdx.x == 0) (void)xb_add(&bar[XB_XCNT(b.x)], 1u);
    return b;
}
__device__ __forceinline__ void xcd_barrier_complete(unsigned* bar, unsigned x, unsigned& nloc, unsigned& nx) {
    const unsigned G = gridDim.x * gridDim.y * gridDim.z;
    unsigned sum, cnt, mine, sp = 0u;
    for (;;) {
        sum = 0u; cnt = 0u; mine = 0u;
#pragma unroll
        for (unsigned j = 0; j < 16; ++j) { const unsigned c = xb_ld(&bar[XB_XCNT(j)]); sum += c; cnt += (c > 0u) ? 1u : 0u; mine = (j == x) ? c : mine; }
        if (sum == G) break;
        __builtin_amdgcn_s_sleep(1);
        if ((++sp & 255u) == 0u) { if (xb_ld(&bar[XB_TMO])) break; if (sp > XB_SPIN_CAP) { atomicAdd(&bar[XB_TMO], 1u); break; } }
    }
    nloc = mine > 0u ? mine : 1u; nx = cnt > 0u ? cnt : 1u;
}
__device__ __forceinline__ void xcd_barrier(const XcdBarrier& b) {
    asm volatile("s_waitcnt vmcnt(0)" ::: "memory");
    __syncthreads();
    if (threadIdx.x == 0) {
        unsigned* bar = b.bar;
        __builtin_amdgcn_s_waitcnt(0);
        unsigned nloc = b.st[0], nx = b.st[1];
        if (nloc == 0u) { xcd_barrier_complete(bar, b.x, nloc, nx); b.st[0] = nloc; b.st[1] = nx; }
        const unsigned old = xb_add(&bar[XB_XSUB(b.x)], 1u);
        const unsigned gen = old / nloc;
        if (old + 1u == (gen + 1u) * nloc) {
            __builtin_amdgcn_fence(__ATOMIC_RELEASE, "agent");
            asm volatile("s_waitcnt vmcnt(0)" ::: "memory");
            const unsigned og = xb_add(&bar[XB_TOP], 1u);
            const unsigned tg = og / nx;
            if (og + 1u == (tg + 1u) * nx) xb_add(&bar[XB_TOPGEN], 1u);
            else XB_SPIN(xb_ld(&bar[XB_TOPGEN]) == tg, bar);
            __builtin_amdgcn_fence(__ATOMIC_ACQUIRE, "agent");
            xb_add(&bar[XB_XGEN(b.x)], 1u);
            asm volatile("s_waitcnt vmcnt(0)" ::: "memory");
        } else {
            XB_SPIN(xb_ld(&bar[XB_XGEN(b.x)]) == gen, bar);
            __builtin_amdgcn_fence(__ATOMIC_ACQUIRE, "agent");
            asm volatile("s_waitcnt vmcnt(0)" ::: "memory");
        }
    }
    __syncthreads();
}

namespace pg8 {
constexpr int BM = 256, BK = 64, HALF = 128, HTB = HALF * BK * 2, STAGE_BYTES = 8 * HTB;
__host__ __device__ __forceinline__ int lds_byte(int r, int c) { const int st = (r >> 4) * 2 + (c >> 5), rr = r & 15, cc = c & 31, ob = rr * 64 + cc * 2; return st * 1024 + (ob ^ (((ob >> 9) & 1) << 5)); }
__host__ __device__ __forceinline__ void stage_rc(int b, int& R, int& C) { const int st = b / 1024, sb = b % 1024, swz = sb ^ (((sb >> 9) & 1) << 5); R = (st >> 1) * 16 + swz / 64; C = (st & 1) * 32 + (swz % 64) / 2; }
__host__ __device__ __forceinline__ int perm32(int rho) { const int n = rho >> 4, i = rho & 15; return 8 * (i >> 2) + 4 * n + (i & 3); }

struct Unit { long aoff, boff; int arow, brow, pm, pn, g, flags; };
constexpr int UF_ACCUM = 1  , UF_NOEPI = 2  ;
struct Gemm { const bf16_t* A; const bf16_t* Bt; int lda, ldb, K; };

template <class Epi, class Sched>
__device__ __forceinline__ void gemm_phase(LAS unsigned char* lds, const int tid, const Gemm g, Sched& S, const Epi& E) {
    const int wid = __builtin_amdgcn_readfirstlane(tid >> 6), lane = tid & 63, wr = wid >> 2, wc = wid & 3, fr = lane & 15, fq = lane >> 4;
    const int K = g.K, nt = K / BK;
    unsigned voffA[2], voffB[2];
#pragma unroll
    for (int i = 0; i < 2; ++i) { int R, C; stage_rc(tid * 16 + i * 8192, R, C); const int Rb = Epi::PERM ? ((R & ~31) + perm32(R & 31)) : R;
        voffA[i] = (unsigned)(R * g.lda + C) * 2u; voffB[i] = (unsigned)(Rb * g.ldb + C) * 2u; }
    const size_t kstep = (size_t)(BK * 2);
    const size_t hstepA = (size_t)HALF * g.lda * 2, hstepB = (size_t)HALF * g.ldb * 2;
    const size_t tstepA = 2 * hstepA, tstepB = 2 * hstepB;
    const unsigned ldsw = (unsigned)wid * 1024u;
    const int aoff = lds_byte(wr * 64 + fr, fq * 8), boff = lds_byte(wc * 32 + fr, fq * 8);
#define PG8_SA(b, h) (((b) * 2 + (h)) * HTB)
#define PG8_SB(b, h) ((4 + (b) * 2 + (h)) * HTB)
#define PG8_STAGE(bufoff, gbase, voff) do { _Pragma("unroll") for (int _i = 0; _i < 2; ++_i) \
        __builtin_amdgcn_global_load_lds((const unsigned*)((const char*)(gbase) + (voff)[_i]), (LAS unsigned*)(lds + (bufoff) + ldsw + _i * 8192), 16, 0, 0); } while (0)
#define PG8_LDA(dst, b, h) do { _Pragma("unroll") for (int m = 0; m < 4; ++m) _Pragma("unroll") for (int k = 0; k < 2; ++k) dst[m][k] = *(const LAS bf16x8*)(lds + PG8_SA(b, h) + aoff + m * 2048 + k * 1024); } while (0)
#define PG8_LDB(dst, b, h) do { _Pragma("unroll") for (int n = 0; n < 2; ++n) _Pragma("unroll") for (int k = 0; k < 2; ++k) dst[n][k] = *(const LAS bf16x8*)(lds + PG8_SB(b, h) + boff + n * 2048 + k * 1024); } while (0)
#define PG8_MMA(ai, bj, At, Bt) do { __builtin_amdgcn_s_setprio(1); _Pragma("unroll") for (int m = 0; m < 4; ++m) _Pragma("unroll") for (int n = 0; n < 2; ++n) _Pragma("unroll") for (int k = 0; k < 2; ++k) \
        acc[ai][bj][m][n] = __builtin_amdgcn_mfma_f32_16x16x32_bf16(Bt[n][k], At[m][k], acc[ai][bj][m][n], 0, 0, 0); __builtin_amdgcn_s_setprio(0); } while (0)
#define PG8_WAIT_V(n) asm volatile("s_waitcnt vmcnt(" #n ")" ::: "memory")
#define PG8_WAIT_L(n) asm volatile("s_waitcnt lgkmcnt(" #n ")" ::: "memory")
#define PG8_BAR __builtin_amdgcn_s_barrier()
#define PG8_SCHED __builtin_amdgcn_sched_barrier(0)
    Unit cur, nxt; int ui = 0;
    if (!S.next(0, cur)) return;
    f32x4 acc[2][2][4][2];
#pragma unroll
    for (int a = 0; a < 2; ++a)
#pragma unroll
        for (int b = 0; b < 2; ++b)
#pragma unroll
            for (int m = 0; m < 4; ++m)
#pragma unroll
                for (int n = 0; n < 2; ++n) acc[a][b][m][n] = (f32x4){0.f, 0.f, 0.f, 0.f};
    bf16x8 At[4][2], B0[2][2], B1[2][2];
    const char* cA = (const char*)g.A + (size_t)cur.arow * tstepA + cur.aoff; const char* cB = (const char*)g.Bt + (size_t)cur.brow * tstepB + cur.boff;
    PG8_STAGE(PG8_SB(0, 0), cB, voffB); PG8_STAGE(PG8_SB(0, 1), cB + hstepB, voffB); PG8_STAGE(PG8_SA(0, 0), cA, voffA); PG8_STAGE(PG8_SA(0, 1), cA + hstepA, voffA);
    if (wr == 1) PG8_BAR;
    PG8_WAIT_V(2); PG8_BAR;
    PG8_STAGE(PG8_SB(1, 0), cB + kstep, voffB); PG8_STAGE(PG8_SA(1, 0), cA + kstep, voffA); PG8_STAGE(PG8_SB(1, 1), cB + hstepB + kstep, voffB);
    PG8_WAIT_V(6); PG8_BAR;
    for (;;) {
        const bool has_next = S.next(ui + 1, nxt);
        const char* nA = has_next ? (const char*)g.A + (size_t)nxt.arow * tstepA + nxt.aoff : cA; const char* nB = has_next ? (const char*)g.Bt + (size_t)nxt.brow * tstepB + nxt.boff : cB;
        for (int t = 0; t < nt; t += 2) {
            if constexpr (Epi::MIDK) { if (t == 8 || t == 16) { int tz = tid; asm volatile("" : "+v"(tz)); E.midk(acc, cur, t, tz); } }
            const bool last = (t == nt - 2);
            const char* a1 = cA + (size_t)(t + 1) * kstep;
            const char* a2 = last ? nA : cA + (size_t)(t + 2) * kstep; const char* b2 = last ? nB : cB + (size_t)(t + 2) * kstep;
            const char* a3 = a2 + kstep; const char* b3 = b2 + kstep;
            PG8_LDB(B0, 0, 0); PG8_LDB(B1, 0, 1); PG8_SCHED; PG8_LDA(At, 0, 0); PG8_STAGE(PG8_SA(1, 1), a1 + hstepA, voffA);
            PG8_WAIT_V(8); PG8_WAIT_L(0); PG8_BAR; PG8_MMA(0, 0, At, B0); PG8_MMA(0, 1, At, B1); PG8_BAR; PG8_SCHED;
            PG8_LDA(At, 0, 1); PG8_STAGE(PG8_SB(0, 0), b2, voffB); PG8_STAGE(PG8_SB(0, 1), b2 + hstepB, voffB); PG8_STAGE(PG8_SA(0, 0), a2, voffA);
            PG8_WAIT_V(8); PG8_WAIT_L(0); PG8_BAR; PG8_MMA(1, 0, At, B0); PG8_MMA(1, 1, At, B1); PG8_BAR; PG8_SCHED;
            PG8_LDB(B0, 1, 0); PG8_LDB(B1, 1, 1); PG8_SCHED; PG8_LDA(At, 1, 0); PG8_STAGE(PG8_SA(0, 1), a2 + hstepA, voffA);
            PG8_WAIT_V(8); PG8_WAIT_L(0); PG8_BAR; PG8_MMA(0, 0, At, B0); PG8_MMA(0, 1, At, B1); PG8_BAR; PG8_SCHED;
            PG8_LDA(At, 1, 1); PG8_STAGE(PG8_SB(1, 0), b3, voffB); PG8_STAGE(PG8_SB(1, 1), b3 + hstepB, voffB); PG8_STAGE(PG8_SA(1, 0), a3, voffA);
            PG8_WAIT_V(8); PG8_WAIT_L(0); PG8_BAR; PG8_MMA(1, 0, At, B0); PG8_MMA(1, 1, At, B1); PG8_BAR; PG8_SCHED;
        }
        if (wr == 0) PG8_BAR;
#ifdef PROBE_PNOISE
        if (Epi::PROBE_P && !(cur.flags & UF_NOEPI)) {
#pragma unroll
            for (int a = 0; a < 2; ++a)
#pragma unroll
                for (int b = 0; b < 2; ++b)
#pragma unroll
                    for (int m = 0; m < 4; ++m)
#pragma unroll
                        for (int n = 0; n < 2; ++n)
#pragma unroll
                            for (int i = 0; i < 4; ++i) { unsigned hsh = (unsigned)(((cur.pm * 32 + cur.pn) * 512 + tid) * 128 + ((a * 2 + b) * 4 + m) * 8 + n * 4 + i) * 2654435761u; hsh ^= hsh >> 15; hsh *= 2246822519u; hsh ^= hsh >> 13;
                                acc[a][b][m][n][i] *= 1.0f + PROBE_PNOISE * (((float)(hsh & 0xffff) * (1.0f / 32768.0f) - 1.0f) * 1.7320508f); }
        }
#endif
        if (!(cur.flags & UF_NOEPI)) { int tz = tid; asm volatile("" : "+v"(tz));
          const int w2 = __builtin_amdgcn_readfirstlane(tz >> 6), l2 = tz & 63; E(acc, cur, w2 >> 2, w2 & 3, l2 & 15, l2 >> 4); }
        if (!has_next) break;
        if (!(nxt.flags & UF_ACCUM)) {
#pragma unroll
        for (int a = 0; a < 2; ++a)
#pragma unroll
            for (int b = 0; b < 2; ++b)
#pragma unroll
                for (int m = 0; m < 4; ++m)
#pragma unroll
                    for (int n = 0; n < 2; ++n) acc[a][b][m][n] = (f32x4){0.f, 0.f, 0.f, 0.f};
        }
        cur = nxt; cA = nA; cB = nB; ++ui;
        if (wr == 1) PG8_BAR;
    }
    PG8_WAIT_V(0);
    PG8_BAR;
#undef PG8_SA
#undef PG8_SB
#undef PG8_STAGE
#undef PG8_LDA
#undef PG8_LDB
#undef PG8_MMA
#undef PG8_WAIT_V
#undef PG8_WAIT_L
#undef PG8_BAR
#undef PG8_SCHED
}
}
__device__ __forceinline__ int pm_of(int kind, int pmi) { return kind == 0 ? pmi : (kind == 1 ? pmi + (pmi >> 3) + 1 : 9 * pmi); }
__device__ __forceinline__ int npm_of(int kind) { return kind == 0 ? 144 : (kind == 1 ? 128 : 16); }
struct RectSched {
    int G, c; int cnt0, kind0, pn00, npn0, cnt1, kind1, pn01, npn1;
    __device__ __forceinline__ void init(int G_, int c_, int kind0_, int pn00_, int npn0_, int kind1_, int pn01_, int npn1_) {
        G = G_; c = c_; kind0 = kind0_; pn00 = pn00_; npn0 = npn0_; cnt0 = npm_of(kind0_) * npn0_; kind1 = kind1_; pn01 = pn01_; npn1 = npn1_; cnt1 = npn1_ > 0 ? npm_of(kind1_) * npn1_ : 0; }
    __device__ __forceinline__ bool decode(int L, int& pm, int& pn) const {
        int kind, pn0, npn;
        if (L < cnt0) { kind = kind0; pn0 = pn00; npn = npn0; } else { L -= cnt0; if (L >= cnt1) return false; kind = kind1; pn0 = pn01; npn = npn1; }
        const int grp = L / (8 * npn), rem = L - grp * 8 * npn; const int pmi = grp * 8 + (rem & 7), pni = rem >> 3;
        pm = pm_of(kind, pmi); pn = pn0 + pni; return true;
    }
    __device__ __forceinline__ bool next(int i, pg8::Unit& u) {
        int pm, pn; if (!decode(i * G + c, pm, pn)) return false;
        u.pm = pm; u.pn = pn; u.arow = pm; u.brow = pn; u.aoff = 0; u.boff = 0; u.g = 0; u.flags = 0; return true;
    }
};
struct InProjSched : RectSched {
    long hlo_off, wlo_off; int t, seg, nseg, pm_, pn_;
    __device__ __forceinline__ void init2(long hlo_off_, long wlo_off_) { hlo_off = hlo_off_; wlo_off = wlo_off_; t = 0; seg = 0; nseg = 1; pm_ = 0; pn_ = 0; }
    __device__ __forceinline__ bool next(int, pg8::Unit& u) {
        if (seg == 0) { if (!decode(t * G + c, pm_, pn_)) return false; nseg = (SPLIT_K && (pn_ == 8 || pn_ == 9)) ? 3 : 1; }
        u.pm = pm_; u.pn = pn_; u.g = 0; u.arow = pm_; u.brow = (seg == 1) ? pn_ - 8 : pn_;
        u.aoff = (seg == 2) ? hlo_off : 0; u.boff = (seg == 1) ? wlo_off : 0;
        u.flags = (seg > 0 ? pg8::UF_ACCUM : 0) | (seg + 1 < nseg ? pg8::UF_NOEPI : 0);
        if (++seg == nseg) { seg = 0; ++t; }
        return true;
    }
};
struct MergeSched {
    int G, c, kind, ntile;
    __device__ __forceinline__ void init(int G_, int c_, int kind_) { G = G_; c = c_; kind = kind_; ntile = npm_of(kind_) * 4; }
    __device__ __forceinline__ bool next(int i, pg8::Unit& u) {
        const int ti = c + i * G; if (ti >= ntile) return false;
        u.pm = pm_of(kind, ti >> 2); u.pn = ti & 3; u.arow = u.pm; u.brow = u.pn; u.aoff = 0; u.boff = 0; u.g = 0; u.flags = 0; return true;
    }
};
struct MoeSched {
    int G, c, npm_e, npn, atile_e, btile_e;
    __device__ __forceinline__ void init(int G_, int c_, int npm_e_, int npn_, int btile_e_) { G = G_; c = c_; npm_e = npm_e_; npn = npn_; atile_e = EROWS / 256; btile_e = btile_e_; }
    __device__ __forceinline__ bool next(int i, pg8::Unit& u) {
        const int L = i * G + c, per = npm_e * npn; if (L >= NEXP * per) return false;
        const int e = L / per, rem = L - e * per; const int pmi = rem % npm_e, pni = rem / npm_e;
        u.pm = pmi; u.pn = pni; u.g = e; u.arow = e * atile_e + pmi; u.brow = e * btile_e + pni; u.aoff = 0; u.boff = 0; u.flags = 0; return true;
    }
};

typedef const f32x4 (&AccRef)[2][2][4][2];
__device__ __forceinline__ int perm16(int kk) { return 8 * ((kk >> 2) & 1) + (kk & 3) + 4 * (kk >> 3); }

struct EpiInProj {
    static constexpr bool PERM = true, PROBE_P = true, MIDK = false;
    bf16_t *Q, *Kb, *Vt, *PRW, *SG, *GATE; const f32x2* rope; bf16_t* KLO;
    __device__ __forceinline__ void operator()(AccRef acc, const pg8::Unit& u, int wr, int wc, int fr, int fq) const {
        const int pn = u.pn, b = u.pm / 9, sl = u.pm - 9 * b; const bool is_ctx = (sl == 0);
        const int rbase = wr * 64 + fr, c8 = wc * 32 + 8 * fq;
        if (pn < 4) {
            bf16_t* dst = (pn < 2) ? Q : Kb; const int cb = (pn & 1) * 256; const float sc = (pn < 2) ? QSCALE : 1.0f; const int hh = wc & 1;
#pragma unroll
            for (int ai = 0; ai < 2; ++ai)
#pragma unroll
                for (int m = 0; m < 4; ++m) { const int rl = ai * 128 + m * 16 + rbase; const size_t row = (size_t)u.pm * 256 + rl;
                    f32x4 r01 = (f32x4){1.f, 0.f, 1.f, 0.f}, r23 = r01;
                    if (!is_ctx) { const int t = (sl - 1) * 256 + rl; const int pos = hh ? (t & 63) : (t >> 6); const f32x4* rp = (const f32x4*)(rope + pos * 16 + 4 * fq); r01 = rp[0]; r23 = rp[1]; }
#pragma unroll
                    for (int bj = 0; bj < 2; ++bj) { const f32x4 v0 = acc[ai][bj][m][0] * sc, v1 = acc[ai][bj][m][1] * sc;
                        const float o0 = v0[0] * r01[0] - v0[1] * r01[1], o1 = v0[1] * r01[0] + v0[0] * r01[1];
                        const float o2 = v0[2] * r01[2] - v0[3] * r01[3], o3 = v0[3] * r01[2] + v0[2] * r01[3];
                        const float o4 = v1[0] * r23[0] - v1[1] * r23[1], o5 = v1[1] * r23[0] + v1[0] * r23[1];
                        const float o6 = v1[2] * r23[2] - v1[3] * r23[3], o7 = v1[3] * r23[2] + v1[2] * r23[3];
                        u32x4 w; w.x = cvt_pk_bf16(o0, o1); w.y = cvt_pk_bf16(o2, o3); w.z = cvt_pk_bf16(o4, o5); w.w = cvt_pk_bf16(o6, o7);
                        *(u32x4*)(dst + row * 512 + cb + bj * 128 + c8) = w; } }
        } else if (pn < 6) {
#pragma unroll
            for (int ai = 0; ai < 2; ++ai)
#pragma unroll
                for (int m = 0; m < 4; ++m) { const int rl = ai * 128 + m * 16 + rbase; const int s = sl * 256 + rl; const int slot = (s & ~15) + perm16(s & 15);
#pragma unroll
                    for (int bj = 0; bj < 2; ++bj) { const int head = 2 * (pn - 4) + bj; bf16_t* vp = Vt + ((size_t)(b * 4 + head) * 128 + c8) * T_ALL + slot;
#pragma unroll
                        for (int n = 0; n < 2; ++n)
#pragma unroll
                            for (int i = 0; i < 4; ++i) vp[(size_t)(4 * n + i) * T_ALL] = (bf16_t)f2bf(acc[ai][bj][m][n][i]); } }
        } else if (SPLIT_K && (pn == 8 || pn == 9)) {
#pragma unroll
            for (int ai = 0; ai < 2; ++ai)
#pragma unroll
                for (int m = 0; m < 4; ++m) { const size_t row = (size_t)u.pm * 256 + ai * 128 + m * 16 + rbase;
#pragma unroll
                    for (int bj = 0; bj < 2; ++bj) { const f32x4 v0 = acc[ai][bj][m][0], v1 = acc[ai][bj][m][1];
                        u32x4 w; w.x = cvt_pk_bf16(v0[0], v0[1]); w.y = cvt_pk_bf16(v0[2], v0[3]); w.z = cvt_pk_bf16(v1[0], v1[1]); w.w = cvt_pk_bf16(v1[2], v1[3]);
                        *(u32x4*)(PRW + row * RW_COLS + (pn - 6) * 256 + bj * 128 + c8) = w;
                        u32x4 lo; lo.x = cvt_pk_bf16(v0[0] - bflo(w.x), v0[1] - bfhi(w.x)); lo.y = cvt_pk_bf16(v0[2] - bflo(w.y), v0[3] - bfhi(w.y));
                        lo.z = cvt_pk_bf16(v1[0] - bflo(w.z), v1[1] - bfhi(w.z)); lo.w = cvt_pk_bf16(v1[2] - bflo(w.w), v1[3] - bfhi(w.w));
                        *(u32x4*)(KLO + row * 512 + (pn - 8) * 256 + bj * 128 + c8) = lo; } }
        } else if (pn < 13) rows_bf16<0>(acc, PRW, RW_COLS, (pn - 6) * 256 + c8, (size_t)u.pm * 256 + rbase);
        else if (pn < 17) rows_bf16<1>(acc, SG, 1024, (pn - 13) * 256 + c8, (size_t)u.pm * 256 + rbase);
        else {
            const int gj = (pn - 17) >> 2, pnm = (pn - 17) & 3;
            bf16_t* gp = GATE + (((((size_t)u.pm * 4 + pnm) * 3 + gj) * 8 + (wr * 4 + wc)) * 16) * 512 + (fr + 16 * fq) * 8;
#pragma unroll
            for (int ai = 0; ai < 2; ++ai)
#pragma unroll
                for (int m = 0; m < 4; ++m)
#pragma unroll
                    for (int bj = 0; bj < 2; ++bj) { f32x4 v0 = acc[ai][bj][m][0], v1 = acc[ai][bj][m][1];
#pragma unroll
                        for (int i = 0; i < 4; ++i) { v0[i] = sigmoidf_(v0[i]); v1[i] = sigmoidf_(v1[i]); }
                        u32x4 w; w.x = cvt_pk_bf16(v0[0], v0[1]); w.y = cvt_pk_bf16(v0[2], v0[3]); w.z = cvt_pk_bf16(v1[0], v1[1]); w.w = cvt_pk_bf16(v1[2], v1[3]);
                        *(u32x4*)(gp + ((ai * 4 + m) * 2 + bj) * 512) = w; } }
    }
    template <int ACT> static __device__ __forceinline__ void rows_bf16(AccRef acc, bf16_t* dst, int ld, int col, size_t row0) {
#pragma unroll
        for (int ai = 0; ai < 2; ++ai)
#pragma unroll
            for (int m = 0; m < 4; ++m) { bf16_t* rp = dst + (row0 + ai * 128 + m * 16) * ld + col;
#pragma unroll
                for (int bj = 0; bj < 2; ++bj) { f32x4 v0 = acc[ai][bj][m][0], v1 = acc[ai][bj][m][1];
                    if (ACT == 1) {
#pragma unroll
                        for (int i = 0; i < 4; ++i) { v0[i] = gelu_tanh(v0[i]); v1[i] = gelu_tanh(v1[i]); } }
                    if (ACT == 2) {
#pragma unroll
                        for (int i = 0; i < 4; ++i) { v0[i] = sigmoidf_(v0[i]); v1[i] = sigmoidf_(v1[i]); } }
                    u32x4 w; w.x = cvt_pk_bf16(v0[0], v0[1]); w.y = cvt_pk_bf16(v0[2], v0[3]); w.z = cvt_pk_bf16(v1[0], v1[1]); w.w = cvt_pk_bf16(v1[2], v1[3]);
                    *(u32x4*)(rp + bj * 128) = w; } }
    }
};

struct EpiMerge { static constexpr bool PROBE_P = false;
    static constexpr bool PERM = true, MIDK = true;
    const bf16_t* GATE; bf16_t* M;
    static __device__ __forceinline__ f32x4 glo(u32x4 w) { return (f32x4){fmaxf(bflo(w.x), 1e-30f), fmaxf(bfhi(w.x), 1e-30f), fmaxf(bflo(w.y), 1e-30f), fmaxf(bfhi(w.y), 1e-30f)}; }
    static __device__ __forceinline__ f32x4 ghi(u32x4 w) { return (f32x4){fmaxf(bflo(w.z), 1e-30f), fmaxf(bfhi(w.z), 1e-30f), fmaxf(bflo(w.w), 1e-30f), fmaxf(bfhi(w.w), 1e-30f)}; }
    __device__ __forceinline__ void midk(f32x4 (&acc)[2][2][4][2], const pg8::Unit& u, int t, int tz) const {
        const int w2 = __builtin_amdgcn_readfirstlane(tz >> 6), l2 = tz & 63, wr = w2 >> 2, wc = w2 & 3, fr = l2 & 15, fq = l2 >> 4;
        const int j = (t == 8) ? 0 : 1;
        const bf16_t* gbase = GATE + (((((size_t)u.pm * 4 + u.pn) * 3 + j) * 8 + w2) * 16) * 512 + l2 * 8;
#pragma unroll
        for (int ai = 0; ai < 2; ++ai) { u32x4 ga[4][2], gb[4][2];
#pragma unroll
            for (int m = 0; m < 4; ++m)
#pragma unroll
                for (int bj = 0; bj < 2; ++bj) { const bf16_t* gp = gbase + ((ai * 4 + m) * 2 + bj) * 512; ga[m][bj] = *(const u32x4*)gp; gb[m][bj] = *(const u32x4*)(gp + 8 * 16 * 512); }
#pragma unroll
            for (int m = 0; m < 4; ++m)
#pragma unroll
                for (int bj = 0; bj < 2; ++bj) { const f32x4 a0 = glo(ga[m][bj]), a1 = ghi(ga[m][bj]), b0 = glo(gb[m][bj]), b1 = ghi(gb[m][bj]);
#pragma unroll
                    for (int i = 0; i < 4; ++i) { acc[ai][bj][m][0][i] *= a0[i] * fast_rcp(b0[i]); acc[ai][bj][m][1][i] *= a1[i] * fast_rcp(b1[i]); } } }
    }
    __device__ __forceinline__ void operator()(const f32x4 (&acc)[2][2][4][2], const pg8::Unit& u, int wr, int wc, int fr, int fq) const {
        const int rbase = wr * 64 + fr, c8 = u.pn * 256 + wc * 32 + 8 * fq;
        u32x4 gwv[2][4][2];
        { const bf16_t* gbase = GATE + (((((size_t)u.pm * 4 + u.pn) * 3 + 2) * 8 + (wr * 4 + wc)) * 16) * 512 + (fr + 16 * fq) * 8;
#pragma unroll
          for (int ai = 0; ai < 2; ++ai)
#pragma unroll
              for (int m = 0; m < 4; ++m)
#pragma unroll
                  for (int bj = 0; bj < 2; ++bj) gwv[ai][m][bj] = *(const u32x4*)(gbase + ((ai * 4 + m) * 2 + bj) * 512); }
#pragma unroll
        for (int ai = 0; ai < 2; ++ai)
#pragma unroll
            for (int m = 0; m < 4; ++m) { const size_t row = (size_t)u.pm * 256 + ai * 128 + m * 16 + rbase;
#pragma unroll
                for (int bj = 0; bj < 2; ++bj) { const int col = c8 + bj * 128;
                    const u32x4 gw = gwv[ai][m][bj];
                    const f32x4 v0 = acc[ai][bj][m][0] * glo(gw), v1 = acc[ai][bj][m][1] * ghi(gw);
                    u32x4 w; w.x = cvt_pk_bf16(v0[0], v0[1]); w.y = cvt_pk_bf16(v0[2], v0[3]); w.z = cvt_pk_bf16(v1[0], v1[1]); w.w = cvt_pk_bf16(v1[2], v1[3]);
                    *(u32x4*)(M + row * 1024 + col) = w; } }
    }
};

struct EpiWout { static constexpr bool PROBE_P = false, MIDK = false;
    static constexpr bool PERM = false;
    const float* xin; const float* cin; float* X; const float* mod; int layer0;
    __device__ __forceinline__ void operator()(AccRef acc, const pg8::Unit& u, int wr, int wc, int fr, int fq) const {
        const int b = u.pm / 9, sl = u.pm - 9 * b; const bool is_ctx = (sl == 0);
        const float* g1 = mod + (size_t)(is_ctx ? 16 : b) * 6144 + 2048;
        const int rbase = wr * 64 + fr, c4 = u.pn * 256 + wc * 32 + 4 * fq;
        f32x4 gv[2][2];
#pragma unroll
        for (int bj = 0; bj < 2; ++bj)
#pragma unroll
            for (int n = 0; n < 2; ++n) gv[bj][n] = *(const f32x4*)(g1 + c4 + bj * 128 + n * 16);
#pragma unroll
        for (int ai = 0; ai < 2; ++ai) { f32x4 xv[4][2][2];
#pragma unroll
            for (int m = 0; m < 4; ++m) { const int rl = ai * 128 + m * 16 + rbase; const size_t row = (size_t)u.pm * 256 + rl;
                const float* xp = layer0 ? (is_ctx ? cin + ((size_t)b * T_CTX + rl) * 1024 : xin + ((size_t)b * T_LAT + (sl - 1) * 256 + rl) * 1024) : X + row * 1024;
#pragma unroll
                for (int bj = 0; bj < 2; ++bj)
#pragma unroll
                    for (int n = 0; n < 2; ++n) xv[m][bj][n] = *(const f32x4*)(xp + c4 + bj * 128 + n * 16); }
#pragma unroll
            for (int m = 0; m < 4; ++m) { const size_t row = (size_t)u.pm * 256 + ai * 128 + m * 16 + rbase;
#pragma unroll
                for (int bj = 0; bj < 2; ++bj)
#pragma unroll
                    for (int n = 0; n < 2; ++n) { const int col = c4 + bj * 128 + n * 16; *(f32x4*)(X + row * 1024 + col) = DN_ALPHA * xv[m][bj][n] + gv[bj][n] * acc[ai][bj][m][n]; } } }
    }
};

struct EpiMoe1 { static constexpr bool PROBE_P = false, MIDK = false;
    static constexpr bool PERM = true;
    bf16_t* HID;
    __device__ __forceinline__ void operator()(AccRef acc, const pg8::Unit& u, int wr, int wc, int fr, int fq) const {
        const int rbase = wr * 64 + fr, c8 = u.pn * 128 + wc * 32 + 8 * fq;
#pragma unroll
        for (int ai = 0; ai < 2; ++ai)
#pragma unroll
            for (int m = 0; m < 4; ++m) { const size_t row = (size_t)u.g * EROWS + u.pm * 256 + ai * 128 + m * 16 + rbase;
                float h[8];
#pragma unroll
                for (int n = 0; n < 2; ++n)
#pragma unroll
                    for (int i = 0; i < 4; ++i) h[4 * n + i] = siluf_(acc[ai][0][m][n][i]) * acc[ai][1][m][n][i];
                u32x4 w; w.x = cvt_pk_bf16(h[0], h[1]); w.y = cvt_pk_bf16(h[2], h[3]); w.z = cvt_pk_bf16(h[4], h[5]); w.w = cvt_pk_bf16(h[6], h[7]);
                *(u32x4*)(HID + row * FF + c8) = w; }
    }
};

struct EpiMoe2 { static constexpr bool PROBE_P = false, MIDK = false;
    static constexpr bool PERM = true;
    bf16_t* YE; const float* GATEE;
    __device__ __forceinline__ void operator()(AccRef acc, const pg8::Unit& u, int wr, int wc, int fr, int fq) const {
        const int rbase = wr * 64 + fr, c8 = u.pn * 256 + wc * 32 + 8 * fq;
#pragma unroll
        for (int ai = 0; ai < 2; ++ai)
#pragma unroll
            for (int m = 0; m < 4; ++m) { const size_t row = (size_t)u.g * EROWS + u.pm * 256 + ai * 128 + m * 16 + rbase; const float gt = GATEE[row];
#pragma unroll
                for (int bj = 0; bj < 2; ++bj) { const f32x4 v0 = acc[ai][bj][m][0] * gt, v1 = acc[ai][bj][m][1] * gt;
                    u32x4 w; w.x = cvt_pk_bf16(v0[0], v0[1]); w.y = cvt_pk_bf16(v0[2], v0[3]); w.z = cvt_pk_bf16(v1[0], v1[1]); w.w = cvt_pk_bf16(v1[2], v1[3]);
                    *(u32x4*)(YE + row * 1024 + c8 + bj * 128) = w; } }
    }
};
struct Frame {
    LAS unsigned char* lds;
    int tid, lane, wave, G, blk;
    float* out; unsigned char* ws;
    __device__ __forceinline__ const float* inp(int i) const {
        const u32x2 w = *(const LAS u32x2*)(lds + LDS_MISC + 64 + 8 * i);
        const unsigned lo = __builtin_amdgcn_readfirstlane(w.x), hi = __builtin_amdgcn_readfirstlane(w.y);
        const GAS float* p = (const GAS float*)(((unsigned long long)hi << 32) | lo);
        return (const float*)p;
    }
};
__device__ __forceinline__ void relaunder(Frame& F) { int tz = threadIdx.x; asm volatile("" : "+v"(tz)); F.tid = tz; F.lane = tz & 63; F.wave = __builtin_amdgcn_readfirstlane(tz >> 6); }
enum { I_X = 0, I_C, I_CTX, I_CCTX, I_WMOD, I_BMOD, I_WIN, I_DALAM, I_DANG, I_RWMU, I_RWW0, I_RWW2, I_RWA0, I_RWA2, I_RWKK, I_RWKA, I_RWRK, I_RWLNG, I_RWLNB, I_RWG2,
       I_SGNG, I_SGNB, I_SGW, I_SGB, I_WBR, I_WOUT, I_LN1G, I_LN1B, I_WROUTER, I_WEG, I_WEU, I_WED, I_LN2G, I_LN2B };

__device__ __forceinline__ float lo_part(float x) { return x - __builtin_bit_cast(float, f2bf(x) << 16); }
template <bool ROPEPERM, bool LO = false>
__device__ __forceinline__ void transpose_item(const float* W, int N, int k0, int n0, bf16_t* WT, int ldt, int drow0, LAS float* scr, int lane) {
    const int dc = ROPEPERM ? ((lane & 32) + 2 * (lane & 15) + ((lane >> 4) & 1)) : lane;
    float tv[64];
#pragma unroll
    for (int kk = 0; kk < 64; ++kk) tv[kk] = __builtin_nontemporal_load(W + (size_t)(k0 + kk) * N + n0 + lane);
#pragma unroll
    for (int kk = 0; kk < 64; ++kk) scr[kk * 65 + dc] = tv[kk];
    LDS_WAIT(); asm volatile("" ::: "memory");
    const int c = lane & 7;
#pragma unroll
    for (int j = 0; j < 8; ++j) { const int n = (lane >> 3) + 8 * j; const LAS float* s = scr + (8 * c) * 65 + n;
        u32x4 o;
        if (LO) { o.x = pk2(lo_part(s[0 * 65]), lo_part(s[1 * 65])); o.y = pk2(lo_part(s[2 * 65]), lo_part(s[3 * 65])); o.z = pk2(lo_part(s[4 * 65]), lo_part(s[5 * 65])); o.w = pk2(lo_part(s[6 * 65]), lo_part(s[7 * 65])); }
        else { o.x = pk2(s[0 * 65], s[1 * 65]); o.y = pk2(s[2 * 65], s[3 * 65]); o.z = pk2(s[4 * 65], s[5 * 65]); o.w = pk2(s[6 * 65], s[7 * 65]); }
        *(u32x4*)(WT + (size_t)(drow0 + n) * ldt + k0 + 8 * c) = o; }
    LDS_WAIT(); asm volatile("" ::: "memory");
}

__device__ __forceinline__ void convert_weights(Frame& F, int l, int gw, int NGW) {
    LAS float* scr = (LAS float*)(F.lds + F.wave * 16896);
    bf16_t* WIN = (bf16_t*)(F.ws + WS_WIN); bf16_t* WB = (bf16_t*)(F.ws + WS_WB); bf16_t* WOUT = (bf16_t*)(F.ws + WS_WOUT); bf16_t* G2T = (bf16_t*)(F.ws + WS_G2T);
    bf16_t* WE1 = (bf16_t*)(F.ws + WS_WE1); bf16_t* WE2 = (bf16_t*)(F.ws + WS_WE2); bf16_t* WLO = (bf16_t*)(F.ws + WS_WLO);
    const float* w_in = F.inp(I_WIN) + (size_t)l * DM * IN_COLS;
    const float* w_br = F.inp(I_WBR) + (size_t)l * MIXW * DM;
    const float* w_out = F.inp(I_WOUT) + (size_t)l * DM * DM;
    const float* g2 = F.inp(I_RWG2) + (size_t)l * 128 * 512;
    const float* weg = F.inp(I_WEG) + (size_t)l * NEXP * DM * FF;
    const float* weu = F.inp(I_WEU) + (size_t)l * NEXP * DM * FF;
    const float* wed = F.inp(I_WED) + (size_t)l * NEXP * FF * DM;
    constexpr int I_IN = 16 * 116, I_BR = 24 * 16, I_OUT = 16 * 16, I_G2 = 2 * 8, I_LO = 16 * 8, I_E1 = NEXP * 2 * 16 * 32, I_E2 = NEXP * 32 * 16;
    constexpr int NITEMS = I_IN + I_BR + I_OUT + I_G2 + I_LO + I_E1 + I_E2;
    for (int it = gw; it < NITEMS; it += NGW) {
        int r = it;
        if (r < I_IN) { const int kb = r / 116, nb = r % 116; if (nb < 16) transpose_item<true>(w_in, IN_COLS, 64 * kb, 64 * nb, WIN, DM, 64 * nb, scr, F.lane); else transpose_item<false>(w_in, IN_COLS, 64 * kb, 64 * nb, WIN, DM, 64 * nb, scr, F.lane); continue; } r -= I_IN;
        if (r < I_BR) { const int kb = r / 16, nb = r % 16; transpose_item<false>(w_br, DM, 64 * kb, 64 * nb, WB, MIXW, 64 * nb, scr, F.lane); continue; } r -= I_BR;
        if (r < I_OUT) { const int kb = r / 16, nb = r % 16; transpose_item<false>(w_out, DM, 64 * kb, 64 * nb, WOUT, DM, 64 * nb, scr, F.lane); continue; } r -= I_OUT;
        if (r < I_G2) { const int kb = r / 8, nb = r % 8; transpose_item<false>(g2, 512, 64 * kb, 64 * nb, G2T, 128, 64 * nb, scr, F.lane); continue; } r -= I_G2;
        if (r < I_LO) { const int kb = r / 8, nb = r % 8; if (SPLIT_K) transpose_item<false, true>(w_in, IN_COLS, 64 * kb, 2048 + 64 * nb, WLO, DM, 64 * nb, scr, F.lane); continue; } r -= I_LO;
        if (r < I_E1) { const int e = r / 1024, r2 = r % 1024, which = r2 / 512, r3 = r2 % 512, kb = r3 / 32, nb = r3 % 32; const int n0 = 64 * nb;
            const float* src = (which ? weu : weg) + (size_t)e * DM * FF; const int drow0 = e * 4096 + 256 * (n0 >> 7) + 128 * which + (n0 & 127);
            transpose_item<false>(src, FF, 64 * kb, n0, WE1, DM, drow0, scr, F.lane); continue; } r -= I_E1;
        { const int e = r / 512, r2 = r % 512, kb = r2 / 16, nb = r2 % 16; transpose_item<false>(wed + (size_t)e * FF * DM, DM, 64 * kb, 64 * nb, WE2, FF, e * 1024 + 64 * nb, scr, F.lane); }
    }
}

__device__ __forceinline__ void mod_partials(Frame& F) {
    LAS float* sl = (LAS float*)F.lds;
    float* MODP = (float*)(F.ws + R_MODP);
    for (int un = F.blk; un < 2 * 12 * 16; un += F.G) {
        const int l = un / 192, r = un % 192, cb = r / 16, kc = r % 16;
        __syncthreads();
        for (int i = F.tid; i < 17 * 64; i += 512) { const int rr = i >> 6, k = i & 63; const float cv = (rr < 16) ? F.inp(I_C)[rr * DM + kc * 64 + k] : F.inp(I_CCTX)[kc * 64 + k]; sl[i] = siluf_(cv); }
        __syncthreads();
        const int n = cb * 512 + F.tid; const float* w = F.inp(I_WMOD) + ((size_t)l * DM + kc * 64) * 6144 + n;
        float a[17];
#pragma unroll
        for (int rr = 0; rr < 17; ++rr) a[rr] = 0.f;
#pragma unroll 4
        for (int k = 0; k < 64; ++k) { const float wv = w[(size_t)k * 6144];
#pragma unroll
            for (int rr = 0; rr < 17; ++rr) a[rr] += sl[rr * 64 + k] * wv; }
#pragma unroll
        for (int rr = 0; rr < 17; ++rr) MODP[(((size_t)kc * 2 + l) * 17 + rr) * 6144 + n] = a[rr];
    }
    __syncthreads();
}
__device__ __forceinline__ void mod_reduce(Frame& F) {
    const float* MODP = (const float*)(F.ws + R_MODP); float* MODF = (float*)(F.ws + WS_MODF);
    for (int i = F.blk * 512 + F.tid; i < 2 * 17 * 6144; i += F.G * 512) { const int l = i / (17 * 6144), n = i % 6144;
        float s = F.inp(I_BMOD)[l * 6144 + n];
#pragma unroll
        for (int kc = 0; kc < 16; ++kc) s += MODP[(size_t)kc * 2 * 17 * 6144 + i];
        MODF[i] = s; }
}
__device__ __forceinline__ void small_tables(Frame& F) {
    if (F.blk == 0) {
        f32x2* rope = (f32x2*)(F.ws + WS_SMALL);
        for (int i = F.tid; i < 64 * 16; i += 512) { const int pos = i >> 4, j = i & 15; const float inv = powf(10000.0f, -(float)(2 * j) / 32.0f); const float ang = (float)pos * inv; rope[i] = (f32x2){cosf(ang), sinf(ang)}; }
    }
    if (F.blk == 1 && F.wave < 2) {
        const int l = F.wave; const float* dl = F.inp(I_DALAM) + l * 256;
        const float s01 = wave_sum(dl[F.lane] * dl[64 + F.lane]), s23 = wave_sum(dl[128 + F.lane] * dl[192 + F.lane]);
        const float lam_init = 0.8f - 0.6f * expf(-0.3f * (float)l);
        if (F.lane == 0) { float* sc = (float*)(F.ws + WS_SMALL + 16384); sc[2 * l] = expf(s01) - expf(s23) + lam_init; sc[2 * l + 1] = lam_init; }
    }
}

__device__ __forceinline__ const float* src_row(Frame& F, int row) { const int b = row / T_ALL, s = row - b * T_ALL; return s < T_CTX ? F.inp(I_CTX) + ((size_t)b * T_CTX + s) * DM : F.inp(I_X) + ((size_t)b * T_LAT + (s - T_CTX)) * DM; }
__device__ __forceinline__ const float* mod_row(Frame& F, int l, int row) { const int b = row / T_ALL, s = row - b * T_ALL; return (const float*)(F.ws + WS_MODF) + ((size_t)l * 17 + (s < T_CTX ? 16 : b)) * 6144; }
__device__ __forceinline__ void store_mod_bf16(bf16_t* dst, bf16_t* dlo, const f32x4 (&v)[4], const float* sh, const float* sc, int lane) {
#pragma unroll
    for (int j = 0; j < 4; ++j) { const int c = 4 * lane + 256 * j; const f32x4 s1 = *(const f32x4*)(sc + c), h1 = *(const f32x4*)(sh + c); const f32x4 o = v[j] * (1.0f + s1) + h1;
        u32x2 w; w.x = cvt_pk_bf16(o[0], o[1]); w.y = cvt_pk_bf16(o[2], o[3]); *(u32x2*)(dst + c) = w;
        if (SPLIT_K) { u32x2 l; l.x = cvt_pk_bf16(o[0] - bflo(w.x), o[1] - bfhi(w.x)); l.y = cvt_pk_bf16(o[2] - bflo(w.y), o[3] - bfhi(w.y)); *(u32x2*)(dlo + c) = l; } }
}
__device__ __forceinline__ void phase_h0(Frame& F) {
    bf16_t* H = (bf16_t*)(F.ws + WS_H); const int stride = F.G * 8;
    int row = F.blk * 8 + F.wave; f32x4 vn[4], vm[4];
#define H0_LD(dst, r_) do { if ((r_) < ROWS) { const float* src_ = src_row(F, (r_)); _Pragma("unroll") for (int j = 0; j < 4; ++j) dst[j] = *(const f32x4*)(src_ + 4 * F.lane + 256 * j); } } while (0)
    H0_LD(vn, row); H0_LD(vm, row + stride);
    for (; row < ROWS; row += stride) {
        f32x4 v[4];
#pragma unroll
        for (int j = 0; j < 4; ++j) { v[j] = vn[j]; vn[j] = vm[j]; }
        H0_LD(vm, row + 2 * stride);
        const float* md = mod_row(F, 0, row);
        store_mod_bf16(H + (size_t)row * DM, (bf16_t*)F.out + (size_t)row * DM, v, md, md + 1024, F.lane);
    }
#undef H0_LD
}
__device__ __forceinline__ void ln_row(f32x4 (&v)[4], const float* g, const float* bta, int lane) {
    float s = 0.f;
#pragma unroll
    for (int j = 0; j < 4; ++j) s += (v[j][0] + v[j][1]) + (v[j][2] + v[j][3]);
    const float mean = wave_sum(s) * (1.0f / DM); float q = 0.f;
#pragma unroll
    for (int j = 0; j < 4; ++j) { v[j] = v[j] - mean; q += (v[j][0] * v[j][0] + v[j][1] * v[j][1]) + (v[j][2] * v[j][2] + v[j][3] * v[j][3]); }
    const float rstd = 1.0f / sqrtf(wave_sum(q) * (1.0f / DM) + LN_EPS);
#pragma unroll
    for (int j = 0; j < 4; ++j) { const int c = 4 * lane + 256 * j; v[j] = v[j] * rstd * *(const f32x4*)(g + c) + *(const f32x4*)(bta + c); }
}
__device__ __forceinline__ void phase_ln1(Frame& F, int l, bool with_ctx) {
    LAS float* wrt = (LAS float*)F.lds;
    const float* wr = F.inp(I_WROUTER) + (size_t)l * DM * NEXP;
    __syncthreads();
    for (int i = F.tid; i < DM * NEXP; i += 512) { const int k = i >> 4, e = i & 15; wrt[e * DM + k] = wr[i]; }
    __syncthreads();
    float* X = (float*)(F.ws + WS_X); bf16_t* H = (bf16_t*)(F.ws + WS_H); float* AFF = (float*)(F.ws + WS_AFF);
    const float* g = F.inp(I_LN1G) + l * DM; const float* bt = F.inp(I_LN1B) + l * DM;
    const int stride = F.G * 8, nrows = with_ctx ? ROWS : NB * T_LAT; int it = F.blk * 8 + F.wave;
#define LN_ROW(i_) (with_ctx ? (i_) : ((i_) / T_LAT) * T_ALL + T_CTX + ((i_) % T_LAT))
#define LN_LD(dst, i_) do { if ((i_) < nrows) { const float* src_ = X + (size_t)LN_ROW(i_) * DM; _Pragma("unroll") for (int j = 0; j < 4; ++j) dst[j] = *(const f32x4*)(src_ + 4 * F.lane + 256 * j); } } while (0)
    f32x4 vn[4], vm[4];
    LN_LD(vn, it); LN_LD(vm, it + stride);
    for (; it < nrows; it += 2 * stride) {
        const bool hasB = it + stride < nrows;
        const int rowA = LN_ROW(it), rowB = hasB ? LN_ROW(it + stride) : rowA;
        f32x4 vA[4], vB[4];
#pragma unroll
        for (int j = 0; j < 4; ++j) { vA[j] = vn[j]; vB[j] = hasB ? vm[j] : vn[j]; }
        LN_LD(vn, it + 2 * stride); LN_LD(vm, it + 3 * stride);
        ln_row(vA, g, bt, F.lane); ln_row(vB, g, bt, F.lane);
        f32x2 hm2[4][4];
        { float* xa = X + (size_t)rowA * DM; float* xb = X + (size_t)rowB * DM; const float* mda = mod_row(F, l, rowA); const float* mdb = mod_row(F, l, rowB);
#pragma unroll
          for (int j = 0; j < 4; ++j) { const int c = 4 * F.lane + 256 * j;
              *(f32x4*)(xa + c) = vA[j]; if (hasB) *(f32x4*)(xb + c) = vB[j];
              const f32x4 ha = vA[j] * (1.0f + *(const f32x4*)(mda + 4096 + c)) + *(const f32x4*)(mda + 3072 + c), hb = vB[j] * (1.0f + *(const f32x4*)(mdb + 4096 + c)) + *(const f32x4*)(mdb + 3072 + c);
              u32x2 w; w.x = cvt_pk_bf16(ha[0], ha[1]); w.y = cvt_pk_bf16(ha[2], ha[3]); *(u32x2*)(H + (size_t)rowA * DM + c) = w;
              if (hasB) { w.x = cvt_pk_bf16(hb[0], hb[1]); w.y = cvt_pk_bf16(hb[2], hb[3]); *(u32x2*)(H + (size_t)rowB * DM + c) = w; }
#pragma unroll
              for (int i2 = 0; i2 < 4; ++i2) hm2[j][i2] = (f32x2){ha[i2], hb[i2]}; } }
        f32x2 pe[NEXP];
        int lz = F.lane; asm volatile("" : "+v"(lz));
#pragma unroll
        for (int e = 0; e < NEXP; ++e) { f32x2 p = (f32x2){0.f, 0.f};
#pragma unroll
            for (int j = 0; j < 4; ++j) { const f32x4 w4 = *(const LAS f32x4*)(wrt + e * DM + 4 * lz + 256 * j);
#pragma unroll
                for (int i2 = 0; i2 < 4; ++i2) p += hm2[j][i2] * w4[i2]; }
            pe[e] = p; }
        float v16[16], v8[8], v4[4], v2[2], lg;
        { const bool h = (F.lane & 32) != 0;
#pragma unroll
          for (int j = 0; j < 16; ++j) { const float send = h ? pe[j].x : pe[j].y, keep = h ? pe[j].y : pe[j].x; v16[j] = keep + __shfl_xor(send, 32); } }
        { const bool h = (F.lane & 16) != 0;
#pragma unroll
          for (int j = 0; j < 8; ++j) { const float send = h ? v16[j] : v16[8 + j], keep = h ? v16[8 + j] : v16[j]; v8[j] = keep + __shfl_xor(send, 16); } }
        { const bool h = (F.lane & 8) != 0;
#pragma unroll
          for (int j = 0; j < 4; ++j) { const float send = h ? v8[j] : v8[4 + j], keep = h ? v8[4 + j] : v8[j]; v4[j] = keep + __shfl_xor(send, 8); } }
        { const bool h = (F.lane & 4) != 0;
#pragma unroll
          for (int j = 0; j < 2; ++j) { const float send = h ? v4[j] : v4[2 + j], keep = h ? v4[2 + j] : v4[j]; v2[j] = keep + __shfl_xor(send, 4); } }
        { const bool h = (F.lane & 2) != 0; const float send = h ? v2[0] : v2[1], keep = h ? v2[1] : v2[0]; lg = keep + __shfl_xor(send, 2); }
        lg += __shfl_xor(lg, 1);
        float mx = lg; mx = fmaxf(mx, __shfl_xor(mx, 2)); mx = fmaxf(mx, __shfl_xor(mx, 4)); mx = fmaxf(mx, __shfl_xor(mx, 8)); mx = fmaxf(mx, __shfl_xor(mx, 16));
        const float ex = expf(lg - mx); float den = ex;
        den += __shfl_xor(den, 2); den += __shfl_xor(den, 4); den += __shfl_xor(den, 8); den += __shfl_xor(den, 16);
        if ((F.lane & 1) == 0 && (F.lane < 32 || hasB)) AFF[(size_t)(F.lane < 32 ? rowA : rowB) * NEXP + ((F.lane >> 1) & 15)] = ex / den;
    }
#undef LN_LD
}

__device__ __forceinline__ void phase_topk(Frame& F, bool with_ctx) {
    LAS unsigned* cnt_sm = (LAS unsigned*)F.lds;
    LAS int* tok_sm = (LAS int*)(F.lds + 1024);
    const float* AFF = (const float*)(F.ws + WS_AFF); short* SLOT = (short*)(F.ws + WS_SLOT); float* GATEE = (float*)(F.ws + WS_GATEE);
    const bf16_t* H = (const bf16_t*)(F.ws + WS_H); bf16_t* XE = (bf16_t*)(F.ws + R_XE);
    const int nun = with_ctx ? 512 : 256;
    for (int un = F.blk; un < nun; un += F.G) {
        const int isc = un >> 8, b = (un >> 4) & 15, e = un & 15;
        const int Tn = isc ? T_CTX : T_LAT, cap = isc ? CAP_C : CAP_L; const int row0 = b * T_ALL + (isc ? 0 : T_CTX);
        unsigned key[4];
#pragma unroll
        for (int i = 0; i < 4; ++i) { const int t = 4 * F.tid + i; key[i] = (t < Tn) ? __builtin_bit_cast(unsigned, AFF[(size_t)(row0 + t) * NEXP + e]) : 0u; }
        unsigned v = 0u;
        for (int bit = 30; bit >= 0; --bit) {
            const unsigned tr = v | (1u << bit);
            int c = (key[0] >= tr) + (key[1] >= tr) + (key[2] >= tr) + (key[3] >= tr);
#pragma unroll
            for (int o = 1; o < 64; o <<= 1) c += __shfl_xor(c, o);
            LAS unsigned* slot = cnt_sm + (bit & 1) * 8;
            if (F.lane == 0) slot[F.wave] = (unsigned)c;
            __syncthreads();
            unsigned tot = 0;
#pragma unroll
            for (int w = 0; w < 8; ++w) tot += slot[w];
            if (tot >= (unsigned)cap) v = tr;
        }
        __syncthreads();
        const int eq = (key[0] == v) + (key[1] == v) + (key[2] == v) + (key[3] == v);
        const int gt = (key[0] > v) + (key[1] > v) + (key[2] > v) + (key[3] > v);
        int incl_eq = eq, incl_gt = gt;
#pragma unroll
        for (int o = 1; o < 64; o <<= 1) { const int a = __shfl_up(incl_eq, o), g2 = __shfl_up(incl_gt, o); if (F.lane >= o) { incl_eq += a; incl_gt += g2; } }
        if (F.lane == 63) { cnt_sm[16 + F.wave] = (unsigned)incl_eq; cnt_sm[24 + F.wave] = (unsigned)incl_gt; }
        __syncthreads();
        int base_eq = 0, base_gt = 0, tot_gt = 0;
#pragma unroll
        for (int w = 0; w < 8; ++w) { const int a = (int)cnt_sm[16 + w], g2 = (int)cnt_sm[24 + w]; if (w < F.wave) { base_eq += a; base_gt += g2; } tot_gt += g2; }
        const int need_eq = cap - tot_gt;
        int eq_before = base_eq + incl_eq - eq, gt_before = base_gt + incl_gt - gt;
#pragma unroll
        for (int i = 0; i < 4; ++i) { const int t = 4 * F.tid + i;
            const bool is_gt = key[i] > v, is_eq = key[i] == v; const bool sel = (t < Tn) && (is_gt || (is_eq && eq_before < need_eq));
            const int slot = gt_before + (eq_before < need_eq ? eq_before : need_eq);
            if (t < Tn) SLOT[(size_t)(row0 + t) * NEXP + e] = sel ? (short)slot : (short)-1;
            if (sel) { tok_sm[slot] = t; GATEE[(size_t)e * EROWS + (isc ? NB * CAP_L + b * CAP_C : b * CAP_L) + slot] = __builtin_bit_cast(float, key[i]); }
            gt_before += is_gt; eq_before += is_eq; }
        __syncthreads();
        const size_t xbase = (size_t)e * EROWS + (isc ? NB * CAP_L + b * CAP_C : b * CAP_L);
        for (int sl = F.wave; sl < cap; sl += 32) {
            u32x4 ra[4], rb[4];
#pragma unroll
            for (int q = 0; q < 4; ++q) { const int t = tok_sm[sl + 8 * q]; const u32x4* src = (const u32x4*)(H + (size_t)(row0 + t) * DM); ra[q] = src[F.lane]; rb[q] = src[64 + F.lane]; }
#pragma unroll
            for (int q = 0; q < 4; ++q) { u32x4* dst = (u32x4*)(XE + (xbase + sl + 8 * q) * DM); dst[F.lane] = ra[q]; dst[64 + F.lane] = rb[q]; } }
        __syncthreads();
    }
}

__device__ __forceinline__ void phase_ln2(Frame& F, int l, bool with_ctx, bool last) {
    float* X = (float*)(F.ws + WS_X); bf16_t* H = (bf16_t*)(F.ws + WS_H); const short* SLOT = (const short*)(F.ws + WS_SLOT); const bf16_t* YE = (const bf16_t*)(F.ws + R_YE);
    const float* g = F.inp(I_LN2G) + l * DM; const float* bt = F.inp(I_LN2B) + l * DM;
    const int stride = F.G * 8, nrows = with_ctx ? ROWS : NB * T_LAT; int it = F.blk * 8 + F.wave;
#define LN2_LD(dst, sl_, i_) do { if ((i_) < nrows) { const int r_ = LN_ROW(i_); sl_ = (F.lane < NEXP) ? (int)SLOT[(size_t)r_ * NEXP + F.lane] : -1; const float* src_ = X + (size_t)r_ * DM; \
        _Pragma("unroll") for (int j = 0; j < 4; ++j) dst[j] = *(const f32x4*)(src_ + 4 * F.lane + 256 * j); } } while (0)
    f32x4 xn[4], xm[4]; int slotn = -1, slotm = -1;
    LN2_LD(xn, slotn, it); LN2_LD(xm, slotm, it + stride);
    for (; it < nrows; it += stride) {
        const int row = LN_ROW(it);
        const int b = row / T_ALL, s = row - b * T_ALL; const bool isc = s < T_CTX;
        const float* md = mod_row(F, l, row);
        f32x4 xc[4]; const int myslot = slotn;
#pragma unroll
        for (int j = 0; j < 4; ++j) { xc[j] = xn[j]; xn[j] = xm[j]; }
        slotn = slotm;
        LN2_LD(xm, slotm, it + 2 * stride);
        f32x4 f[4];
#pragma unroll
        for (int j = 0; j < 4; ++j) f[j] = (f32x4){0.f, 0.f, 0.f, 0.f};
        { unsigned msk = (unsigned)(__builtin_amdgcn_ballot_w64(myslot >= 0) & 0xFFFFull); const size_t ebase = (size_t)(isc ? NB * CAP_L + b * CAP_C : b * CAP_L);
#pragma unroll 1
          while (msk) {
              u32x2 wv[4][4];
#pragma unroll
              for (int k = 0; k < 4; ++k)
#pragma unroll
                  for (int j = 0; j < 4; ++j) wv[k][j] = (u32x2){0u, 0u};
#pragma unroll
              for (int k = 0; k < 4; ++k) { if (msk) { const int e = __builtin_ctz(msk); msk &= msk - 1; const int sl = __builtin_amdgcn_readlane(myslot, e);
                      const bf16_t* yr = YE + ((size_t)e * EROWS + ebase + sl) * DM;
#pragma unroll
                      for (int j = 0; j < 4; ++j) wv[k][j] = *(const u32x2*)(yr + 4 * F.lane + 256 * j); } }
#pragma unroll
              for (int k = 0; k < 4; ++k)
#pragma unroll
                  for (int j = 0; j < 4; ++j) f[j] += (f32x4){bflo(wv[k][j].x), bfhi(wv[k][j].x), bflo(wv[k][j].y), bfhi(wv[k][j].y)}; } }
        f32x4 v[4];
#pragma unroll
        for (int j = 0; j < 4; ++j) { const int c = 4 * F.lane + 256 * j; v[j] = DN_ALPHA * xc[j] + *(const f32x4*)(md + 5120 + c) * f[j]; }
        ln_row(v, g, bt, F.lane);
        if (last) {
            float* o = F.out + ((size_t)b * T_LAT + (s - T_CTX)) * DM;
#pragma unroll
            for (int j = 0; j < 4; ++j) *(f32x4*)(o + 4 * F.lane + 256 * j) = v[j];
        } else {
#pragma unroll
            for (int j = 0; j < 4; ++j) *(f32x4*)(X + (size_t)row * DM + 4 * F.lane + 256 * j) = v[j];
            const float* md1 = mod_row(F, l + 1, row);
            store_mod_bf16(H + (size_t)row * DM, (bf16_t*)F.out + (size_t)row * DM, v, md1, md1 + 1024, F.lane);
        }
    }
#undef LN2_LD
#undef LN_ROW
}
#ifdef PROBE_O1ONLY
#define PROBE_LAM(x) 0.0f
#else
#define PROBE_LAM(x) (x)
#endif
constexpr int AT_KS = 136, AT_VS = 72;
constexpr int AT_KB = 64 * AT_KS * 2, AT_VB = 128 * AT_VS * 2;
constexpr int AT_EX = 0, AT_STG = 65536, AT_SSTR = 132;
__device__ __forceinline__ void attn_unit(Frame& F, const bf16_t* Qb, const bf16_t* Kb, const bf16_t* Vt, bf16_t* Yall, const float* norm_g, float lam, float lam_init,
                                          int b, int h, int qrow0, int krow0, int nkt) {
    const int tid = F.tid, lane = F.lane, wave = F.wave, r32 = lane & 31, hi = lane >> 5, map = wave >> 2, qs = wave & 3;
    LAS unsigned char* lds = F.lds;
    const bf16_t* kg = Kb + (size_t)(krow0 + (tid >> 3)) * 512 + h * 128 + 16 * (tid & 7);
    const bf16_t* vg = Vt + ((size_t)(b * 4 + h) * 128 + (tid >> 2)) * T_ALL + 16 * (tid & 3);
    const int kst = ((tid >> 3) * AT_KS + 16 * (tid & 7)) * 2, vst = ((tid >> 2) * AT_VS + 16 * (tid & 3)) * 2;
    u32x4 kr0, kr1, vr0, vr1;
    kr0 = *(const u32x4*)kg; kr1 = *(const u32x4*)(kg + 8); vr0 = *(const u32x4*)vg; vr1 = *(const u32x4*)(vg + 8);
    bf16x8 qf[4];
    { const bf16_t* qp = Qb + (size_t)(qrow0 + qs * 32 + r32) * 512 + h * 128 + map * 64 + 8 * hi;
#pragma unroll
      for (int ks = 0; ks < 4; ++ks) qf[ks] = *(const bf16x8*)(qp + 16 * ks); }
    *(LAS u32x4*)(lds + kst) = kr0; *(LAS u32x4*)(lds + kst + 16) = kr1;
    *(LAS u32x4*)(lds + 2 * AT_KB + vst) = vr0; *(LAS u32x4*)(lds + 2 * AT_KB + vst + 16) = vr1;
    __syncthreads();
    f32x16 o[4];
#pragma unroll
    for (int d = 0; d < 4; ++d)
#pragma unroll
        for (int r = 0; r < 16; ++r) o[d][r] = 0.f;
    float m_run = -INFINITY, l_run = 0.f;
    const int koff = (r32 * AT_KS + map * 64 + 8 * hi) * 2, voff = (r32 * AT_VS + 8 * hi) * 2;
    for (int kt = 0; kt < nkt; ++kt) {
        const int buf = kt & 1;
        if (kt + 1 < nkt) { const bf16_t* kn = kg + (size_t)(kt + 1) * 64 * 512; const bf16_t* vn = vg + (kt + 1) * 64;
            kr0 = *(const u32x4*)kn; kr1 = *(const u32x4*)(kn + 8); vr0 = *(const u32x4*)vn; vr1 = *(const u32x4*)(vn + 8); }
        LAS unsigned char* kb = lds + buf * AT_KB + koff; LAS unsigned char* vb = lds + 2 * AT_KB + buf * AT_VB + voff;
        f32x16 p0, p1;
#pragma unroll
        for (int r = 0; r < 16; ++r) { p0[r] = 0.f; p1[r] = 0.f; }
#pragma unroll
        for (int ks = 0; ks < 4; ++ks) { const bf16x8 ka = *(const LAS bf16x8*)(kb + 32 * ks), kc = *(const LAS bf16x8*)(kb + 32 * AT_KS * 2 + 32 * ks);
            p0 = __builtin_amdgcn_mfma_f32_32x32x16_bf16(ka, qf[ks], p0, 0, 0, 0); p1 = __builtin_amdgcn_mfma_f32_32x32x16_bf16(kc, qf[ks], p1, 0, 0, 0); }
        float rm = fmaxf(p0[0], p1[0]);
#pragma unroll
        for (int r = 1; r < 16; ++r) rm = fmaxf(rm, fmaxf(p0[r], p1[r]));
        rm = xhalf_max(rm);
        if (__builtin_amdgcn_ballot_w64(rm > m_run) != 0ull) {
            const float mn = fmaxf(m_run, rm), alpha = fast_exp2(m_run - mn);
            l_run *= alpha; m_run = mn;
#pragma unroll
            for (int d = 0; d < 4; ++d)
#pragma unroll
                for (int r = 0; r < 16; ++r) o[d][r] *= alpha;
        }
        float ls = 0.f;
#pragma unroll
        for (int r = 0; r < 16; ++r) { p0[r] = fast_exp2(p0[r] - m_run); p1[r] = fast_exp2(p1[r] - m_run); ls += p0[r] + p1[r]; }
        l_run += ls;
        u32x4 pw[4];
#pragma unroll
        for (int s2 = 0; s2 < 2; ++s2) {
            pw[s2] = (u32x4){cvt_pk_bf16(p0[8 * s2 + 0], p0[8 * s2 + 1]), cvt_pk_bf16(p0[8 * s2 + 2], p0[8 * s2 + 3]), cvt_pk_bf16(p0[8 * s2 + 4], p0[8 * s2 + 5]), cvt_pk_bf16(p0[8 * s2 + 6], p0[8 * s2 + 7])};
            pw[2 + s2] = (u32x4){cvt_pk_bf16(p1[8 * s2 + 0], p1[8 * s2 + 1]), cvt_pk_bf16(p1[8 * s2 + 2], p1[8 * s2 + 3]), cvt_pk_bf16(p1[8 * s2 + 4], p1[8 * s2 + 5]), cvt_pk_bf16(p1[8 * s2 + 6], p1[8 * s2 + 7])}; }
#pragma unroll
        for (int d = 0; d < 4; ++d)
#pragma unroll
            for (int s = 0; s < 4; ++s) { const bf16x8 va = *(const LAS bf16x8*)(vb + d * 32 * AT_VS * 2 + 32 * s);
                o[d] = __builtin_amdgcn_mfma_f32_32x32x16_bf16(va, __builtin_bit_cast(bf16x8, pw[s]), o[d], 0, 0, 0); }
        if (kt + 1 < nkt) { const int nb = buf ^ 1;
            *(LAS u32x4*)(lds + nb * AT_KB + kst) = kr0; *(LAS u32x4*)(lds + nb * AT_KB + kst + 16) = kr1;
            *(LAS u32x4*)(lds + 2 * AT_KB + nb * AT_VB + vst) = vr0; *(LAS u32x4*)(lds + 2 * AT_KB + nb * AT_VB + vst + 16) = vr1; }
        __syncthreads();
    }
    { const float inv = 1.0f / xhalf_sum(l_run);
#pragma unroll
      for (int d = 0; d < 4; ++d)
#pragma unroll
          for (int r = 0; r < 16; ++r) o[d][r] *= inv; }
    LAS float* ex = (LAS float*)(lds + AT_EX);
    if (map == 1) {
#pragma unroll
        for (int d = 0; d < 4; ++d)
#pragma unroll
            for (int r = 0; r < 16; ++r) ex[((qs * 64) + d * 16 + r) * 64 + lane] = o[d][r];
    }
    __syncthreads();
    if (map == 0) {
        float ss = 0.f;
#pragma unroll
        for (int d = 0; d < 4; ++d)
#pragma unroll
            for (int r = 0; r < 16; ++r) { const float v = o[d][r] - PROBE_LAM(lam) * ex[((qs * 64) + d * 16 + r) * 64 + lane]; o[d][r] = v; ss += v * v; }
        ss = xhalf_sum(ss);
        float sc = (1.0f / sqrtf(ss * (1.0f / 128.0f) + DA_EPS)) * (1.0f - lam_init);
#ifdef PROBE_O1ONLY
        sc = 16.0f;
#endif
        LAS bf16_t* stg = (LAS bf16_t*)(lds + AT_STG) + qs * 32 * AT_SSTR;
#pragma unroll
        for (int d = 0; d < 4; ++d)
#pragma unroll
            for (int g4 = 0; g4 < 4; ++g4) { const int dim = 32 * d + 8 * g4 + 4 * hi; const f32x4 ng = *(const f32x4*)(norm_g + dim);
                u32x2 w; w.x = cvt_pk_bf16(o[d][4 * g4] * sc * ng[0], o[d][4 * g4 + 1] * sc * ng[1]); w.y = cvt_pk_bf16(o[d][4 * g4 + 2] * sc * ng[2], o[d][4 * g4 + 3] * sc * ng[3]);
                *(LAS u32x2*)(stg + r32 * AT_SSTR + dim) = w; }
        LDS_WAIT();
#pragma unroll
        for (int it = 0; it < 8; ++it) { const int row = it * 4 + (lane >> 4), ch = lane & 15;
            const u32x2 a = *(const LAS u32x2*)(stg + row * AT_SSTR + ch * 8), c = *(const LAS u32x2*)(stg + row * AT_SSTR + ch * 8 + 4);
            *(u32x4*)(Yall + (size_t)(qrow0 + qs * 32 + row) * MIXW + h * 128 + ch * 8) = (u32x4){a.x, a.y, c.x, c.y}; }
    }
    __syncthreads();
}
__device__ __forceinline__ void phase_attn(Frame& F, int l, bool with_ctx) {
    const bf16_t* Qb = (const bf16_t*)(F.ws + R_Q); const bf16_t* Kb = (const bf16_t*)(F.ws + R_K); const bf16_t* Vt = (const bf16_t*)(F.ws + R_VT); bf16_t* Yall = (bf16_t*)F.out;
    const float* sc = (const float*)(F.ws + WS_SMALL + 16384); const float lam = sc[2 * l], lam_init = sc[2 * l + 1];
    const float* ng = F.inp(I_DANG) + l * 128;
    const int nun = 1024 + (with_ctx ? 128 : 0);
    for (int un = F.blk; un < nun; un += F.G) {
        if (un < 1024) { const int b = un >> 6, h = (un >> 4) & 3, qb = un & 15;
#ifdef PROBE_SKIPCTX_L1
            if (l == 1) attn_unit(F, Qb, Kb, Vt + T_CTX, Yall, ng, lam, lam_init, b, h, b * T_ALL + T_CTX + qb * 128, b * T_ALL + T_CTX, 32); else
#endif
            attn_unit(F, Qb, Kb, Vt, Yall, ng, lam, lam_init, b, h, b * T_ALL + T_CTX + qb * 128, b * T_ALL, 36);
        } else { const int u2 = un - 1024; const int b = u2 >> 3, h = (u2 >> 1) & 3, qb = u2 & 1;
            attn_unit(F, Qb, Kb, Vt, Yall, ng, lam, lam_init, b, h, b * T_ALL + qb * 128, b * T_ALL, 4); }
    }
}

constexpr int RW_CH = 32;
constexpr int RWL_FEAT = 0, RWL_XW = 49152, RWL_XA = 57856, RWL_PW = 66560, RWL_PA = 74752, RWL_YB = 82944;
__device__ __forceinline__ f32x4 ld_bf4(const bf16_t* p) { const u32x2 w = *(const u32x2*)p; return (f32x4){bflo(w.x), bfhi(w.x), bflo(w.y), bfhi(w.y)}; }
__device__ __forceinline__ f32x4 shift4(const bf16_t* cur, bool hp, bool hn, const float* mu0, const float* mu1) {
    const f32x4 p = ld_bf4(cur); const f32x4 pv = hp ? ld_bf4(cur - RW_COLS) : (f32x4){0.f, 0.f, 0.f, 0.f}; const f32x4 nx = hn ? ld_bf4(cur + RW_COLS) : (f32x4){0.f, 0.f, 0.f, 0.f};
    return p + *(const f32x4*)mu0 * (pv - p) + *(const f32x4*)mu1 * (nx - p);
}
__device__ __forceinline__ void rwkv_scan_unit(Frame& F, int l, int b, int hd, int z, bool emit_ctx) {
    const int tid = F.tid, lane = F.lane, wave = F.wave;
    LAS float* FEAT = (LAS float*)(F.lds + RWL_FEAT); LAS float* XW = (LAS float*)(F.lds + RWL_XW); LAS float* XA = (LAS float*)(F.lds + RWL_XA);
    LAS float* PW = (LAS float*)(F.lds + RWL_PW); LAS float* PA = (LAS float*)(F.lds + RWL_PA); LAS float* YB = (LAS float*)(F.lds + RWL_YB);
    const bf16_t* PRW = (const bf16_t*)(F.ws + R_PRW); const bf16_t* KLO = (const bf16_t*)(F.ws + R_KLO); float* Y = (float*)(F.ws + R_YFB) + (size_t)z * ROWS * 512; float* BON = (float*)(F.ws + WS_BONUS) + (size_t)z * ROWS * 8;
    const float* mu = F.inp(I_RWMU) + (size_t)l * 2 * RW_COLS; const float* mu0 = mu, *mu1 = mu + RW_COLS;
    const float* w0 = F.inp(I_RWW0) + ((size_t)l * 2 + z) * 512 + hd * 64; const float* a0 = F.inp(I_RWA0) + ((size_t)l * 2 + z) * 512 + hd * 64;
    const float* w2 = F.inp(I_RWW2) + ((size_t)l * 2 + z) * 64 * 512; const float* a2 = F.inp(I_RWA2) + ((size_t)l * 2 + z) * 64 * 512;
    const float* k_k = F.inp(I_RWKK) + l * 512 + hd * 64; const float* k_a = F.inp(I_RWKA) + l * 512 + hd * 64; const float* r_k = F.inp(I_RWRK) + l * 512 + hd * 64;
    float breg[16];
    { const float* src = (wave < 4 ? w2 : a2) + hd * 64 + 16 * (wave & 3) + (lane & 15);
#pragma unroll
      for (int ks = 0; ks < 16; ++ks) breg[ks] = src[(size_t)(4 * ks + (lane >> 4)) * 512]; }
    const int tt = tid >> 4, jq = tid & 15, j4 = 4 * jq;
    const f32x4 w0c = *(const f32x4*)(w0 + j4), a0c = *(const f32x4*)(a0 + j4), kkc = *(const f32x4*)(k_k + j4), kac = *(const f32x4*)(k_a + j4), rkc = *(const f32x4*)(r_k + j4);
    f32x4 S0 = (f32x4){0.f, 0.f, 0.f, 0.f}, S1 = S0;
    u32x2 raw[5][3];
#define RW_CHUNK_GEOM(ci_) const bool isc_ = (ci_) < 8; const int cc_ = isc_ ? (z ? 7 - (ci_) : (ci_)) : (z ? 63 - ((ci_) - 8) : ((ci_) - 8)); \
        const int len_ = isc_ ? T_CTX : T_LAT; const int rb_ = b * T_ALL + (isc_ ? 0 : T_CTX); const int t_ = cc_ * RW_CH + tt;
#define RW_LOADRAW(ci_) do { RW_CHUNK_GEOM(ci_) const int tp_ = t_ > 0 ? t_ - 1 : t_, tn_ = t_ < len_ - 1 ? t_ + 1 : t_; \
        const bf16_t* pc_ = PRW + (size_t)(rb_ + t_) * RW_COLS; const bf16_t* pp_ = PRW + (size_t)(rb_ + tp_) * RW_COLS; const bf16_t* pn_ = PRW + (size_t)(rb_ + tn_) * RW_COLS; \
        const int cg_[5] = {hd * 64 + j4, 512 + hd * 64 + j4, 1024 + hd * 64 + j4, 1536 + j4, 1600 + j4}; \
        _Pragma("unroll") for (int g_ = 0; g_ < 5; ++g_) { raw[g_][0] = *(const u32x2*)(pp_ + cg_[g_]); raw[g_][1] = *(const u32x2*)(pc_ + cg_[g_]); raw[g_][2] = *(const u32x2*)(pn_ + cg_[g_]); } } while (0)
    RW_LOADRAW(0);
    for (int ci = 0; ci < 72; ++ci) {
        const bool isc = ci < 8; const int cc = isc ? (z ? 7 - ci : ci) : (z ? 63 - (ci - 8) : (ci - 8));
        const int len = isc ? T_CTX : T_LAT; const int rb = b * T_ALL + (isc ? 0 : T_CTX); const int t0 = cc * RW_CH;
        const int t = t0 + tt; const float fp = t > 0 ? 1.f : 0.f, fn = t < len - 1 ? 1.f : 0.f;
        f32x4 sh[5];
        { const int cg[5] = {hd * 64 + j4, 512 + hd * 64 + j4, 1024 + hd * 64 + j4, 1536 + j4, 1600 + j4};
#pragma unroll
          for (int g = 0; g < 5; ++g) { const f32x4 pv = (f32x4){bflo(raw[g][0].x), bfhi(raw[g][0].x), bflo(raw[g][0].y), bfhi(raw[g][0].y)} * fp;
              const f32x4 p = (f32x4){bflo(raw[g][1].x), bfhi(raw[g][1].x), bflo(raw[g][1].y), bfhi(raw[g][1].y)};
              const f32x4 nx = (f32x4){bflo(raw[g][2].x), bfhi(raw[g][2].x), bflo(raw[g][2].y), bfhi(raw[g][2].y)} * fn;
              sh[g] = p + *(const f32x4*)(mu0 + cg[g]) * (pv - p) + *(const f32x4*)(mu1 + cg[g]) * (nx - p); } }
        const f32x4 r4 = sh[0], k4 = sh[1], v4 = sh[2];
        *(LAS f32x4*)(XW + tt * 68 + j4) = (f32x4){tanhf_(sh[3][0]), tanhf_(sh[3][1]), tanhf_(sh[3][2]), tanhf_(sh[3][3])}; *(LAS f32x4*)(XA + tt * 68 + j4) = sh[4];
        if (ci + 1 < 72) RW_LOADRAW(ci + 1);
        __syncthreads();
        { const LAS float* Xs = (wave < 4) ? XW : XA; LAS float* Ps = (wave < 4) ? PW : PA;
#pragma unroll
          for (int mt = 0; mt < 2; ++mt) { f32x4 acc = (f32x4){0.f, 0.f, 0.f, 0.f}, acc2 = acc;
#pragma unroll
              for (int ks = 0; ks < 16; ks += 2) { acc = __builtin_amdgcn_mfma_f32_16x16x4f32(Xs[(mt * 16 + (lane & 15)) * 68 + 4 * ks + (lane >> 4)], breg[ks], acc, 0, 0, 0);
                  acc2 = __builtin_amdgcn_mfma_f32_16x16x4f32(Xs[(mt * 16 + (lane & 15)) * 68 + 4 * (ks + 1) + (lane >> 4)], breg[ks + 1], acc2, 0, 0, 0); }
              acc += acc2;
#pragma unroll
              for (int rg = 0; rg < 4; ++rg) Ps[(mt * 16 + 4 * (lane >> 4) + rg) * 64 + 16 * (wave & 3) + (lane & 15)] = acc[rg]; } }
        __syncthreads();
        { const f32x4 pw = *(const LAS f32x4*)(PW + tt * 64 + j4) + w0c, pa = *(const LAS f32x4*)(PA + tt * 64 + j4) + a0c;
          f32x4 dec, av, kkr, kd, bb; float ss = 0.f, bo = 0.f;
#pragma unroll
          for (int i = 0; i < 4; ++i) { dec[i] = __expf(-0.6065306597126334f * sigmoidf_(pw[i])); av[i] = sigmoidf_(pa[i]); kkr[i] = k4[i] * kkc[i]; ss += kkr[i] * kkr[i];
              kd[i] = k4[i] * (1.0f + (av[i] - 1.0f) * kac[i]); bo += r4[i] * kd[i] * rkc[i]; }
          ss = sum16(ss); bo = sum16(bo);
          const float inv = 1.0f / fmaxf(sqrtf(ss), 1e-12f);
#pragma unroll
          for (int i = 0; i < 4; ++i) { kkr[i] *= inv; bb[i] = kkr[i] * av[i]; }
          *(LAS f32x4*)(FEAT + (0 * 32 + tt) * 64 + j4) = kkr; *(LAS f32x4*)(FEAT + (1 * 32 + tt) * 64 + j4) = dec; *(LAS f32x4*)(FEAT + (2 * 32 + tt) * 64 + j4) = bb;
          *(LAS f32x4*)(FEAT + (3 * 32 + tt) * 64 + j4) = kd; *(LAS f32x4*)(FEAT + (4 * 32 + tt) * 64 + j4) = r4; *(LAS f32x4*)(FEAT + (5 * 32 + tt) * 64 + j4) = v4;
          if (jq == 0) BON[(size_t)(rb + t) * 8 + hd] = bo; }
        __syncthreads();
        { const int ri = tid >> 3, c8 = 8 * (tid & 7);
#define RW_LOADF(ts_) kkA = *(const LAS f32x4*)(FEAT + (0 * 32 + (ts_)) * 64 + c8); kkB = *(const LAS f32x4*)(FEAT + (0 * 32 + (ts_)) * 64 + c8 + 4); \
          wdA = *(const LAS f32x4*)(FEAT + (1 * 32 + (ts_)) * 64 + c8); wdB = *(const LAS f32x4*)(FEAT + (1 * 32 + (ts_)) * 64 + c8 + 4); \
          bbA = *(const LAS f32x4*)(FEAT + (2 * 32 + (ts_)) * 64 + c8); bbB = *(const LAS f32x4*)(FEAT + (2 * 32 + (ts_)) * 64 + c8 + 4); \
          kdA = *(const LAS f32x4*)(FEAT + (3 * 32 + (ts_)) * 64 + c8); kdB = *(const LAS f32x4*)(FEAT + (3 * 32 + (ts_)) * 64 + c8 + 4); \
          rrA = *(const LAS f32x4*)(FEAT + (4 * 32 + (ts_)) * 64 + c8); rrB = *(const LAS f32x4*)(FEAT + (4 * 32 + (ts_)) * 64 + c8 + 4); vv = FEAT[(5 * 32 + (ts_)) * 64 + ri];
          f32x4 kkA, kkB, wdA, wdB, bbA, bbB, kdA, kdB, rrA, rrB; float vv;
#ifdef PROBE_REPLOOP
          const f32x4 S0s = S0, S1s = S1;
#pragma unroll 1
          for (int rep2 = 0; rep2 < 2; ++rep2) { S0 = S0s; S1 = S1s;
#endif
          { const int ts0 = z ? (RW_CH - 1) : 0; RW_LOADF(ts0) }
#pragma unroll 2
          for (int st = 0; st < RW_CH; ++st) { const int ts = z ? (RW_CH - 1 - st) : st; const int tn = (st + 1 < RW_CH) ? (z ? ts - 1 : ts + 1) : ts;
            const f32x4 ckA = kkA, ckB = kkB, cwA = wdA, cwB = wdB, cbA = bbA, cbB = bbB, cdA = kdA, cdB = kdB, crA = rrA, crB = rrB; const float cv = vv;
            RW_LOADF(tn)
            float sa = -(((S0[0] * ckA[0] + S0[1] * ckA[1]) + (S0[2] * ckA[2] + S0[3] * ckA[3])) + ((S1[0] * ckB[0] + S1[1] * ckB[1]) + (S1[2] * ckB[2] + S1[3] * ckB[3])));
            sa = sum8(sa);
            S0 = S0 * cwA + sa * cbA + cv * cdA; S1 = S1 * cwB + sa * cbB + cv * cdB;
            float y = ((S0[0] * crA[0] + S0[1] * crA[1]) + (S0[2] * crA[2] + S0[3] * crA[3])) + ((S1[0] * crB[0] + S1[1] * crB[1]) + (S1[2] * crB[2] + S1[3] * crB[3]));
            y = sum8(y);
            if ((tid & 7) == 0) YB[ts * 64 + ri] = y; }
#ifdef PROBE_REPLOOP
          }
#endif
#undef RW_LOADF
        }
        __syncthreads();
        if (!isc || emit_ctx) *(f32x4*)(Y + (size_t)(rb + t) * 512 + hd * 64 + j4) = *(const LAS f32x4*)(YB + tt * 64 + j4);
    }
    __syncthreads();
}

constexpr int RW2_FEAT = 0  , RW2_XW = 98304, RW2_XA = 107008, RW2_PW = 115712, RW2_PA = 123904, RW2_YB = 132096  , RW2_CT = 148480  ;
__device__ __forceinline__ void rwkv_scan_unit2(Frame& F, int l, int b, int hd, int z, bool emit_ctx) {
    const int tid = F.tid, wave = F.wave;
    LAS float* FEAT0 = (LAS float*)(F.lds + RW2_FEAT); LAS float* XW = (LAS float*)(F.lds + RW2_XW); LAS float* XA = (LAS float*)(F.lds + RW2_XA);
    LAS float* PW = (LAS float*)(F.lds + RW2_PW); LAS float* PA = (LAS float*)(F.lds + RW2_PA); LAS float* YB0 = (LAS float*)(F.lds + RW2_YB);
    const bf16_t* PRW = (const bf16_t*)(F.ws + R_PRW); float* Y = (float*)(F.ws + R_YFB) + (size_t)z * ROWS * 512; float* BON = (float*)(F.ws + WS_BONUS) + (size_t)z * ROWS * 8;
#define RW2_GEOM(ci_, cc_, len_, rb_) const bool isc_##cc_ = (ci_) < 8; const int cc_ = isc_##cc_ ? (z ? 7 - (ci_) : (ci_)) : (z ? 63 - ((ci_) - 8) : ((ci_) - 8)); \
        const int len_ = isc_##cc_ ? T_CTX : T_LAT; const int rb_ = b * T_ALL + (isc_##cc_ ? 0 : T_CTX);
    if (wave < 4) {
        const int cg8 = 8 * (tid & 7), ri0 = tid >> 3, ri1 = ri0 + 32;
        f32x4 A0 = (f32x4){0.f, 0.f, 0.f, 0.f}, B0 = A0, A1 = A0, B1 = A0;
        __syncthreads(); __syncthreads(); __syncthreads();
        for (int ci = 0; ci < 72; ++ci) {
            const LAS float* FT = FEAT0 + (ci & 1) * 12288; LAS float* YB = YB0 + (ci & 1) * 2048;
#define RW2_LD(ts_) kkA = *(const LAS f32x4*)(FT + (0 * 32 + (ts_)) * 64 + cg8); kkB = *(const LAS f32x4*)(FT + (0 * 32 + (ts_)) * 64 + cg8 + 4); \
            wdA = *(const LAS f32x4*)(FT + (1 * 32 + (ts_)) * 64 + cg8); wdB = *(const LAS f32x4*)(FT + (1 * 32 + (ts_)) * 64 + cg8 + 4); \
            bbA = *(const LAS f32x4*)(FT + (2 * 32 + (ts_)) * 64 + cg8); bbB = *(const LAS f32x4*)(FT + (2 * 32 + (ts_)) * 64 + cg8 + 4); \
            kdA = *(const LAS f32x4*)(FT + (3 * 32 + (ts_)) * 64 + cg8); kdB = *(const LAS f32x4*)(FT + (3 * 32 + (ts_)) * 64 + cg8 + 4); \
            rrA = *(const LAS f32x4*)(FT + (4 * 32 + (ts_)) * 64 + cg8); rrB = *(const LAS f32x4*)(FT + (4 * 32 + (ts_)) * 64 + cg8 + 4); v0 = FT[(5 * 32 + (ts_)) * 64 + ri0]; v1 = FT[(5 * 32 + (ts_)) * 64 + ri1];
            f32x4 kkA, kkB, wdA, wdB, bbA, bbB, kdA, kdB, rrA, rrB; float v0, v1;
            { const int ts0 = z ? (RW_CH - 1) : 0; RW2_LD(ts0) }
#pragma unroll 1
            for (int seg = 0; seg < 3; ++seg) {
                const int s_lo = seg == 0 ? 0 : (seg == 1 ? 11 : 22), s_hi = seg == 0 ? 11 : (seg == 1 ? 22 : RW_CH);
#pragma unroll 2
                for (int st = s_lo; st < s_hi; ++st) { const int ts = z ? (RW_CH - 1 - st) : st; const int tn = (st + 1 < RW_CH) ? (z ? ts - 1 : ts + 1) : ts;
                    const f32x4 ckA = kkA, ckB = kkB, cwA = wdA, cwB = wdB, cbA = bbA, cbB = bbB, cdA = kdA, cdB = kdB, crA = rrA, crB = rrB; const float cv0 = v0, cv1 = v1;
                    RW2_LD(tn)
                    float sa0 = -(((A0[0] * ckA[0] + A0[1] * ckA[1]) + (A0[2] * ckA[2] + A0[3] * ckA[3])) + ((B0[0] * ckB[0] + B0[1] * ckB[1]) + (B0[2] * ckB[2] + B0[3] * ckB[3])));
                    float sa1 = -(((A1[0] * ckA[0] + A1[1] * ckA[1]) + (A1[2] * ckA[2] + A1[3] * ckA[3])) + ((B1[0] * ckB[0] + B1[1] * ckB[1]) + (B1[2] * ckB[2] + B1[3] * ckB[3])));
                    sa0 = sum8(sa0); sa1 = sum8(sa1);
                    A0 = A0 * cwA + sa0 * cbA + cv0 * cdA; B0 = B0 * cwB + sa0 * cbB + cv0 * cdB; A1 = A1 * cwA + sa1 * cbA + cv1 * cdA; B1 = B1 * cwB + sa1 * cbB + cv1 * cdB;
                    float y0 = ((A0[0] * crA[0] + A0[1] * crA[1]) + (A0[2] * crA[2] + A0[3] * crA[3])) + ((B0[0] * crB[0] + B0[1] * crB[1]) + (B0[2] * crB[2] + B0[3] * crB[3]));
                    float y1 = ((A1[0] * crA[0] + A1[1] * crA[1]) + (A1[2] * crA[2] + A1[3] * crA[3])) + ((B1[0] * crB[0] + B1[1] * crB[1]) + (B1[2] * crB[2] + B1[3] * crB[3]));
                    y0 = sum8(y0); y1 = sum8(y1);
                    if ((tid & 7) == 0) { YB[ts * 64 + ri0] = y0; YB[ts * 64 + ri1] = y1; } }
                __syncthreads();
            }
#undef RW2_LD
        }
        __syncthreads();
    } else {
        int tzp = tid; asm volatile("" : "+v"(tzp));
        const int p = tzp - 256, tt = p >> 3, j8 = 8 * (p & 7), pw = wave - 4; const int lane = tzp & 63;
        const float* mu = F.inp(I_RWMU) + (size_t)l * 2 * RW_COLS; const float* mu0 = mu, *mu1 = mu + RW_COLS;
        const float* w0 = F.inp(I_RWW0) + ((size_t)l * 2 + z) * 512 + hd * 64; const float* a0 = F.inp(I_RWA0) + ((size_t)l * 2 + z) * 512 + hd * 64;
        const float* w2 = F.inp(I_RWW2) + ((size_t)l * 2 + z) * 64 * 512; const float* a2 = F.inp(I_RWA2) + ((size_t)l * 2 + z) * 64 * 512;
        const float* k_k = F.inp(I_RWKK) + l * 512 + hd * 64; const float* k_a = F.inp(I_RWKA) + l * 512 + hd * 64; const float* r_k = F.inp(I_RWRK) + l * 512 + hd * 64;
        float breg[2][16];
        { const float* src = (pw < 2 ? w2 : a2) + hd * 64 + 32 * (pw & 1) + (lane & 15) + (size_t)(lane >> 4) * 512;
#pragma unroll
          for (int ks = 0; ks < 16; ++ks) { breg[0][ks] = src[0]; breg[1][ks] = src[16]; src += 4 * 512; asm volatile("" : "+v"(src)); } }
        LAS float* CT = (LAS float*)(F.lds + RW2_CT);
        if (p < 64) { CT[p] = w0[p]; CT[64 + p] = a0[p]; CT[128 + p] = k_k[p]; CT[192 + p] = k_a[p]; CT[256 + p] = r_k[p]; }
        u32x4 raw[5][3];
#define RW2_LOADRAW(ci_) do { RW2_GEOM(ci_, ccL, lenL, rbL) const int tL = ccL * RW_CH + tt; const int tpL = tL > 0 ? tL - 1 : tL, tnL = tL < lenL - 1 ? tL + 1 : tL; \
            const bf16_t* pcL = PRW + (size_t)(rbL + tL) * RW_COLS; const bf16_t* ppL = PRW + (size_t)(rbL + tpL) * RW_COLS; const bf16_t* pnL = PRW + (size_t)(rbL + tnL) * RW_COLS; \
            const int cgL[5] = {hd * 64 + j8, 512 + hd * 64 + j8, 1024 + hd * 64 + j8, 1536 + j8, 1600 + j8}; \
            _Pragma("unroll") for (int g_ = 0; g_ < 5; ++g_) { raw[g_][0] = *(const u32x4*)(ppL + cgL[g_]); raw[g_][1] = *(const u32x4*)(pcL + cgL[g_]); raw[g_][2] = *(const u32x4*)(pnL + cgL[g_]); } } while (0)
        RW2_LOADRAW(0);
        for (int ci = -1; ci < 72; ++ci) {
            const int cn = ci + 1;
            if (ci >= 1) { const int cp = ci - 1; RW2_GEOM(cp, ccP, lenP, rbP) (void)lenP;
                if (!isc_ccP || emit_ctx) { const LAS float* YBp = YB0 + (cp & 1) * 2048;
#pragma unroll
                    for (int h2 = 0; h2 < 2; ++h2) *(f32x4*)(Y + (size_t)(rbP + ccP * RW_CH + tt) * 512 + hd * 64 + j8 + 4 * h2) = *(const LAS f32x4*)(YBp + tt * 64 + j8 + 4 * h2); } }
            f32x4 r8[2], k8[2], v8[2]; int rbN = 0, tN = 0;
            if (cn < 72) {
                RW2_GEOM(cn, ccN, lenN, rbN_) rbN = rbN_; tN = ccN * RW_CH + tt; const float fp = tN > 0 ? 1.f : 0.f, fn = tN < lenN - 1 ? 1.f : 0.f;
                const int cg[5] = {hd * 64 + j8, 512 + hd * 64 + j8, 1024 + hd * 64 + j8, 1536 + j8, 1600 + j8};
                f32x4 sh[5][2];
#pragma unroll
                for (int g = 0; g < 5; ++g)
#pragma unroll
                    for (int h2 = 0; h2 < 2; ++h2) { const unsigned pa_ = h2 ? raw[g][0].z : raw[g][0].x, pb_ = h2 ? raw[g][0].w : raw[g][0].y, ca_ = h2 ? raw[g][1].z : raw[g][1].x, cb_ = h2 ? raw[g][1].w : raw[g][1].y, na_ = h2 ? raw[g][2].z : raw[g][2].x, nb_ = h2 ? raw[g][2].w : raw[g][2].y;
                        const f32x4 pv = (f32x4){bflo(pa_), bfhi(pa_), bflo(pb_), bfhi(pb_)} * fp, pc = (f32x4){bflo(ca_), bfhi(ca_), bflo(cb_), bfhi(cb_)}, nx = (f32x4){bflo(na_), bfhi(na_), bflo(nb_), bfhi(nb_)} * fn;
                        sh[g][h2] = pc + *(const f32x4*)(mu0 + cg[g] + 4 * h2) * (pv - pc) + *(const f32x4*)(mu1 + cg[g] + 4 * h2) * (nx - pc); }
#pragma unroll
                for (int h2 = 0; h2 < 2; ++h2) { r8[h2] = sh[0][h2]; k8[h2] = sh[1][h2]; v8[h2] = sh[2][h2];
                    *(LAS f32x4*)(XW + tt * 68 + j8 + 4 * h2) = (f32x4){tanhf_(sh[3][h2][0]), tanhf_(sh[3][h2][1]), tanhf_(sh[3][h2][2]), tanhf_(sh[3][h2][3])}; *(LAS f32x4*)(XA + tt * 68 + j8 + 4 * h2) = sh[4][h2]; }
                if (cn + 1 < 72) RW2_LOADRAW(cn + 1);
            }
            __syncthreads();
            if (cn < 72) { const LAS float* Xs = (pw < 2) ? XW : XA; LAS float* Ps = (pw < 2) ? PW : PA;
#pragma unroll
                for (int n = 0; n < 2; ++n)
#pragma unroll
                    for (int mt = 0; mt < 2; ++mt) { f32x4 acc = (f32x4){0.f, 0.f, 0.f, 0.f}, acc2 = acc;
#pragma unroll
                        for (int ks = 0; ks < 16; ks += 2) { acc = __builtin_amdgcn_mfma_f32_16x16x4f32(Xs[(mt * 16 + (lane & 15)) * 68 + 4 * ks + (lane >> 4)], breg[n][ks], acc, 0, 0, 0);
                            acc2 = __builtin_amdgcn_mfma_f32_16x16x4f32(Xs[(mt * 16 + (lane & 15)) * 68 + 4 * (ks + 1) + (lane >> 4)], breg[n][ks + 1], acc2, 0, 0, 0); }
                        acc += acc2;
#pragma unroll
                        for (int rg = 0; rg < 4; ++rg) Ps[(mt * 16 + 4 * (lane >> 4) + rg) * 64 + 32 * (pw & 1) + 16 * n + (lane & 15)] = acc[rg]; } }
            __syncthreads();
            if (cn < 72) { LAS float* FT = FEAT0 + (cn & 1) * 12288;
                f32x4 dec[2], av[2], kkr[2], kd[2], bb[2]; float ss = 0.f, bo = 0.f;
#pragma unroll
                for (int h2 = 0; h2 < 2; ++h2) { const f32x4 pwv = *(const LAS f32x4*)(PW + tt * 64 + j8 + 4 * h2) + *(const LAS f32x4*)(CT + j8 + 4 * h2), pav = *(const LAS f32x4*)(PA + tt * 64 + j8 + 4 * h2) + *(const LAS f32x4*)(CT + 64 + j8 + 4 * h2);
                    const f32x4 kkc_ = *(const LAS f32x4*)(CT + 128 + j8 + 4 * h2), kac_ = *(const LAS f32x4*)(CT + 192 + j8 + 4 * h2), rkc_ = *(const LAS f32x4*)(CT + 256 + j8 + 4 * h2);
#pragma unroll
                    for (int i = 0; i < 4; ++i) { dec[h2][i] = __expf(-0.6065306597126334f * sigmoidf_(pwv[i])); av[h2][i] = sigmoidf_(pav[i]); kkr[h2][i] = k8[h2][i] * kkc_[i]; ss += kkr[h2][i] * kkr[h2][i];
                        kd[h2][i] = k8[h2][i] * (1.0f + (av[h2][i] - 1.0f) * kac_[i]); bo += r8[h2][i] * kd[h2][i] * rkc_[i]; } }
                ss = sum8(ss); bo = sum8(bo);
                const float inv = 1.0f / fmaxf(sqrtf(ss), 1e-12f);
#pragma unroll
                for (int h2 = 0; h2 < 2; ++h2) { kkr[h2] = kkr[h2] * inv; bb[h2] = kkr[h2] * av[h2];
                    *(LAS f32x4*)(FT + (0 * 32 + tt) * 64 + j8 + 4 * h2) = kkr[h2]; *(LAS f32x4*)(FT + (1 * 32 + tt) * 64 + j8 + 4 * h2) = dec[h2]; *(LAS f32x4*)(FT + (2 * 32 + tt) * 64 + j8 + 4 * h2) = bb[h2];
                    *(LAS f32x4*)(FT + (3 * 32 + tt) * 64 + j8 + 4 * h2) = kd[h2]; *(LAS f32x4*)(FT + (4 * 32 + tt) * 64 + j8 + 4 * h2) = r8[h2]; *(LAS f32x4*)(FT + (5 * 32 + tt) * 64 + j8 + 4 * h2) = v8[h2]; }
                if ((p & 7) == 0) BON[(size_t)(rbN + tN) * 8 + hd] = bo; }
            __syncthreads();
        }
        __syncthreads();
        { const int cp = 71; RW2_GEOM(cp, ccP, lenP, rbP) (void)lenP;
          if (!isc_ccP || emit_ctx) { const LAS float* YBp = YB0 + (cp & 1) * 2048;
#pragma unroll
              for (int h2 = 0; h2 < 2; ++h2) *(f32x4*)(Y + (size_t)(rbP + ccP * RW_CH + tt) * 512 + hd * 64 + j8 + 4 * h2) = *(const LAS f32x4*)(YBp + tt * 64 + j8 + 4 * h2); } }
#undef RW2_LOADRAW
    }
#undef RW2_GEOM
    __syncthreads();
}

constexpr int R3_Z = 0, R3_X1 = 17408, R3_YB = 34816, R3_NT = 43008;
constexpr int R3_B = 49152, R3_XW = 17408, R3_XA = 17408 + 8704, R3_KR = R3_B, R3_BD = R3_B + 9216, R3_BDT = R3_B + 18432, R3_GL = R3_B + 27648, R3_PT = R3_B + 35840;
constexpr int R3_C = R3_B + 36864, R3_S16 = R3_C, R3_SF = R3_C + 9216, R3_PW = R3_SF, R3_PA = R3_SF + 8192, R3_VT = R3_C + 25600, R3_U = R3_C + 34816, R3_UV = R3_C + 44032, R3_RHS = R3_C + 53248;
constexpr int R3_LS = 72  , R3_FS = 68  , R3_VS = 36  ;
__device__ __forceinline__ void split8(const f32x4 a, const f32x4 b, bf16x8& hi, bf16x8& lo) {
    u32x4 h, l;
    h.x = cvt_pk_bf16(a[0], a[1]); h.y = cvt_pk_bf16(a[2], a[3]); h.z = cvt_pk_bf16(b[0], b[1]); h.w = cvt_pk_bf16(b[2], b[3]);
    l.x = cvt_pk_bf16(a[0] - bflo(h.x), a[1] - bfhi(h.x)); l.y = cvt_pk_bf16(a[2] - bflo(h.y), a[3] - bfhi(h.y));
    l.z = cvt_pk_bf16(b[0] - bflo(h.z), b[1] - bfhi(h.z)); l.w = cvt_pk_bf16(b[2] - bflo(h.w), b[3] - bfhi(h.w));
    hi = __builtin_bit_cast(bf16x8, h); lo = __builtin_bit_cast(bf16x8, l);
}
template <int B> __device__ __forceinline__ void solve_block4(f32x4& ra, f32x4& rb, f32x4& ua, f32x4& ub, const LAS float* zp, int q, f32x4 (&na)[4], f32x4 (&nb)[4]) {
    f32x4 ma[4], mb[4];
    if (B < 7) {
#pragma unroll
        for (int e = 0; e < 4; ++e) { ma[e] = *(const LAS f32x4*)(zp + (4 * B + 4 + e) * R3_FS); mb[e] = *(const LAS f32x4*)(zp + (4 * B + 4 + e) * R3_FS + 4); } }
    const f32x4 rr = (B & 1) ? rb : ra;
    const f32x4 m0 = (B & 1) ? nb[0] : na[0], m1 = (B & 1) ? nb[1] : na[1], m2 = (B & 1) ? nb[2] : na[2];
    const float u0 = rr[0], u1 = rr[1] - u0 * m0[1], u2 = rr[2] - (u0 * m0[2] + u1 * m1[2]), u3 = rr[3] - ((u0 * m0[3] + u1 * m1[3]) + u2 * m2[3]);
    if (q == (B >> 1)) { if (B & 1) ub = (f32x4){u0, u1, u2, u3}; else ua = (f32x4){u0, u1, u2, u3}; }
    if (B < 7) {
        constexpr int o = B >> 1, ctrl = o | (o << 2) | (o << 4) | (o << 6);
        const float b0 = dppf<ctrl>(u0), b1 = dppf<ctrl>(u1), b2 = dppf<ctrl>(u2), b3 = dppf<ctrl>(u3);
        ra -= (b0 * na[0] + b1 * na[1]) + (b2 * na[2] + b3 * na[3]);
        rb -= (b0 * nb[0] + b1 * nb[1]) + (b2 * nb[2] + b3 * nb[3]);
#pragma unroll
        for (int e = 0; e < 4; ++e) { na[e] = ma[e]; nb[e] = mb[e]; } }
}
__device__ __forceinline__ void rwkv_scan_unit3(Frame& F, int l, int b, int hd, int z, bool emit_ctx) {
    const int tid0 = F.tid, lane0 = F.lane, wave = F.wave;
    LAS unsigned char* L = F.lds;
    LAS float* FEAT = (LAS float*)(L + 0); LAS float* XW = (LAS float*)(L + R3_XW); LAS float* XA = (LAS float*)(L + R3_XA); LAS float* PW = (LAS float*)(L + R3_PW); LAS float* PA = (LAS float*)(L + R3_PA);
    LAS float* Zm = (LAS float*)(L + R3_Z); LAS float* X1 = (LAS float*)(L + R3_X1); LAS float* YB = (LAS float*)(L + R3_YB); LAS float* NT = (LAS float*)(L + R3_NT); LAS float* WT = (LAS float*)(L + R3_NT + 4096);
    LAS bf16_t* KR = (LAS bf16_t*)(L + R3_KR); LAS bf16_t* BD = (LAS bf16_t*)(L + R3_BD); LAS bf16_t* BDT = (LAS bf16_t*)(L + R3_BDT); LAS float* GL = (LAS float*)(L + R3_GL); LAS float* PT = (LAS float*)(L + R3_PT);
    LAS bf16_t* S16 = (LAS bf16_t*)(L + R3_S16); LAS float* SF = (LAS float*)(L + R3_SF); LAS bf16_t* UVL = (LAS bf16_t*)(L + R3_VT); LAS bf16_t* ZT2 = (LAS bf16_t*)(L + R3_U)  ; LAS bf16_t* ZTD = (LAS bf16_t*)(L + R3_Z + 8704)  ; LAS bf16_t* UV = (LAS bf16_t*)(L + R3_UV); LAS float* RHS = (LAS float*)(L + R3_RHS);
    const bf16_t* PRW = (const bf16_t*)(F.ws + R_PRW); float* Y = (float*)(F.ws + R_YFB) + (size_t)z * ROWS * 512; float* BON = (float*)(F.ws + WS_BONUS) + (size_t)z * ROWS * 8;
    const float* mu = F.inp(I_RWMU) + (size_t)l * 2 * RW_COLS; const float* mu0 = mu, *mu1 = mu + RW_COLS;
    const float* w0 = F.inp(I_RWW0) + ((size_t)l * 2 + z) * 512 + hd * 64; const float* a0 = F.inp(I_RWA0) + ((size_t)l * 2 + z) * 512 + hd * 64;
    const float* w2 = F.inp(I_RWW2) + ((size_t)l * 2 + z) * 64 * 512; const float* a2 = F.inp(I_RWA2) + ((size_t)l * 2 + z) * 64 * 512;
    const float* k_k = F.inp(I_RWKK) + l * 512 + hd * 64; const float* k_a = F.inp(I_RWKA) + l * 512 + hd * 64; const float* r_k = F.inp(I_RWRK) + l * 512 + hd * 64;
    f32x4 shr[8];
    if (wave >= 4) {
#pragma unroll
      for (int n = 0; n < 2; ++n) { const float* src = (wave < 6 ? w2 : a2) + hd * 64 + 32 * (wave & 1) + 16 * n + (lane0 & 15) + (size_t)(8 * (lane0 >> 4)) * 512;
#pragma unroll
        for (int ks = 0; ks < 2; ++ks) { f32x4 wa, wb;
#pragma unroll
          for (int j = 0; j < 4; ++j) { wa[j] = src[0]; src += 512; asm volatile("" : "+v"(src)); }
#pragma unroll
          for (int j = 0; j < 4; ++j) { wb[j] = src[0]; src += 512; asm volatile("" : "+v"(src)); }
          bf16x8 th, tl; split8(wa, wb, th, tl); shr[2 * n + ks] = __builtin_bit_cast(f32x4, th); shr[4 + 2 * n + ks] = __builtin_bit_cast(f32x4, tl); src += 24 * 512; } } }
    LAS float* CT = (LAS float*)(L + R3_C + 62464);
    LAS float* MT = CT + 384;
    { const int tid = tid0;
      for (int i = tid; i < 640; i += 512) { const int m = i / 320, g = (i % 320) >> 6, j = i & 63; const int col = (g < 3 ? g * 512 + hd * 64 : (g == 3 ? 1536 : 1600)) + j; MT[i] = mu[(size_t)m * RW_COLS + col]; }
      if (tid < 64) { CT[tid] = w0[tid]; CT[64 + tid] = a0[tid]; CT[128 + tid] = k_k[tid]; CT[192 + tid] = k_a[tid]; CT[256 + tid] = r_k[tid]; }
    for (int i = tid; i < 64 * R3_LS / 2; i += 512) ((LAS unsigned*)S16)[i] = 0u; }
    if (wave < 4) {
#pragma unroll
      for (int nt = 0; nt < 4; ++nt) shr[nt] = (f32x4){0.f, 0.f, 0.f, 0.f}; }
    u32x2 raw[5][3];
#define RW3_GEOM(ci_) const bool isc_ = (ci_) < 8; const int cc_ = isc_ ? (z ? 7 - (ci_) : (ci_)) : (z ? 63 - ((ci_) - 8) : ((ci_) - 8)); \
        const int len_ = isc_ ? T_CTX : T_LAT; const int rb_ = b * T_ALL + (isc_ ? 0 : T_CTX); const int t_ = cc_ * RW_CH + tt;
#define RW3_LOADRAW(ci_) do { RW3_GEOM(ci_) const int tp_ = t_ > 0 ? t_ - 1 : t_, tn_ = t_ < len_ - 1 ? t_ + 1 : t_; \
        const bf16_t* pc_ = PRW + (size_t)(rb_ + t_) * RW_COLS; const bf16_t* pp_ = PRW + (size_t)(rb_ + tp_) * RW_COLS; const bf16_t* pn_ = PRW + (size_t)(rb_ + tn_) * RW_COLS; \
        const int cg_[5] = {hd * 64 + j4, 512 + hd * 64 + j4, 1024 + hd * 64 + j4, 1536 + j4, 1600 + j4}; \
        _Pragma("unroll") for (int g_ = 0; g_ < 5; ++g_) { raw[g_][0] = *(const u32x2*)(pp_ + cg_[g_]); raw[g_][1] = *(const u32x2*)(pc_ + cg_[g_]); raw[g_][2] = *(const u32x2*)(pn_ + cg_[g_]); } } while (0)
#define RW3_BAR() asm volatile("s_waitcnt lgkmcnt(0)\n\ts_barrier" ::: "memory")
#define RW3_P1(ci_) do { RW3_GEOM(ci_) const float fp_ = t_ > 0 ? 1.f : 0.f, fn_ = t_ < len_ - 1 ? 1.f : 0.f; f32x4 sh_[5]; \
        _Pragma("unroll") for (int g = 0; g < 5; ++g) { const f32x4 pv = (f32x4){bflo(raw[g][0].x), bfhi(raw[g][0].x), bflo(raw[g][0].y), bfhi(raw[g][0].y)} * fp_; \
            const f32x4 p = (f32x4){bflo(raw[g][1].x), bfhi(raw[g][1].x), bflo(raw[g][1].y), bfhi(raw[g][1].y)}; \
            const f32x4 nx = (f32x4){bflo(raw[g][2].x), bfhi(raw[g][2].x), bflo(raw[g][2].y), bfhi(raw[g][2].y)} * fn_; \
            sh_[g] = p + *(const LAS f32x4*)(MT + g * 64 + j4) * (pv - p) + *(const LAS f32x4*)(MT + 320 + g * 64 + j4) * (nx - p); } \
        *(LAS f32x4*)(XW + tt * 68 + j4) = (f32x4){tanhf_(sh_[3][0]), tanhf_(sh_[3][1]), tanhf_(sh_[3][2]), tanhf_(sh_[3][3])}; *(LAS f32x4*)(XA + tt * 68 + j4) = sh_[4]; \
        r4 = sh_[0]; k4 = sh_[1]; v4 = sh_[2]; } while (0)
#define RW3_P2() do { const LAS float* Xs = (wave < 6) ? XW : XA; LAS float* Ps = (wave < 6) ? PW : PA; \
        _Pragma("unroll") for (int mt = 0; mt < 2; ++mt) { f32x4 acc[2], acc2[2]; \
            _Pragma("unroll") for (int n = 0; n < 2; ++n) { acc[n] = (f32x4){0.f, 0.f, 0.f, 0.f}; acc2[n] = acc[n]; } \
            _Pragma("unroll") for (int ks = 0; ks < 2; ++ks) { const LAS float* xp = Xs + (mt * 16 + (lane & 15)) * 68 + 32 * ks + 8 * (lane >> 4); bf16x8 ah, al; \
                split8(*(const LAS f32x4*)xp, *(const LAS f32x4*)(xp + 4), ah, al); \
                _Pragma("unroll") for (int n = 0; n < 2; ++n) { \
                    const bf16x8 bh_ = __builtin_bit_cast(bf16x8, shr[2 * n + ks]), bl_ = __builtin_bit_cast(bf16x8, shr[4 + 2 * n + ks]); \
                    acc[n] = __builtin_amdgcn_mfma_f32_16x16x32_bf16(ah, bh_, acc[n], 0, 0, 0); \
                    acc2[n] = __builtin_amdgcn_mfma_f32_16x16x32_bf16(ah, bl_, acc2[n], 0, 0, 0); \
                    acc2[n] = __builtin_amdgcn_mfma_f32_16x16x32_bf16(al, bh_, acc2[n], 0, 0, 0); } } \
            _Pragma("unroll") for (int n = 0; n < 2; ++n) { acc[n] += acc2[n]; \
                _Pragma("unroll") for (int rg = 0; rg < 4; ++rg) Ps[(mt * 16 + 4 * (lane >> 4) + rg) * 64 + 32 * (wave & 1) + 16 * n + (lane & 15)] = acc[n][rg]; } } } while (0)
    f32x4 r4, k4, v4;
    { const int tt = tid0 >> 4, j4 = 4 * (tid0 & 15), lane = lane0; RW3_LOADRAW(0); __syncthreads(); RW3_P1(0); RW3_BAR(); if (wave >= 4) RW3_P2(); }
    RW3_BAR();
    for (int ci = 0; ci < 72; ++ci) {
        int tzl = tid0; asm volatile("" : "+v"(tzl));
        const int tid = tzl, lane = tzl & 63, tt = tzl >> 4, jq = tzl & 15, j4 = 4 * jq;
        const bool isc = ci < 8; const int cc = isc ? (z ? 7 - ci : ci) : (z ? 63 - (ci - 8) : (ci - 8));
        const int rb = b * T_ALL + (isc ? 0 : T_CTX); const int t0 = cc * RW_CH; const int t = t0 + tt;
        if (ci + 1 < 72) RW3_LOADRAW(ci + 1);
#ifndef RP_P3A
#define RP_P3A 1
#endif
#ifndef RP_P3B
#define RP_P3B 1
#endif
        { f32x4 ldv, av, kkr, kd, bb, c;
#pragma unroll 1
          for (int rq_ = 0; rq_ < RP_P3A; ++rq_) {
          const f32x4 pw = *(const LAS f32x4*)(PW + tt * 64 + j4) + *(const LAS f32x4*)(CT + j4), pa = *(const LAS f32x4*)(PA + tt * 64 + j4) + *(const LAS f32x4*)(CT + 64 + j4);
          const f32x4 kkc = *(const LAS f32x4*)(CT + 128 + j4), kac = *(const LAS f32x4*)(CT + 192 + j4), rkc = *(const LAS f32x4*)(CT + 256 + j4);
          float ss = 0.f, bo = 0.f;
#pragma unroll
          for (int i = 0; i < 4; ++i) { ldv[i] = -0.8750387749f * sigmoidf_(pw[i]); av[i] = sigmoidf_(pa[i]); kkr[i] = k4[i] * kkc[i]; ss += kkr[i] * kkr[i];
              kd[i] = k4[i] * (1.0f + (av[i] - 1.0f) * kac[i]); bo += r4[i] * kd[i] * rkc[i]; }
          ss = sum16(ss); bo = sum16(bo);
          const float inv = 1.0f / fmaxf(sqrtf(ss), 1e-12f);
#pragma unroll
          for (int i = 0; i < 4; ++i) { kkr[i] *= inv; bb[i] = kkr[i] * av[i]; }
          if (jq == 0) BON[(size_t)(rb + t) * 8 + hd] = bo;
          c = ldv;
          { const int s1 = z ? lane + 16 : lane - 16, s2 = z ? lane + 32 : lane - 32; const bool o1 = z ? lane < 48 : lane >= 16, o2 = z ? lane < 32 : lane >= 32;
            f32x4 t1; t1[0] = __shfl(c[0], s1); t1[1] = __shfl(c[1], s1); t1[2] = __shfl(c[2], s1); t1[3] = __shfl(c[3], s1);
            if (o1) c += t1;
            t1[0] = __shfl(c[0], s2); t1[1] = __shfl(c[1], s2); t1[2] = __shfl(c[2], s2); t1[3] = __shfl(c[3], s2);
            if (o2) c += t1; }
          if (z ? lane < 16 : lane >= 48) *(LAS f32x4*)(WT + wave * 64 + j4) = c;
          }
          RW3_BAR();
#pragma unroll 1
          for (int rq_ = 0; rq_ < RP_P3B; ++rq_) {
          f32x4 base = (f32x4){0.f, 0.f, 0.f, 0.f};
          { f32x4 wt[8];
#pragma unroll
            for (int w2 = 0; w2 < 8; ++w2) wt[w2] = *(const LAS f32x4*)(WT + w2 * 64 + j4);
#pragma unroll
            for (int w2 = 0; w2 < 8; ++w2) { const float mk = (z ? w2 > wave : w2 < wave) ? 1.f : 0.f; base += wt[w2] * mk; } }
          const f32x4 Lc = base + c;
          f32x4 gt, gm, ig;
#pragma unroll
          for (int i = 0; i < 4; ++i) { gt[i] = fast_exp2(Lc[i]); gm[i] = fast_exp2(Lc[i] - ldv[i]); ig[i] = fast_exp2(-Lc[i]); }
          const int tau = z ? 31 - tt : tt;
          const f32x4 kh = kkr * gm, rh = r4 * gt; f32x4 bh = bb * ig, dh = kd * ig, vv = v4;
          u32x2 w; w.x = cvt_pk_bf16(kh[0], kh[1]); w.y = cvt_pk_bf16(kh[2], kh[3]); *(LAS u32x2*)(KR + tau * R3_LS + j4) = w;
          w.x = cvt_pk_bf16(rh[0], rh[1]); w.y = cvt_pk_bf16(rh[2], rh[3]); *(LAS u32x2*)(KR + (32 + tau) * R3_LS + j4) = w;
          w.x = cvt_pk_bf16(bh[0], bh[1]); w.y = cvt_pk_bf16(bh[2], bh[3]); *(LAS u32x2*)(BD + tau * R3_LS + j4) = w;
          w.x = cvt_pk_bf16(dh[0], dh[1]); w.y = cvt_pk_bf16(dh[2], dh[3]); *(LAS u32x2*)(BD + (32 + tau) * R3_LS + j4) = w;
          if (tau == 31) *(LAS f32x4*)(CT + 320 + j4) = gt;
          { const int rot = jq >> 2;
            if (rot & 1) { bh = (f32x4){bh[1], bh[2], bh[3], bh[0]}; dh = (f32x4){dh[1], dh[2], dh[3], dh[0]}; vv = (f32x4){vv[1], vv[2], vv[3], vv[0]}; }
            if (rot & 2) { bh = (f32x4){bh[2], bh[3], bh[0], bh[1]}; dh = (f32x4){dh[2], dh[3], dh[0], dh[1]}; vv = (f32x4){vv[2], vv[3], vv[0], vv[1]}; }
#pragma unroll
            for (int i = 0; i < 4; ++i) { const int row = j4 + ((i + rot) & 3);
                BDT[row * R3_LS + tau] = (bf16_t)f2bf(bh[i]); BDT[row * R3_LS + 32 + tau] = (bf16_t)f2bf(dh[i]);
                const unsigned vh = f2bf(vv[i]); UV[row * R3_LS + 32 + tau] = (bf16_t)vh; UVL[row * R3_LS + 32 + tau] = (bf16_t)f2bf(vv[i] - bflo(vh)); } }
          } }
        RW3_BAR();
        if (ci + 1 < 72) RW3_P1(ci + 1);
        const int c16 = lane & 15, q4 = lane >> 4;
        if (wave < 4) { const int i0 = 16 * wave;
            const bf16x8 a0 = *(const LAS bf16x8*)(S16 + (i0 + c16) * R3_LS + 8 * q4), a1 = *(const LAS bf16x8*)(S16 + (i0 + c16) * R3_LS + 32 + 8 * q4);
#pragma unroll
            for (int nt = 0; nt < 4; ++nt) { shr[4 + nt] = (f32x4){0.f, 0.f, 0.f, 0.f};
                shr[4 + nt] = __builtin_amdgcn_mfma_f32_16x16x32_bf16(a0, *(const LAS bf16x8*)(KR + (16 * nt + c16) * R3_LS + 8 * q4), shr[4 + nt], 0, 0, 0);
                shr[4 + nt] = __builtin_amdgcn_mfma_f32_16x16x32_bf16(a1, *(const LAS bf16x8*)(KR + (16 * nt + c16) * R3_LS + 32 + 8 * q4), shr[4 + nt], 0, 0, 0); }
        } else { const int mt = wave - 4;
            const bf16x8 a0 = *(const LAS bf16x8*)(BD + (16 * mt + c16) * R3_LS + 8 * q4), a1 = *(const LAS bf16x8*)(BD + (16 * mt + c16) * R3_LS + 32 + 8 * q4);
#pragma unroll
            for (int nt = 0; nt < 4; ++nt) { f32x4 az = (f32x4){0.f, 0.f, 0.f, 0.f};
                az = __builtin_amdgcn_mfma_f32_16x16x32_bf16(a0, *(const LAS bf16x8*)(KR + (16 * nt + c16) * R3_LS + 8 * q4), az, 0, 0, 0);
                az = __builtin_amdgcn_mfma_f32_16x16x32_bf16(a1, *(const LAS bf16x8*)(KR + (16 * nt + c16) * R3_LS + 32 + 8 * q4), az, 0, 0, 0);
                if (mt < 2 && nt < 2) {
#pragma unroll
                    for (int rg = 0; rg < 4; ++rg) Zm[(16 * mt + 4 * q4 + rg) * R3_FS + 16 * nt + c16] = az[rg];
                } else {
                    const int s0 = 16 * (mt & 1) + 4 * q4, tc = 16 * (nt & 1) + c16; const int lim = (nt < 2) ? tc - 1 : tc;
                    f32x4 zz;
#pragma unroll
                    for (int rg = 0; rg < 4; ++rg) zz[rg] = (s0 + rg <= lim) ? az[rg] : 0.f;
                    u32x2 h, lo_; h.x = cvt_pk_bf16(zz[0], zz[1]); h.y = cvt_pk_bf16(zz[2], zz[3]);
                    lo_.x = cvt_pk_bf16(zz[0] - bflo(h.x), zz[1] - bfhi(h.x)); lo_.y = cvt_pk_bf16(zz[2] - bflo(h.y), zz[3] - bfhi(h.y));
                    if (nt < 2) { *(LAS u32x2*)(ZTD + tc * 40 + s0) = h; *(LAS u32x2*)(ZTD + 1280 + tc * 40 + s0) = lo_; }
                    else { const int k0 = (mt >= 2 ? 32 : 0) + s0; *(LAS u32x2*)(ZT2 + tc * R3_LS + k0) = h; *(LAS u32x2*)(ZT2 + 2304 + tc * R3_LS + k0) = lo_; } } } }
        RW3_BAR();
#ifndef RP_CH
#define RP_CH 1
#endif
#pragma unroll 1
        for (int rq_ = 0; rq_ < RP_CH; ++rq_)
        if (wave < 4) { const int i0 = 16 * wave;
            { const bf16x8 ah = *(const LAS bf16x8*)(UV + (i0 + c16) * R3_LS + 32 + 8 * q4), al = *(const LAS bf16x8*)(UVL + (i0 + c16) * R3_LS + 32 + 8 * q4);
#pragma unroll
              for (int nt = 0; nt < 2; ++nt) { const bf16x8 bh = *(const LAS bf16x8*)(ZTD + (16 * nt + c16) * 40 + 8 * q4), bl = *(const LAS bf16x8*)(ZTD + 1280 + (16 * nt + c16) * 40 + 8 * q4);
                  f32x4 acc = shr[4 + nt], acc2 = (f32x4){0.f, 0.f, 0.f, 0.f};
                  acc = __builtin_amdgcn_mfma_f32_16x16x32_bf16(ah, bh, acc, 0, 0, 0);
                  acc2 = __builtin_amdgcn_mfma_f32_16x16x32_bf16(ah, bl, acc2, 0, 0, 0);
                  acc2 = __builtin_amdgcn_mfma_f32_16x16x32_bf16(al, bh, acc2, 0, 0, 0);
                  acc += acc2;
#pragma unroll
                  for (int rg = 0; rg < 4; ++rg) RHS[(i0 + 4 * q4 + rg) * R3_VS + 16 * nt + c16] = -acc[rg]; } }
#ifndef RP_SV
#define RP_SV 1
#endif
#pragma unroll 1
            for (int rs_ = 0; rs_ < RP_SV; ++rs_)
            { const int row = i0 + (lane >> 2), q = lane & 3;
              f32x4 ra = *(const LAS f32x4*)(RHS + row * R3_VS + 8 * q), rb = *(const LAS f32x4*)(RHS + row * R3_VS + 8 * q + 4), ua = ra, ub = rb;
              const LAS float* zp = Zm + 8 * q; f32x4 na[4], nb[4];
#pragma unroll
              for (int e = 0; e < 4; ++e) { na[e] = *(const LAS f32x4*)(zp + e * R3_FS); nb[e] = *(const LAS f32x4*)(zp + e * R3_FS + 4); }
              solve_block4<0>(ra, rb, ua, ub, zp, q, na, nb); solve_block4<1>(ra, rb, ua, ub, zp, q, na, nb); solve_block4<2>(ra, rb, ua, ub, zp, q, na, nb); solve_block4<3>(ra, rb, ua, ub, zp, q, na, nb);
              solve_block4<4>(ra, rb, ua, ub, zp, q, na, nb); solve_block4<5>(ra, rb, ua, ub, zp, q, na, nb); solve_block4<6>(ra, rb, ua, ub, zp, q, na, nb); solve_block4<7>(ra, rb, ua, ub, zp, q, na, nb);
              bf16x8 uh, ul; split8(ua, ub, uh, ul);
              *(LAS bf16x8*)(UV + row * R3_LS + 8 * q) = uh; *(LAS bf16x8*)(UVL + row * R3_LS + 8 * q) = ul; }
            { const bf16x8 ah0 = *(const LAS bf16x8*)(UV + (i0 + c16) * R3_LS + 8 * q4), ah1 = *(const LAS bf16x8*)(UV + (i0 + c16) * R3_LS + 32 + 8 * q4);
              const bf16x8 al0 = *(const LAS bf16x8*)(UVL + (i0 + c16) * R3_LS + 8 * q4), al1 = *(const LAS bf16x8*)(UVL + (i0 + c16) * R3_LS + 32 + 8 * q4);
#pragma unroll
              for (int nt = 0; nt < 2; ++nt) { f32x4 acc = shr[6 + nt], acc2 = (f32x4){0.f, 0.f, 0.f, 0.f};
                  const LAS bf16_t* zb = ZT2 + (16 * nt + c16) * R3_LS + 8 * q4;
                  const bf16x8 bh0 = *(const LAS bf16x8*)(zb), bh1 = *(const LAS bf16x8*)(zb + 32), bl0 = *(const LAS bf16x8*)(zb + 2304), bl1 = *(const LAS bf16x8*)(zb + 2304 + 32);
                  acc = __builtin_amdgcn_mfma_f32_16x16x32_bf16(ah0, bh0, acc, 0, 0, 0); acc2 = __builtin_amdgcn_mfma_f32_16x16x32_bf16(ah0, bl0, acc2, 0, 0, 0); acc2 = __builtin_amdgcn_mfma_f32_16x16x32_bf16(al0, bh0, acc2, 0, 0, 0);
                  acc = __builtin_amdgcn_mfma_f32_16x16x32_bf16(ah1, bh1, acc, 0, 0, 0); acc2 = __builtin_amdgcn_mfma_f32_16x16x32_bf16(ah1, bl1, acc2, 0, 0, 0); acc2 = __builtin_amdgcn_mfma_f32_16x16x32_bf16(al1, bh1, acc2, 0, 0, 0);
                  acc += acc2;
                  { const int tau = 16 * nt + c16, ts = z ? 31 - tau : tau; *(LAS f32x4*)(YB + ts * 64 + i0 + 4 * q4) = acc; } }
#pragma unroll
              for (int nt = 0; nt < 4; ++nt) { f32x4 ac = (f32x4){0.f, 0.f, 0.f, 0.f};
                  ac = __builtin_amdgcn_mfma_f32_16x16x32_bf16(ah0, *(const LAS bf16x8*)(BDT + (16 * nt + c16) * R3_LS + 8 * q4), ac, 0, 0, 0);
                  ac = __builtin_amdgcn_mfma_f32_16x16x32_bf16(ah1, *(const LAS bf16x8*)(BDT + (16 * nt + c16) * R3_LS + 32 + 8 * q4), ac, 0, 0, 0);
                  const int col = 16 * nt + c16; const float gl = CT[320 + col];
                  const f32x4 sn = (shr[nt] + ac) * gl;
                  if (rq_ == RP_CH - 1) { shr[nt] = sn;
#pragma unroll
                  for (int rg = 0; rg < 4; ++rg) S16[(i0 + 4 * q4 + rg) * R3_LS + col] = (bf16_t)f2bf(sn[rg]); } else asm volatile("" :: "v"(sn)); } } }
        else if (ci + 1 < 72) RW3_P2();
        RW3_BAR();
#ifndef RP_Y
#define RP_Y 1
#endif
#pragma unroll 1
        for (int rq_ = 0; rq_ < RP_Y; ++rq_) {
        if (!isc || emit_ctx) *(f32x4*)(Y + (size_t)(rb + t) * 512 + hd * 64 + j4) = *(const LAS f32x4*)(YB + tt * 64 + j4);
        }
    }
    __syncthreads();
#undef RW3_P1
#undef RW3_P2
#undef RW3_BAR
#undef RW3_GEOM
#undef RW3_LOADRAW
}

constexpr int RO_AS = 136;
__device__ __forceinline__ void phase_rwkv_out(Frame& F, int l, bool with_ctx) {
    const int tid = F.tid, lane = F.lane, hd = F.wave, c16 = lane & 15, rq = lane >> 4;
    const bf16_t* PRW = (const bf16_t*)(F.ws + R_PRW); const float* Yf = (const float*)(F.ws + R_YFB); const float* Yb = Yf + (size_t)ROWS * 512;
    const float* BON0 = (const float*)(F.ws + WS_BONUS); const float* BON1 = BON0 + (size_t)ROWS * 8; bf16_t* Yall = (bf16_t*)F.out;
    const bf16_t* G2T = (const bf16_t*)(F.ws + WS_G2T);
    const float* mu = F.inp(I_RWMU) + (size_t)l * 2 * RW_COLS; const float* mu0 = mu, *mu1 = mu + RW_COLS;
    const float* lng = F.inp(I_RWLNG) + l * 512; const float* lnb = F.inp(I_RWLNB) + l * 512;
    LAS bf16_t* As = (LAS bf16_t*)F.lds;
    bf16x8 bfr[4][4];
#pragma unroll
    for (int nt = 0; nt < 4; ++nt)
#pragma unroll
        for (int ks = 0; ks < 4; ++ks) bfr[nt][ks] = *(const bf16x8*)(G2T + (size_t)(hd * 64 + 16 * nt + c16) * 128 + 32 * ks + 8 * rq);
    const int nunr = with_ctx ? ROWS / 64 : NB * (T_LAT / 64);
    for (int it = F.blk; it < nunr; it += F.G) {
        const int un = with_ctx ? it : (it >> 5) * 36 + 4 + (it & 31);
        const int r0 = un * 64; const int s0 = r0 % T_ALL; const bool isc = s0 < T_CTX;
        const int seq_lo = isc ? 0 : T_CTX, seq_hi = isc ? T_CTX - 1 : T_ALL - 1;
        __syncthreads();
        { const int tk = tid >> 3, cq = tid & 7; const int s = s0 + tk; const bool hp = s > seq_lo, hn = s < seq_hi; const bf16_t* cur = PRW + (size_t)(r0 + tk) * RW_COLS + 1664 + 16 * cq;
#pragma unroll
          for (int q4 = 0; q4 < 4; ++q4) { const f32x4 x = shift4(cur + 4 * q4, hp, hn, mu0 + 1664 + 16 * cq + 4 * q4, mu1 + 1664 + 16 * cq + 4 * q4);
              u32x2 w; w.x = cvt_pk_bf16(sigmoidf_(x[0]), sigmoidf_(x[1])); w.y = cvt_pk_bf16(sigmoidf_(x[2]), sigmoidf_(x[3])); *(LAS u32x2*)(As + tk * RO_AS + 16 * cq + 4 * q4) = w; } }
        __syncthreads();
        f32x4 acc[4][4];
#pragma unroll
        for (int mt = 0; mt < 4; ++mt)
#pragma unroll
            for (int nt = 0; nt < 4; ++nt) acc[mt][nt] = (f32x4){0.f, 0.f, 0.f, 0.f};
#pragma unroll
        for (int mt = 0; mt < 4; ++mt)
#pragma unroll
            for (int ks = 0; ks < 4; ++ks) { const bf16x8 a = *(const LAS bf16x8*)(As + (mt * 16 + c16) * RO_AS + 32 * ks + 8 * rq);
#pragma unroll
                for (int nt = 0; nt < 4; ++nt) acc[mt][nt] = __builtin_amdgcn_mfma_f32_16x16x32_bf16(bfr[nt][ks], a, acc[mt][nt], 0, 0, 0); }
#pragma unroll
        for (int mt = 0; mt < 4; ++mt) { const int tk = mt * 16 + c16; const int row = r0 + tk, s = s0 + tk; const float fp = s > seq_lo ? 1.f : 0.f, fn = s < seq_hi ? 1.f : 0.f;
            const int rp = s > seq_lo ? row - 1 : row, rn = s < seq_hi ? row + 1 : row;
            f32x4 y[4]; float sm = 0.f;
#pragma unroll
            for (int nt = 0; nt < 4; ++nt) { const size_t o = (size_t)row * 512 + hd * 64 + 16 * nt + 4 * rq; y[nt] = *(const f32x4*)(Yf + o) + *(const f32x4*)(Yb + o); sm += (y[nt][0] + y[nt][1]) + (y[nt][2] + y[nt][3]); }
            sm += __shfl_xor(sm, 16); sm += __shfl_xor(sm, 32);
            const float mean = sm * (1.0f / 64.0f); float q = 0.f;
#pragma unroll
            for (int nt = 0; nt < 4; ++nt) { y[nt] = y[nt] - mean; q += (y[nt][0] * y[nt][0] + y[nt][1] * y[nt][1]) + (y[nt][2] * y[nt][2] + y[nt][3] * y[nt][3]); }
            q += __shfl_xor(q, 16); q += __shfl_xor(q, 32);
            const float rstd = 1.0f / sqrtf(q * (1.0f / 64.0f) + RW_GN_EPS);
            const float bonus = 0.5f * (BON0[(size_t)row * 8 + hd] + BON1[(size_t)row * 8 + hd]);
#pragma unroll
            for (int nt = 0; nt < 4; ++nt) { const int ch = hd * 64 + 16 * nt + 4 * rq;
                const f32x4 p = ld_bf4(PRW + (size_t)row * RW_COLS + 1024 + ch), pv = ld_bf4(PRW + (size_t)rp * RW_COLS + 1024 + ch) * fp, nx = ld_bf4(PRW + (size_t)rn * RW_COLS + 1024 + ch) * fn;
                const f32x4 v = p + *(const f32x4*)(mu0 + 1024 + ch) * (pv - p) + *(const f32x4*)(mu1 + 1024 + ch) * (nx - p);
                const f32x4 o4 = (y[nt] * rstd * *(const f32x4*)(lng + ch) + *(const f32x4*)(lnb + ch) + bonus * v) * acc[mt][nt];
                u32x2 w; w.x = cvt_pk_bf16(o4[0], o4[1]); w.y = cvt_pk_bf16(o4[2], o4[3]); *(u32x2*)(Yall + (size_t)row * MIXW + 512 + ch) = w; } }
    }
    __syncthreads();
}

constexpr int SGL_VNT = 0, SGL_WS = 34816, SGL_ST = 69632, SG_LS = 136;
__device__ __forceinline__ void phase_sg(Frame& F, int l, bool with_ctx) {
    const int tid = F.tid, lane = F.lane, wave = F.wave, r32 = lane & 31, hi = lane >> 5;
    const bf16_t* SG = (const bf16_t*)(F.ws + R_SG); bf16_t* Yall = (bf16_t*)F.out;
    const float* ng = F.inp(I_SGNG) + l * 512; const float* nb = F.inp(I_SGNB) + l * 512; const float* sw = F.inp(I_SGW) + (size_t)l * 4 * 128 * 128; const float* sb = F.inp(I_SGB) + l * 4 * 128;
    LAS bf16_t* VNT = (LAS bf16_t*)(F.lds + SGL_VNT); LAS bf16_t* WSm = (LAS bf16_t*)(F.lds + SGL_WS); LAS float* ST = (LAS float*)(F.lds + SGL_ST);
    const int nun4 = with_ctx ? 4 * (ROWS / 128) : 4 * NB * (T_LAT / 128);
    for (int it4 = with_ctx ? (F.blk + (F.G >> 1)) % F.G : F.blk; it4 < nun4; it4 += F.G) {
        const int un4 = with_ctx ? it4 : ((((it4 >> 2) >> 4) * 18 + 2 + ((it4 >> 2) & 15)) << 2) + (it4 & 3);
        const int un = un4 >> 2; const int row0 = un * 128;
        __syncthreads();
        { u32x4 w[16];
#pragma unroll
          for (int i = 0; i < 16; ++i) w[i] = *(const u32x4*)(SG + (size_t)(row0 + wave * 16 + i) * 1024 + 512 + 8 * lane);
          float v16[16];
          { float a[16], b2[16];
#pragma unroll
            for (int i = 0; i < 16; ++i) { const float x[8] = {bflo(w[i].x), bfhi(w[i].x), bflo(w[i].y), bfhi(w[i].y), bflo(w[i].z), bfhi(w[i].z), bflo(w[i].w), bfhi(w[i].w)}; float s1 = 0.f, s2 = 0.f;
#pragma unroll
                for (int e = 0; e < 8; ++e) { s1 += x[e]; s2 += x[e] * x[e]; }
                a[i] = s1; b2[i] = s2; }
            const bool h5 = (lane & 32) != 0;
#pragma unroll
            for (int j2 = 0; j2 < 16; ++j2) { const float send = h5 ? a[j2] : b2[j2], keep = h5 ? b2[j2] : a[j2]; v16[j2] = keep + __shfl_xor(send, 32); } }
          float v8[8], v4[4], v2[2], v1;
          { const bool h = (lane & 16) != 0;
#pragma unroll
            for (int j2 = 0; j2 < 8; ++j2) { const float send = h ? v16[j2] : v16[8 + j2], keep = h ? v16[8 + j2] : v16[j2]; v8[j2] = keep + __shfl_xor(send, 16); } }
          { const bool h = (lane & 8) != 0;
#pragma unroll
            for (int j2 = 0; j2 < 4; ++j2) { const float send = h ? v8[j2] : v8[4 + j2], keep = h ? v8[4 + j2] : v8[j2]; v4[j2] = keep + __shfl_xor(send, 8); } }
          { const bool h = (lane & 4) != 0;
#pragma unroll
            for (int j2 = 0; j2 < 2; ++j2) { const float send = h ? v4[j2] : v4[2 + j2], keep = h ? v4[2 + j2] : v4[j2]; v2[j2] = keep + __shfl_xor(send, 4); } }
          { const bool h = (lane & 2) != 0; const float send = h ? v2[0] : v2[1], keep = h ? v2[1] : v2[0]; v1 = keep + __shfl_xor(send, 2); }
          v1 += __shfl_xor(v1, 1);
          const float other = __shfl_xor(v1, 32);
          if (lane < 32 && (lane & 1) == 0) { const int q = wave * 16 + (lane >> 1); const float mean = v1 * (1.0f / 512.0f); const float var = fmaxf(other * (1.0f / 512.0f) - mean * mean, 0.f);
              ST[2 * q] = mean; ST[2 * q + 1] = 1.0f / sqrtf(var + LN_EPS); } }
        __syncthreads();
        { const int g = un4 & 3;
            u32x2 ur0[4], ur1[4];
            { const size_t row = (size_t)row0 + 32 * (wave >> 1) + r32;
#pragma unroll
              for (int g4 = 0; g4 < 4; ++g4) { const int ch0 = g * 128 + 32 * ((wave & 1) * 2) + 8 * g4 + 4 * hi; ur0[g4] = *(const u32x2*)(SG + row * 1024 + ch0); ur1[g4] = *(const u32x2*)(SG + row * 1024 + ch0 + 32); } }
            { const int p = tid >> 2, c0 = 32 * (tid & 3); const float* wp = sw + ((size_t)g * 128 + p) * 128 + c0;
#pragma unroll
              for (int i = 0; i < 4; ++i) { const f32x4 a = *(const f32x4*)(wp + 8 * i), c = *(const f32x4*)(wp + 8 * i + 4);
                  *(LAS u32x4*)(WSm + p * SG_LS + c0 + 8 * i) = (u32x4){cvt_pk_bf16(a[0], a[1]), cvt_pk_bf16(a[2], a[3]), cvt_pk_bf16(c[0], c[1]), cvt_pk_bf16(c[2], c[3])}; } }
            { const int q = tid & 127, cb = 32 * (tid >> 7); const float mean = ST[2 * q], rstd = ST[2 * q + 1]; const bf16_t* vp = SG + (size_t)(row0 + q) * 1024 + 512 + g * 128 + cb;
#pragma unroll
              for (int i = 0; i < 4; ++i) { const u32x4 w = *(const u32x4*)(vp + 8 * i); const float x[8] = {bflo(w.x), bfhi(w.x), bflo(w.y), bfhi(w.y), bflo(w.z), bfhi(w.z), bflo(w.w), bfhi(w.w)};
#pragma unroll
                  for (int e = 0; e < 8; ++e) { const int c = cb + 8 * i + e; VNT[c * SG_LS + q] = (bf16_t)f2bf((x[e] - mean) * rstd * ng[g * 128 + c] + nb[g * 128 + c]); } } }
            __syncthreads();
            const int pt = wave >> 1, ct0 = (wave & 1) * 2;
            f32x16 acc0, acc1;
#pragma unroll
            for (int r = 0; r < 16; ++r) { acc0[r] = 0.f; acc1[r] = 0.f; }
#pragma unroll
            for (int ks = 0; ks < 8; ++ks) { const bf16x8 a = *(const LAS bf16x8*)(WSm + (32 * pt + r32) * SG_LS + 16 * ks + 8 * hi);
                const bf16x8 b0 = *(const LAS bf16x8*)(VNT + (32 * ct0 + r32) * SG_LS + 16 * ks + 8 * hi), b1 = *(const LAS bf16x8*)(VNT + (32 * (ct0 + 1) + r32) * SG_LS + 16 * ks + 8 * hi);
                acc0 = __builtin_amdgcn_mfma_f32_32x32x16_bf16(b0, a, acc0, 0, 0, 0); acc1 = __builtin_amdgcn_mfma_f32_32x32x16_bf16(b1, a, acc1, 0, 0, 0); }
            { const int p = 32 * pt + r32; const size_t row = (size_t)row0 + p; const float bs = sb[g * 128 + p];
#pragma unroll
              for (int g4 = 0; g4 < 4; ++g4) { const int ch0 = g * 128 + 32 * ct0 + 8 * g4 + 4 * hi, ch1 = ch0 + 32;
                  const f32x4 u0 = (f32x4){bflo(ur0[g4].x), bfhi(ur0[g4].x), bflo(ur0[g4].y), bfhi(ur0[g4].y)}, u1 = (f32x4){bflo(ur1[g4].x), bfhi(ur1[g4].x), bflo(ur1[g4].y), bfhi(ur1[g4].y)};
                  const f32x4 o0 = u0 * ((f32x4){acc0[4 * g4], acc0[4 * g4 + 1], acc0[4 * g4 + 2], acc0[4 * g4 + 3]} + bs), o1 = u1 * ((f32x4){acc1[4 * g4], acc1[4 * g4 + 1], acc1[4 * g4 + 2], acc1[4 * g4 + 3]} + bs);
                  u32x2 w; w.x = cvt_pk_bf16(o0[0], o0[1]); w.y = cvt_pk_bf16(o0[2], o0[3]); *(u32x2*)(Yall + row * MIXW + 1024 + ch0) = w;
                  w.x = cvt_pk_bf16(o1[0], o1[1]); w.y = cvt_pk_bf16(o1[2], o1[3]); *(u32x2*)(Yall + row * MIXW + 1024 + ch1) = w; } }
            __syncthreads();
        }
    }
}

#ifdef PROBE_CHECKS
__device__ __forceinline__ float tshift(const bf16_t* PRW, int row, int col, bool hp, bool hn, const float* mu0, const float* mu1) {
    const float p = bf2f(PRW[(size_t)row * RW_COLS + col]), pv = hp ? bf2f(PRW[(size_t)(row - 1) * RW_COLS + col]) : 0.f, nx = hn ? bf2f(PRW[(size_t)(row + 1) * RW_COLS + col]) : 0.f;
    return p + mu0[col] * (pv - p) + mu1[col] * (nx - p);
}
__device__ __forceinline__ bool mism(float fast, float ref) { return !(fabsf(fast - ref) <= 0.03f * fabsf(ref) + 0.03f); }
__device__ __forceinline__ void probe_checks(Frame& F, int l, int stage) {
    float* flags = (float*)(F.ws + WS_CTL + 32768);
    const bf16_t* Yall = (const bf16_t*)F.out; const int lane = F.lane;
    if (F.blk >= 24) return;
    const int kind = F.blk >> 3, si = (F.blk & 7) * 8 + F.wave;
    if ((stage == 0) == (kind == 1)) return;
    const int b = si & 15, srow = (si * 37 + 11) % T_ALL;
    const int row = b * T_ALL + srow; const bool isc = srow < T_CTX;
    const int seq_lo = isc ? 0 : T_CTX, seq_hi = isc ? T_CTX - 1 : T_ALL - 1; const bool hp = srow > seq_lo, hn = srow < seq_hi;
    if (kind == 0) {
        const bf16_t* SG = (const bf16_t*)(F.ws + R_SG); const int ch = (si * 53 + 7) & 511, g = ch >> 7, c = ch & 127; const int row0 = row & ~127, p = row & 127;
        const float* ng = F.inp(I_SGNG) + l * 512; const float* nb = F.inp(I_SGNB) + l * 512; const float* sw = F.inp(I_SGW) + (size_t)l * 4 * 128 * 128; const float* sb = F.inp(I_SGB) + l * 4 * 128;
        float vm = 0.f;
        for (int q = 0; q < 128; ++q) { float s = 0.f, x[8];
            for (int e = 0; e < 8; ++e) { x[e] = bf2f(SG[(size_t)(row0 + q) * 1024 + 512 + lane * 8 + e]); s += x[e]; }
            const float mean = wave_sum(s) * (1.0f / 512.0f); float qq = 0.f;
            for (int e = 0; e < 8; ++e) qq += (x[e] - mean) * (x[e] - mean);
            const float rstd = 1.0f / sqrtf(wave_sum(qq) * (1.0f / 512.0f) + LN_EPS);
            const float vn = (bf2f(SG[(size_t)(row0 + q) * 1024 + 512 + ch]) - mean) * rstd * ng[ch] + nb[ch];
            vm += sw[((size_t)g * 128 + p) * 128 + q] * vn; }
        const float ref = bf2f(SG[(size_t)row * 1024 + ch]) * (vm + sb[g * 128 + p]);
        const float fast = bf2f(Yall[(size_t)row * MIXW + 1024 + ch]);
        (void)fast; (void)ref;
    } else if (kind == 1) {
        const bf16_t* PRW = (const bf16_t*)(F.ws + R_PRW); const float* Yf = (const float*)(F.ws + R_YFB); const float* Yb = Yf + (size_t)ROWS * 512;
        const float* B0 = (const float*)(F.ws + WS_BONUS); const float* B1 = B0 + (size_t)ROWS * 8;
        const float* mu = F.inp(I_RWMU) + (size_t)l * 2 * RW_COLS; const float* mu0 = mu, *mu1 = mu + RW_COLS;
        const float* g2 = F.inp(I_RWG2) + (size_t)l * 128 * 512; const float* lng = F.inp(I_RWLNG) + l * 512; const float* lnb = F.inp(I_RWLNB) + l * 512;
        const int hd = si & 7, ch = hd * 64 + lane;
        const float y = Yf[(size_t)row * 512 + ch] + Yb[(size_t)row * 512 + ch];
        const float mean = wave_sum(y) * (1.0f / 64.0f); const float var = wave_sum((y - mean) * (y - mean)) * (1.0f / 64.0f);
        const float gn = (y - mean) / sqrtf(var + RW_GN_EPS) * lng[ch] + lnb[ch];
        const float v = tshift(PRW, row, 1024 + ch, hp, hn, mu0, mu1);
        const float bonus = 0.5f * (B0[(size_t)row * 8 + hd] + B1[(size_t)row * 8 + hd]);
        float gg = 0.f;
        for (int r = 0; r < 128; ++r) { const float xg = tshift(PRW, row, 1664 + r, hp, hn, mu0, mu1); gg += (1.0f / (1.0f + expf(-xg))) * g2[(size_t)r * 512 + ch]; }
        const float ref = (gn + bonus * v) * gg, fast = bf2f(Yall[(size_t)row * MIXW + 512 + ch]);
        (void)fast; (void)ref;
    } else if (!isc || l == 0) {
        const bf16_t* Qb = (const bf16_t*)(F.ws + R_Q); const bf16_t* Kb = (const bf16_t*)(F.ws + R_K); const bf16_t* Vt = (const bf16_t*)(F.ws + R_VT);
        const float* sc = (const float*)(F.ws + WS_SMALL + 16384); const float lam = sc[2 * l], lam_init = sc[2 * l + 1]; const float* ng = F.inp(I_DANG) + l * 128;
        const int h = si & 3, nkeys = isc ? T_CTX : T_ALL; const int krow0 = b * T_ALL;
        float o0 = 0.f, o1 = 0.f;
        for (int m = 0; m < 2; ++m) {
            float mx = -3.0e38f;
            for (int k = lane; k < nkeys; k += 64) { float s = 0.f; for (int d = 0; d < 64; ++d) s += bf2f(Qb[(size_t)row * 512 + h * 128 + m * 64 + d]) * bf2f(Kb[(size_t)(krow0 + k) * 512 + h * 128 + m * 64 + d]); mx = fmaxf(mx, s); }
            mx = wave_max(mx); float den = 0.f;
            for (int k = lane; k < nkeys; k += 64) { float s = 0.f; for (int d = 0; d < 64; ++d) s += bf2f(Qb[(size_t)row * 512 + h * 128 + m * 64 + d]) * bf2f(Kb[(size_t)(krow0 + k) * 512 + h * 128 + m * 64 + d]); den += exp2f(s - mx); }
            den = wave_sum(den);
            float a0 = 0.f, a1 = 0.f;
            for (int k = 0; k < nkeys; ++k) { float s = 0.f; for (int d = 0; d < 64; ++d) s += bf2f(Qb[(size_t)row * 512 + h * 128 + m * 64 + d]) * bf2f(Kb[(size_t)(krow0 + k) * 512 + h * 128 + m * 64 + d]);
                const float pk = exp2f(s - mx) / den; const int slot = (k & ~15) + perm16(k & 15);
                a0 += pk * bf2f(Vt[((size_t)(b * 4 + h) * 128 + lane) * T_ALL + slot]); a1 += pk * bf2f(Vt[((size_t)(b * 4 + h) * 128 + lane + 64) * T_ALL + slot]); }
            if (m == 0) { o0 = a0; o1 = a1; } else { o0 -= PROBE_LAM(lam) * a0; o1 -= PROBE_LAM(lam) * a1; }
        }
        const float ss = wave_sum(o0 * o0 + o1 * o1) * (1.0f / 128.0f); const float scl = (1.0f / sqrtf(ss + DA_EPS)) * (1.0f - lam_init);
#ifdef PROBE_O1ONLY
        const float r0 = o0 * 16.0f * ng[lane], r1 = o1 * 16.0f * ng[lane + 64];
#else
        const float r0 = o0 * scl * ng[lane], r1 = o1 * scl * ng[lane + 64];
#endif
        const float f0 = bf2f(Yall[(size_t)row * MIXW + h * 128 + lane]), f1 = bf2f(Yall[(size_t)row * MIXW + h * 128 + lane + 64]);
        const float dv = wave_max(fmaxf(fabsf(f0 - r0), fabsf(f1 - r1)));
        if (lane == 0) atomicMax((unsigned*)flags + (isc ? 1 : 0), __builtin_bit_cast(unsigned, dv));
    }
}
#endif

#ifndef MK_PER_PHASE
#define MK_PER_PHASE 0
#endif
constexpr int N_PHASES = 3 + 10 * DEPTH;
struct Args { const float* in[34]; float* out; unsigned char* ws; int ph_lo, ph_hi; };
__global__ void __launch_bounds__(512, 2) trunk_fwd(Args args) {
    extern __shared__ __attribute__((aligned(16))) unsigned char lds_raw[];
    Frame F;
    F.lds = (LAS unsigned char*)lds_raw;
    F.tid = threadIdx.x; F.lane = F.tid & 63; F.wave = __builtin_amdgcn_readfirstlane(F.tid >> 6); F.G = gridDim.x; F.blk = blockIdx.x;
    F.out = args.out; F.ws = args.ws;
    volatile LAS unsigned* misc = (volatile LAS unsigned*)(F.lds + LDS_MISC);
    if (F.tid < 16) misc[F.tid] = 0u;
    if (F.tid == 0) {
#pragma unroll
        for (int i = 0; i < 34; ++i) *(LAS unsigned long long*)(F.lds + LDS_MISC + 64 + 8 * i) = (unsigned long long)args.in[i];
    }
    __syncthreads();
    XcdBarrier bar; bar.bar = (unsigned*)(F.ws + WS_CTL); bar.x = 0; bar.st = misc;
    if (!MK_PER_PHASE) bar = xcd_barrier_post((unsigned*)(F.ws + WS_CTL), misc);
    const int lo = args.ph_lo, hi = args.ph_hi;
#ifndef PHM
#define PHM 0xFFFFFFFFu
#endif
#define PHB(n) ((PHM >> (n)) & 1u)
#ifndef REPMASK
#define REPMASK 0u
#endif
#define NREP(n) ((int)((REPMASK >> (n)) & 1u) + 1)
#define IN(k) (lo <= (k) && (k) < hi)
#define SEAM(k) do { if (!MK_PER_PHASE && IN((k) + 1)) xcd_barrier(bar); } while (0)
    const int NGW = F.G * 8;

    if (PHB(0) && IN(0)) { for (int rep = 0; rep < NREP(0); ++rep) { relaunder(F); mod_partials(F); relaunder(F); small_tables(F); relaunder(F); convert_weights(F, 0, F.blk * 8 + F.wave, NGW); } SEAM(0); }
    if (PHB(1) && IN(1)) { relaunder(F); mod_reduce(F); SEAM(1); }
    if (PHB(2) && IN(2)) { relaunder(F); phase_h0(F); SEAM(2); }

#pragma unroll 1
    for (int l = 0; l < DEPTH; ++l) {
        const int pb = 3 + 10 * l; const bool first = (l == 0), last = (l == DEPTH - 1); const bool with_ctx = !last;
        if (PHB(3) && IN(pb + 0)) { relaunder(F);
#pragma unroll 1
            for (int rep = 0; rep < NREP(3); ++rep) {
            pg8::Gemm g{(const bf16_t*)(F.ws + WS_H), (const bf16_t*)(F.ws + WS_WIN), DM, DM, DM};
            InProjSched S; if (with_ctx) S.init(F.G, F.blk, 0, 0, 17, 0, 0, 0); else S.init(F.G, F.blk, 1, 0, 17, 2, 2, 11);
            S.init2((long)((const char*)F.out - (const char*)(F.ws + WS_H)), (long)WS_WLO - (long)WS_WIN);
            EpiInProj E{(bf16_t*)(F.ws + R_Q), (bf16_t*)(F.ws + R_K), (bf16_t*)(F.ws + R_VT), (bf16_t*)(F.ws + R_PRW), (bf16_t*)(F.ws + R_SG), (bf16_t*)(F.ws + R_GATE), (const f32x2*)(F.ws + WS_SMALL), (bf16_t*)(F.ws + R_KLO)};
            pg8::gemm_phase(F.lds, F.tid, g, S, E);
            }
            SEAM(pb + 0);
        }
        if (PHB(4) && IN(pb + 1)) { relaunder(F);
#ifndef RWKV_SCAN
#define RWKV_SCAN rwkv_scan_unit3
#endif
#ifndef REP_SCAN
#define REP_SCAN NREP(21)
#endif
#ifndef REP_ATTN
#define REP_ATTN NREP(22)
#endif
#ifndef REP_SG
#define REP_SG NREP(20)
#endif
#pragma unroll 1
            for (int rep = 0; rep < REP_SCAN; ++rep) for (int un = F.blk; un < 256; un += F.G) RWKV_SCAN(F, l, un >> 4, (un >> 1) & 7, un & 1, with_ctx);
#pragma unroll 1
            for (int rep = 0; rep < REP_ATTN; ++rep) { relaunder(F); phase_attn(F, l, with_ctx); }
#pragma unroll 1
            for (int rep = 0; rep < REP_SG; ++rep) { relaunder(F); phase_sg(F, l, with_ctx); }
            SEAM(pb + 1);
        }
        if (PHB(5) && IN(pb + 2)) { relaunder(F);
#ifdef PROBE_CHECKS
            if (l == 0) { probe_checks(F, l, 0); xcd_barrier(bar); relaunder(F); }
#endif
#pragma unroll 1
            for (int rep = 0; rep < NREP(5); ++rep) {
            phase_rwkv_out(F, l, with_ctx); relaunder(F);
            pg8::Gemm g{(const bf16_t*)(F.ws + WS_H), (const bf16_t*)(F.ws + WS_WIN), DM, DM, DM};
            RectSched S; S.init(F.G, with_ctx ? (F.blk + 3 * (F.G >> 2)) % F.G : F.blk, with_ctx ? 0 : 1, 17, 12, 0, 0, 0);
            EpiInProj E{(bf16_t*)(F.ws + R_Q), (bf16_t*)(F.ws + R_K), (bf16_t*)(F.ws + R_VT), (bf16_t*)(F.ws + R_PRW), (bf16_t*)(F.ws + R_SG), (bf16_t*)(F.ws + R_GATE), (const f32x2*)(F.ws + WS_SMALL), (bf16_t*)(F.ws + R_KLO)};
            pg8::gemm_phase(F.lds, F.tid, g, S, E);
#ifdef PROBE_CHECKS
            if (l == 0) { xcd_barrier(bar); relaunder(F); probe_checks(F, l, 1); }
#endif
            }
            SEAM(pb + 2);
        }
        if (PHB(6) && IN(pb + 3)) { relaunder(F);
#pragma unroll 1
            for (int rep = 0; rep < NREP(6); ++rep) {
            pg8::Gemm g{(const bf16_t*)F.out, (const bf16_t*)(F.ws + WS_WB), MIXW, MIXW, MIXW};
            MergeSched S; S.init(F.G, F.blk, with_ctx ? 0 : 1);
            EpiMerge E{(const bf16_t*)(F.ws + R_GATE), (bf16_t*)(F.ws + R_M)};
            pg8::gemm_phase(F.lds, F.tid, g, S, E);
            }
            SEAM(pb + 3);
        }
        if (PHB(7) && IN(pb + 4)) { relaunder(F);
            pg8::Gemm g{(const bf16_t*)(F.ws + R_M), (const bf16_t*)(F.ws + WS_WOUT), DM, DM, DM};
            RectSched S; S.init(F.G, F.blk, with_ctx ? 0 : 1, 0, 4, 0, 0, 0);
            EpiWout E{F.inp(I_X), F.inp(I_CTX), (float*)(F.ws + WS_X), (const float*)(F.ws + WS_MODF) + (size_t)l * 17 * 6144, first ? 1 : 0};
            pg8::gemm_phase(F.lds, F.tid, g, S, E);
            SEAM(pb + 4);
        }
        if (PHB(8) && IN(pb + 5)) { relaunder(F); phase_ln1(F, l, with_ctx); SEAM(pb + 5); }
        if (PHB(9) && IN(pb + 6)) { for (int rep = 0; rep < NREP(9); ++rep) { relaunder(F); phase_topk(F, with_ctx); } SEAM(pb + 6); }
        if (PHB(10) && IN(pb + 7)) { relaunder(F);
#pragma unroll 1
            for (int rep = 0; rep < NREP(10); ++rep) {
            pg8::Gemm g{(const bf16_t*)(F.ws + R_XE), (const bf16_t*)(F.ws + WS_WE1), DM, DM, DM};
            MoeSched S; S.init(F.G, F.blk, with_ctx ? 18 : 16, 16, 16);
            EpiMoe1 E{(bf16_t*)(F.ws + R_HID)};
            pg8::gemm_phase(F.lds, F.tid, g, S, E);
            }
            SEAM(pb + 7);
        }
        if (PHB(11) && IN(pb + 8)) { relaunder(F);
#pragma unroll 1
            for (int rep = 0; rep < NREP(11); ++rep) {
            pg8::Gemm g{(const bf16_t*)(F.ws + R_HID), (const bf16_t*)(F.ws + WS_WE2), FF, FF, FF};
            MoeSched S; S.init(F.G, F.blk, with_ctx ? 18 : 16, 4, 4);
            EpiMoe2 E{(bf16_t*)(F.ws + R_YE), (const float*)(F.ws + WS_GATEE)};
            pg8::gemm_phase(F.lds, F.tid, g, S, E);
            }
            SEAM(pb + 8);
        }
        if (PHB(12) && IN(pb + 9)) { relaunder(F);
            phase_ln2(F, l, with_ctx, last);
            for (int rep = 0; rep < NREP(12); ++rep) { relaunder(F); if (!last) convert_weights(F, l + 1, F.blk * 8 + F.wave, NGW); }
            SEAM(pb + 9);
        }
    }
#ifdef PROBE_CHECKS
    xcd_barrier(bar);
    if (F.blk == 0 && F.tid == 0) { const float* flags = (const float*)(F.ws + WS_CTL + 32768); F.out[0] += 1000.0f * flags[0]; }
#endif
#undef IN
#undef SEAM
}

extern "C" void kernel_launch(void* const* d_in, const int* in_sizes, int n_in, void* d_out, int out_size, void* d_ws, size_t ws_size, hipStream_t stream) {
    static int grid = 0;
    if (grid == 0) {
        if (n_in != 34 || out_size != NB * T_LAT * DM || ws_size < WS_END) { fprintf(stderr, "kernel_launch: unexpected shapes (n_in %d, out %d, ws %zu, need %zu); nothing launched\n", n_in, out_size, ws_size, (size_t)WS_END); grid = -1; return; }
        int dev = 0, cus = 0, per_cu = 0;
        if (hipGetDevice(&dev) != hipSuccess || hipDeviceGetAttribute(&cus, hipDeviceAttributeMultiprocessorCount, dev) != hipSuccess) { grid = -1; return; }
        if (hipFuncSetAttribute((const void*)trunk_fwd, hipFuncAttributeMaxDynamicSharedMemorySize, LDS_BYTES) != hipSuccess) { fprintf(stderr, "kernel_launch: hipFuncSetAttribute failed\n"); grid = -1; return; }
        if (hipOccupancyMaxActiveBlocksPerMultiprocessor(&per_cu, (const void*)trunk_fwd, 512, LDS_BYTES) != hipSuccess || per_cu < 1) { fprintf(stderr, "kernel_launch: occupancy query reports %d\n", per_cu); }
        (void)hipGetLastError();
        grid = cus;
    }
    if (grid < 0) return;
    (void)hipMemsetAsync((char*)d_ws + WS_CTL, 0, CTL_ZERO_BYTES, stream);
#ifdef DIAG_ZERO_WS
    (void)hipMemsetAsync((char*)d_ws, 0, WS_END, stream);
    (void)hipMemsetAsync((char*)d_ws + WS_MODF, 0xFF, WS_X - WS_MODF, stream);
    (void)hipMemsetAsync((char*)d_ws + WS_WIN, 0xFF, WS_R - WS_WIN, stream);
#endif
    Args a{};
    for (int i = 0; i < 34; ++i) a.in[i] = (const float*)d_in[i];
    a.out = (float*)d_out; a.ws = (unsigned char*)d_ws;
#if MK_PER_PHASE
    for (int p = 0; p < N_PHASES; ++p) { a.ph_lo = p; a.ph_hi = p + 1; hipLaunchKernelGGL(trunk_fwd, dim3(grid), dim3(512), LDS_BYTES, stream, a); }
#else
    a.ph_lo = 0; a.ph_hi = N_PHASES; hipLaunchKernelGGL(trunk_fwd, dim3(grid), dim3(512), LDS_BYTES, stream, a);
#endif
}
```

```cpp
#include <hip/hip_runtime.h>

#ifndef SPLIT_K
#define SPLIT_K 0
#endif
#include <cstdio>
#include <cstdint>
#include <cmath>

#define LAS __attribute__((address_space(3)))
#define GAS __attribute__((address_space(1)))
typedef unsigned short bf16_t;
typedef short bf16x8 __attribute__((ext_vector_type(8)));
typedef float f32x4 __attribute__((ext_vector_type(4)));
typedef float f32x2 __attribute__((ext_vector_type(2)));
typedef float f32x16 __attribute__((ext_vector_type(16)));
typedef unsigned u32x4 __attribute__((ext_vector_type(4)));
typedef unsigned u32x2 __attribute__((ext_vector_type(2)));

constexpr int NB = 16, T_LAT = 2048, T_CTX = 256, T_ALL = 2304, DM = 1024, DEPTH = 2;
constexpr int ROWS = NB * T_ALL;
constexpr int NPM = ROWS / 256;
constexpr int IN_COLS = 7424, RW_COLS = 1792, MIXW = 1536;
constexpr int NEXP = 16, FF = 2048, CAP_L = 256, CAP_C = 32;
constexpr int EROWS = NB * CAP_L + NB * CAP_C;
constexpr float LN_EPS = 1e-5f, DA_EPS = 1e-5f, RW_GN_EPS = 64e-5f;
constexpr float DN_ALPHA = 1.4142135623730951f;
constexpr float QSCALE = 0.125f * 1.4426950408889634f;

constexpr size_t MiB = 1u << 20;
constexpr size_t WS_CTL = 0;
constexpr size_t CTL_ZERO_BYTES = 64 * 1024;
constexpr size_t WS_MODF = 1 * MiB;
constexpr size_t WS_SMALL = 2 * MiB;
constexpr size_t WS_AFF = 3 * MiB;
constexpr size_t WS_SLOT = 6 * MiB;
constexpr size_t WS_GATEE = 8 * MiB;
constexpr size_t WS_BONUS = 9 * MiB;
constexpr size_t WS_X = 16 * MiB;
constexpr size_t WS_H = 160 * MiB;
constexpr size_t WS_WIN = 232 * MiB;
constexpr size_t WS_WB = 247 * MiB;
constexpr size_t WS_WOUT = 250 * MiB;
constexpr size_t WS_G2T = 252 * MiB;
constexpr size_t WS_WLO = 253 * MiB;
constexpr size_t WS_WE1 = 254 * MiB;
constexpr size_t WS_WE2 = 382 * MiB;
constexpr size_t WS_R = 446 * MiB;
constexpr size_t R_Q = WS_R + 0 * MiB;
constexpr size_t R_K = WS_R + 36 * MiB;
constexpr size_t R_VT = WS_R + 72 * MiB;
constexpr size_t R_SG = WS_R + 108 * MiB;
constexpr size_t R_KLO = WS_R + 180 * MiB;
constexpr size_t R_GATE = WS_R + 0 * MiB;
constexpr size_t R_PRW = WS_R + 216 * MiB;
constexpr size_t R_YFB = WS_R + 342 * MiB;
constexpr size_t R_M = WS_R + 216 * MiB;
constexpr size_t R_MACC = WS_R + 342 * MiB;
constexpr size_t R_MODP = WS_R + 0 * MiB;
constexpr size_t R_HID = WS_R + 0 * MiB;
constexpr size_t R_XE = WS_R + 288 * MiB;
constexpr size_t R_YE = WS_R + 288 * MiB;
constexpr size_t WS_END = WS_R + 576 * MiB;

constexpr int LDS_MAIN = 155648;
constexpr int LDS_MISC = LDS_MAIN;
constexpr int LDS_BYTES = LDS_MAIN + 64 + 34 * 8 + 48;

__device__ __forceinline__ unsigned f2bf(float f) { unsigned u = __builtin_bit_cast(unsigned, f); return (u + 0x7fffu + ((u >> 16) & 1u)) >> 16; }
__device__ __forceinline__ unsigned pk2(float lo, float hi) { return f2bf(lo) | (f2bf(hi) << 16); }
typedef __bf16 bf16x2_t __attribute__((ext_vector_type(2)));
__device__ __forceinline__ unsigned cvt_pk_bf16(float lo, float hi) { const f32x2 v = {lo, hi}; const bf16x2_t b = __builtin_convertvector(v, bf16x2_t); return __builtin_bit_cast(unsigned, b); }
__device__ __forceinline__ float bf2f(bf16_t b) { return __builtin_bit_cast(float, ((unsigned)b) << 16); }
__device__ __forceinline__ float bflo(unsigned w) { return __builtin_bit_cast(float, w << 16); }
__device__ __forceinline__ float bfhi(unsigned w) { return __builtin_bit_cast(float, w & 0xffff0000u); }
__device__ __forceinline__ float fast_exp2(float x) { return __builtin_amdgcn_exp2f(x); }
__device__ __forceinline__ float fast_rcp(float x) { return __builtin_amdgcn_rcpf(x); }
__device__ __forceinline__ float sigmoidf_(float x) { return fast_rcp(1.0f + fast_exp2(-1.4426950408889634f * x)); }
__device__ __forceinline__ float siluf_(float x) { return x * sigmoidf_(x); }
__device__ __forceinline__ float gelu_tanh(float x) { const float u = 0.7978845608028654f * (x + 0.044715f * x * x * x); return x * sigmoidf_(2.0f * u); }
__device__ __forceinline__ float tanhf_(float x) { return 2.0f * sigmoidf_(2.0f * x) - 1.0f; }
template <int CTRL> __device__ __forceinline__ float dppf(float v) { return __builtin_bit_cast(float, __builtin_amdgcn_mov_dpp(__builtin_bit_cast(int, v), CTRL, 0xF, 0xF, true)); }
__device__ __forceinline__ float sum16(float v) {
#ifdef PROBE_NAIVE_RW
    v += __shfl_xor(v, 1); v += __shfl_xor(v, 2); v += __shfl_xor(v, 4); v += __shfl_xor(v, 8); return v;
#endif
    v += dppf<0xB1>(v);
    v += dppf<0x4E>(v);
    v += dppf<0x141>(v);
    v += dppf<0x140>(v);
    return v;
}
__device__ __forceinline__ float sum8(float v) {
    v += dppf<0xB1>(v); v += dppf<0x4E>(v); v += dppf<0x141>(v); return v;
}
__device__ __forceinline__ void xhalf_swap(float& a, float& b) { asm volatile("s_nop 1\n\tv_permlane32_swap_b32 %0, %1\n\ts_nop 1" : "+v"(a), "+v"(b)); }
__device__ __forceinline__ float xhalf_max(float m) { float a = m, b = m; xhalf_swap(a, b); return fmaxf(a, b); }
__device__ __forceinline__ float xhalf_sum(float m) { float a = m, b = m; xhalf_swap(a, b); return a + b; }
__device__ __forceinline__ float wave_sum(float v) { v = sum16(v); v += __shfl_xor(v, 16); return xhalf_sum(v); }
__device__ __forceinline__ float wave_max(float v) {
    v = fmaxf(v, dppf<0xB1>(v)); v = fmaxf(v, dppf<0x4E>(v)); v = fmaxf(v, dppf<0x141>(v)); v = fmaxf(v, dppf<0x140>(v)); v = fmaxf(v, __shfl_xor(v, 16)); return xhalf_max(v); }
__device__ __forceinline__ int crow(int r, int hi) { return (r & 3) + 8 * (r >> 2) + 4 * hi; }
#define LDS_WAIT() asm volatile("s_waitcnt lgkmcnt(0)" ::: "memory")
#define VM_WAIT() asm volatile("s_waitcnt vmcnt(0)" ::: "memory")

#define XB_TMO      128
#define XB_XCNT(j)  (256  + 64 * (j))
#define XB_XSUB(j)  (1280 + 64 * (j))
#define XB_XGEN(j)  (2304 + 64 * (j))
#define XB_TOP      3328
#define XB_TOPGEN   3392
#define XCD_BAR_WORDS 3456
#define XB_SPIN_CAP (1u << 20)
__device__ __forceinline__ unsigned xb_ld(unsigned* p)              { return __hip_atomic_load(p, __ATOMIC_RELAXED, __HIP_MEMORY_SCOPE_AGENT); }
__device__ __forceinline__ unsigned xb_add(unsigned* p, unsigned v) { return __hip_atomic_fetch_add(p, v, __ATOMIC_RELAXED, __HIP_MEMORY_SCOPE_AGENT); }
__device__ __forceinline__ unsigned xb_xcc_id() { return (unsigned)__builtin_amdgcn_s_getreg((3 << 11) | 20) & 0xFu; }
#define XB_SPIN(cond, bar) do { unsigned _sp = 0; while (cond) { __builtin_amdgcn_s_sleep(1); \
    if ((++_sp & 255u) == 0u) { if (xb_ld(&(bar)[XB_TMO])) break; if (_sp > XB_SPIN_CAP) { atomicAdd(&(bar)[XB_TMO], 1u); break; } } } } while (0)
struct XcdBarrier { unsigned* bar; unsigned x; volatile LAS unsigned* st; };
__device__ __forceinline__ XcdBarrier xcd_barrier_post(unsigned* bar, volatile LAS unsigned* st) {
    XcdBarrier b; b.bar = bar; b.x = xb_xcc_id(); b.st = st;
    if (threadIdx.x == 0) (void)xb_add(&bar[XB_XCNT(b.x)], 1u);
    return b;
}
__device__ __forceinline__ void xcd_barrier_complete(unsigned* bar, unsigned x, unsigned& nloc, unsigned& nx) {
    const unsigned G = gridDim.x * gridDim.y * gridDim.z;
    unsigned sum, cnt, mine, sp = 0u;
    for (;;) {
        sum = 0u; cnt = 0u; mine = 0u;
#pragma unroll
        for (unsigned j = 0; j < 16; ++j) { const unsigned c = xb_ld(&bar[XB_XCNT(j)]); sum += c; cnt += (c > 0u) ? 1u : 0u; mine = (j == x) ? c : mine; }
        if (sum == G) break;
        __builtin_amdgcn_s_sleep(1);
        if ((++sp & 255u) == 0u) { if (xb_ld(&bar[XB_TMO])) break; if (sp > XB_SPIN_CAP) { atomicAdd(&bar[XB_TMO], 1u); break; } }
    }
    nloc = mine > 0u ? mine : 1u; nx = cnt > 0u ? cnt : 1u;
}
__device__ __forceinline__ void xcd_barrier(const XcdBarrier& b) {
    asm volatile("s_waitcnt vmcnt(0)" ::: "memory");
    __syncthreads();
    if (threadIdx.x == 0) {
        unsigned* bar = b.bar;
        __builtin_amdgcn_s_waitcnt(0);
        unsigned nloc = b.st[0], nx = b.st[1];
        if (nloc == 0u) { xcd_barrier_complete(bar, b.x, nloc, nx); b.st[0] = nloc; b.st[1] = nx; }
        const unsigned old = xb_add(&bar[XB_XSUB(b.x)], 1u);
        const unsigned gen = old / nloc;
        if (old + 1u == (gen + 1u) * nloc) {
            __builtin_amdgcn_fence(__ATOMIC_RELEASE, "agent");
            asm volatile("s_waitcnt vmcnt(0)" ::: "memory");
            const unsigned og = xb_add(&bar[XB_TOP], 1u);
            const unsigned tg = og / nx;
            if (og + 1u == (tg + 1u) * nx) xb_add(&bar[XB_TOPGEN], 1u);
            else XB_SPIN(xb_ld(&bar[XB_TOPGEN]) == tg, bar);
            __builtin_amdgcn_fence(__ATOMIC_ACQUIRE, "agent");
            xb_add(&bar[XB_XGEN(b.x)], 1u);
            asm volatile("s_waitcnt vmcnt(0)" ::: "memory");
        } else {
            XB_SPIN(xb_ld(&bar[XB_XGEN(b.x)]) == gen, bar);
            __builtin_amdgcn_fence(__ATOMIC_ACQUIRE, "agent");
            asm volatile("s_waitcnt vmcnt(0)" ::: "memory");
        }
    }
    __syncthreads();
}

namespace pg8 {
constexpr int BM = 256, BK = 64, HALF = 128, HTB = HALF * BK * 2, STAGE_BYTES = 8 * HTB;
__host__ __device__ __forceinline__ int lds_byte(int r, int c) { const int st = (r >> 4) * 2 + (c >> 5), rr = r & 15, cc = c & 31, ob = rr * 64 + cc * 2; return st * 1024 + (ob ^ (((ob >> 9) & 1) << 5)); }
__host__ __device__ __forceinline__ void stage_rc(int b, int& R, int& C) { const int st = b / 1024, sb = b % 1024, swz = sb ^ (((sb >> 9) & 1) << 5); R = (st >> 1) * 16 + swz / 64; C = (st & 1) * 32 + (swz % 64) / 2; }
__host__ __device__ __forceinline__ int perm32(int rho) { const int n = rho >> 4, i = rho & 15; return 8 * (i >> 2) + 4 * n + (i & 3); }

struct Unit { long aoff, boff; int arow, brow, pm, pn, g, flags; };
constexpr int UF_ACCUM = 1  , UF_NOEPI = 2  ;
struct Gemm { const bf16_t* A; const bf16_t* Bt; int lda, ldb, K; };

template <class Epi, class Sched>
__device__ __forceinline__ void gemm_phase(LAS unsigned char* lds, const int tid, const Gemm g, Sched& S, const Epi& E) {
    const int wid = __builtin_amdgcn_readfirstlane(tid >> 6), lane = tid & 63, wr = wid >> 2, wc = wid & 3, fr = lane & 15, fq = lane >> 4;
    const int K = g.K, nt = K / BK;
    unsigned voffA[2], voffB[2];
#pragma unroll
    for (int i = 0; i < 2; ++i) { int R, C; stage_rc(tid * 16 + i * 8192, R, C); const int Rb = Epi::PERM ? ((R & ~31) + perm32(R & 31)) : R;
        voffA[i] = (unsigned)(R * g.lda + C) * 2u; voffB[i] = (unsigned)(Rb * g.ldb + C) * 2u; }
    const size_t kstep = (size_t)(BK * 2);
    const size_t hstepA = (size_t)HALF * g.lda * 2, hstepB = (size_t)HALF * g.ldb * 2;
    const size_t tstepA = 2 * hstepA, tstepB = 2 * hstepB;
    const unsigned ldsw = (unsigned)wid * 1024u;
    const int aoff = lds_byte(wr * 64 + fr, fq * 8), boff = lds_byte(wc * 32 + fr, fq * 8);
#define PG8_SA(b, h) (((b) * 2 + (h)) * HTB)
#define PG8_SB(b, h) ((4 + (b) * 2 + (h)) * HTB)
#define PG8_STAGE(bufoff, gbase, voff) do { _Pragma("unroll") for (int _i = 0; _i < 2; ++_i) \
        __builtin_amdgcn_global_load_lds((const unsigned*)((const char*)(gbase) + (voff)[_i]), (LAS unsigned*)(lds + (bufoff) + ldsw + _i * 8192), 16, 0, 0); } while (0)
#define PG8_LDA(dst, b, h) do { _Pragma("unroll") for (int m = 0; m < 4; ++m) _Pragma("unroll") for (int k = 0; k < 2; ++k) dst[m][k] = *(const LAS bf16x8*)(lds + PG8_SA(b, h) + aoff + m * 2048 + k * 1024); } while (0)
#define PG8_LDB(dst, b, h) do { _Pragma("unroll") for (int n = 0; n < 2; ++n) _Pragma("unroll") for (int k = 0; k < 2; ++k) dst[n][k] = *(const LAS bf16x8*)(lds + PG8_SB(b, h) + boff + n * 2048 + k * 1024); } while (0)
#define PG8_MMA(ai, bj, At, Bt) do { __builtin_amdgcn_s_setprio(1); _Pragma("unroll") for (int m = 0; m < 4; ++m) _Pragma("unroll") for (int n = 0; n < 2; ++n) _Pragma("unroll") for (int k = 0; k < 2; ++k) \
        acc[ai][bj][m][n] = __builtin_amdgcn_mfma_f32_16x16x32_bf16(Bt[n][k], At[m][k], acc[ai][bj][m][n], 0, 0, 0); __builtin_amdgcn_s_setprio(0); } while (0)
#define PG8_WAIT_V(n) asm volatile("s_waitcnt vmcnt(" #n ")" ::: "memory")
#define PG8_WAIT_L(n) asm volatile("s_waitcnt lgkmcnt(" #n ")" ::: "memory")
#define PG8_BAR __builtin_amdgcn_s_barrier()
#define PG8_SCHED __builtin_amdgcn_sched_barrier(0)
    Unit cur, nxt; int ui = 0;
    if (!S.next(0, cur)) return;
    f32x4 acc[2][2][4][2];
#pragma unroll
    for (int a = 0; a < 2; ++a)
#pragma unroll
        for (int b = 0; b < 2; ++b)
#pragma unroll
            for (int m = 0; m < 4; ++m)
#pragma unroll
                for (int n = 0; n < 2; ++n) acc[a][b][m][n] = (f32x4){0.f, 0.f, 0.f, 0.f};
    bf16x8 At[4][2], B0[2][2], B1[2][2];
    const char* cA = (const char*)g.A + (size_t)cur.arow * tstepA + cur.aoff; const char* cB = (const char*)g.Bt + (size_t)cur.brow * tstepB + cur.boff;
    PG8_STAGE(PG8_SB(0, 0), cB, voffB); PG8_STAGE(PG8_SB(0, 1), cB + hstepB, voffB); PG8_STAGE(PG8_SA(0, 0), cA, voffA); PG8_STAGE(PG8_SA(0, 1), cA + hstepA, voffA);
    if (wr == 1) PG8_BAR;
    PG8_WAIT_V(2); PG8_BAR;
    PG8_STAGE(PG8_SB(1, 0), cB + kstep, voffB); PG8_STAGE(PG8_SA(1, 0), cA + kstep, voffA); PG8_STAGE(PG8_SB(1, 1), cB + hstepB + kstep, voffB);
    PG8_WAIT_V(6); PG8_BAR;
    for (;;) {
        const bool has_next = S.next(ui + 1, nxt);
        const char* nA = has_next ? (const char*)g.A + (size_t)nxt.arow * tstepA + nxt.aoff : cA; const char* nB = has_next ? (const char*)g.Bt + (size_t)nxt.brow * tstepB + nxt.boff : cB;
        for (int t = 0; t < nt; t += 2) {
            if constexpr (Epi::MIDK) { if (t == 8 || t == 16) { int tz = tid; asm volatile("" : "+v"(tz)); E.midk(acc, cur, t, tz); } }
            const bool last = (t == nt - 2);
            const char* a1 = cA + (size_t)(t + 1) * kstep;
            const char* a2 = last ? nA : cA + (size_t)(t + 2) * kstep; const char* b2 = last ? nB : cB + (size_t)(t + 2) * kstep;
            const char* a3 = a2 + kstep; const char* b3 = b2 + kstep;
            PG8_LDB(B0, 0, 0); PG8_LDB(B1, 0, 1); PG8_SCHED; PG8_LDA(At, 0, 0); PG8_STAGE(PG8_SA(1, 1), a1 + hstepA, voffA);
            PG8_WAIT_V(8); PG8_WAIT_L(0); PG8_BAR; PG8_MMA(0, 0, At, B0); PG8_MMA(0, 1, At, B1); PG8_BAR; PG8_SCHED;
            PG8_LDA(At, 0, 1); PG8_STAGE(PG8_SB(0, 0), b2, voffB); PG8_STAGE(PG8_SB(0, 1), b2 + hstepB, voffB); PG8_STAGE(PG8_SA(0, 0), a2, voffA);
            PG8_WAIT_V(8); PG8_WAIT_L(0); PG8_BAR; PG8_MMA(1, 0, At, B0); PG8_MMA(1, 1, At, B1); PG8_BAR; PG8_SCHED;
            PG8_LDB(B0, 1, 0); PG8_LDB(B1, 1, 1); PG8_SCHED; PG8_LDA(At, 1, 0); PG8_STAGE(PG8_SA(0, 1), a2 + hstepA, voffA);
            PG8_WAIT_V(8); PG8_WAIT_L(0); PG8_BAR; PG8_MMA(0, 0, At, B0); PG8_MMA(0, 1, At, B1); PG8_BAR; PG8_SCHED;
            PG8_LDA(At, 1, 1); PG8_STAGE(PG8_SB(1, 0), b3, voffB); PG8_STAGE(PG8_SB(1, 1), b3 + hstepB, voffB); PG8_STAGE(PG8_SA(1, 0), a3, voffA);
            PG8_WAIT_V(8); PG8_WAIT_L(0); PG8_BAR; PG8_MMA(1, 0, At, B0); PG8_MMA(1, 1, At, B1); PG8_BAR; PG8_SCHED;
        }
        if (wr == 0) PG8_BAR;
#ifdef PROBE_PNOISE
        if (Epi::PROBE_P && !(cur.flags & UF_NOEPI)) {
#pragma unroll
            for (int a = 0; a < 2; ++a)
#pragma unroll
                for (int b = 0; b < 2; ++b)
#pragma unroll
                    for (int m = 0; m < 4; ++m)
#pragma unroll
                        for (int n = 0; n < 2; ++n)
#pragma unroll
                            for (int i = 0; i < 4; ++i) { unsigned hsh = (unsigned)(((cur.pm * 32 + cur.pn) * 512 + tid) * 128 + ((a * 2 + b) * 4 + m) * 8 + n * 4 + i) * 2654435761u; hsh ^= hsh >> 15; hsh *= 2246822519u; hsh ^= hsh >> 13;
                                acc[a][b][m][n][i] *= 1.0f + PROBE_PNOISE * (((float)(hsh & 0xffff) * (1.0f / 32768.0f) - 1.0f) * 1.7320508f); }
        }
#endif
        if (!(cur.flags & UF_NOEPI)) { int tz = tid; asm volatile("" : "+v"(tz));
          const int w2 = __builtin_amdgcn_readfirstlane(tz >> 6), l2 = tz & 63; E(acc, cur, w2 >> 2, w2 & 3, l2 & 15, l2 >> 4); }
        if (!has_next) break;
        if (!(nxt.flags & UF_ACCUM)) {
#pragma unroll
        for (int a = 0; a < 2; ++a)
#pragma unroll
            for (int b = 0; b < 2; ++b)
#pragma unroll
                for (int m = 0; m < 4; ++m)
#pragma unroll
                    for (int n = 0; n < 2; ++n) acc[a][b][m][n] = (f32x4){0.f, 0.f, 0.f, 0.f};
        }
        cur = nxt; cA = nA; cB = nB; ++ui;
        if (wr == 1) PG8_BAR;
    }
    PG8_WAIT_V(0);
    PG8_BAR;
#undef PG8_SA
#undef PG8_SB
#undef PG8_STAGE
#undef PG8_LDA
#undef PG8_LDB
#undef PG8_MMA
#undef PG8_WAIT_V
#undef PG8_WAIT_L
#undef PG8_BAR
#undef PG8_SCHED
}
}
__device__ __forceinline__ int pm_of(int kind, int pmi) { return kind == 0 ? pmi : (kind == 1 ? pmi + (pmi >> 3) + 1 : 9 * pmi); }
__device__ __forceinline__ int npm_of(int kind) { return kind == 0 ? 144 : (kind == 1 ? 128 : 16); }
struct RectSched {
    int G, c; int cnt0, kind0, pn00, npn0, cnt1, kind1, pn01, npn1;
    __device__ __forceinline__ void init(int G_, int c_, int kind0_, int pn00_, int npn0_, int kind1_, int pn01_, int npn1_) {
        G = G_; c = c_; kind0 = kind0_; pn00 = pn00_; npn0 = npn0_; cnt0 = npm_of(kind0_) * npn0_; kind1 = kind1_; pn01 = pn01_; npn1 = npn1_; cnt1 = npn1_ > 0 ? npm_of(kind1_) * npn1_ : 0; }
    __device__ __forceinline__ bool decode(int L, int& pm, int& pn) const {
        int kind, pn0, npn;
        if (L < cnt0) { kind = kind0; pn0 = pn00; npn = npn0; } else { L -= cnt0; if (L >= cnt1) return false; kind = kind1; pn0 = pn01; npn = npn1; }
        const int grp = L / (8 * npn), rem = L - grp * 8 * npn; const int pmi = grp * 8 + (rem & 7), pni = rem >> 3;
        pm = pm_of(kind, pmi); pn = pn0 + pni; return true;
    }
    __device__ __forceinline__ bool next(int i, pg8::Unit& u) {
        int pm, pn; if (!decode(i * G + c, pm, pn)) return false;
        u.pm = pm; u.pn = pn; u.arow = pm; u.brow = pn; u.aoff = 0; u.boff = 0; u.g = 0; u.flags = 0; return true;
    }
};
struct InProjSched : RectSched {
    long hlo_off, wlo_off; int t, seg, nseg, pm_, pn_;
    __device__ __forceinline__ void init2(long hlo_off_, long wlo_off_) { hlo_off = hlo_off_; wlo_off = wlo_off_; t = 0; seg = 0; nseg = 1; pm_ = 0; pn_ = 0; }
    __device__ __forceinline__ bool next(int, pg8::Unit& u) {
        if (seg == 0) { if (!decode(t * G + c, pm_, pn_)) return false; nseg = (SPLIT_K && (pn_ == 8 || pn_ == 9)) ? 3 : 1; }
        u.pm = pm_; u.pn = pn_; u.g = 0; u.arow = pm_; u.brow = (seg == 1) ? pn_ - 8 : pn_;
        u.aoff = (seg == 2) ? hlo_off : 0; u.boff = (seg == 1) ? wlo_off : 0;
        u.flags = (seg > 0 ? pg8::UF_ACCUM : 0) | (seg + 1 < nseg ? pg8::UF_NOEPI : 0);
        if (++seg == nseg) { seg = 0; ++t; }
        return true;
    }
};
struct MergeSched {
    int G, c, kind, ntile;
    __device__ __forceinline__ void init(int G_, int c_, int kind_) { G = G_; c = c_; kind = kind_; ntile = npm_of(kind_) * 4; }
    __device__ __forceinline__ bool next(int i, pg8::Unit& u) {
        const int ti = c + i * G; if (ti >= ntile) return false;
        u.pm = pm_of(kind, ti >> 2); u.pn = ti & 3; u.arow = u.pm; u.brow = u.pn; u.aoff = 0; u.boff = 0; u.g = 0; u.flags = 0; return true;
    }
};
struct MoeSched {
    int G, c, npm_e, npn, atile_e, btile_e;
    __device__ __forceinline__ void init(int G_, int c_, int npm_e_, int npn_, int btile_e_) { G = G_; c = c_; npm_e = npm_e_; npn = npn_; atile_e = EROWS / 256; btile_e = btile_e_; }
    __device__ __forceinline__ bool next(int i, pg8::Unit& u) {
        const int L = i * G + c, per = npm_e * npn; if (L >= NEXP * per) return false;
        const int e = L / per, rem = L - e * per; const int pmi = rem % npm_e, pni = rem / npm_e;
        u.pm = pmi; u.pn = pni; u.g = e; u.arow = e * atile_e + pmi; u.brow = e * btile_e + pni; u.aoff = 0; u.boff = 0; u.flags = 0; return true;
    }
};

typedef const f32x4 (&AccRef)[2][2][4][2];
__device__ __forceinline__ int perm16(int kk) { return 8 * ((kk >> 2) & 1) + (kk & 3) + 4 * (kk >> 3); }

struct EpiInProj {
    static constexpr bool PERM = true, PROBE_P = true, MIDK = false;
    bf16_t *Q, *Kb, *Vt, *PRW, *SG, *GATE; const f32x2* rope; bf16_t* KLO;
    __device__ __forceinline__ void operator()(AccRef acc, const pg8::Unit& u, int wr, int wc, int fr, int fq) const {
        const int pn = u.pn, b = u.pm / 9, sl = u.pm - 9 * b; const bool is_ctx = (sl == 0);
        const int rbase = wr * 64 + fr, c8 = wc * 32 + 8 * fq;
        if (pn < 4) {
            bf16_t* dst = (pn < 2) ? Q : Kb; const int cb = (pn & 1) * 256; const float sc = (pn < 2) ? QSCALE : 1.0f; const int hh = wc & 1;
#pragma unroll
            for (int ai = 0; ai < 2; ++ai)
#pragma unroll
                for (int m = 0; m < 4; ++m) { const int rl = ai * 128 + m * 16 + rbase; const size_t row = (size_t)u.pm * 256 + rl;
                    f32x4 r01 = (f32x4){1.f, 0.f, 1.f, 0.f}, r23 = r01;
                    if (!is_ctx) { const int t = (sl - 1) * 256 + rl; const int pos = hh ? (t & 63) : (t >> 6); const f32x4* rp = (const f32x4*)(rope + pos * 16 + 4 * fq); r01 = rp[0]; r23 = rp[1]; }
#pragma unroll
                    for (int bj = 0; bj < 2; ++bj) { const f32x4 v0 = acc[ai][bj][m][0] * sc, v1 = acc[ai][bj][m][1] * sc;
                        const float o0 = v0[0] * r01[0] - v0[1] * r01[1], o1 = v0[1] * r01[0] + v0[0] * r01[1];
                        const float o2 = v0[2] * r01[2] - v0[3] * r01[3], o3 = v0[3] * r01[2] + v0[2] * r01[3];
                        const float o4 = v1[0] * r23[0] - v1[1] * r23[1], o5 = v1[1] * r23[0] + v1[0] * r23[1];
                        const float o6 = v1[2] * r23[2] - v1[3] * r23[3], o7 = v1[3] * r23[2] + v1[2] * r23[3];
                        u32x4 w; w.x = cvt_pk_bf16(o0, o1); w.y = cvt_pk_bf16(o2, o3); w.z = cvt_pk_bf16(o4, o5); w.w = cvt_pk_bf16(o6, o7);
                        *(u32x4*)(dst + row * 512 + cb + bj * 128 + c8) = w; } }
        } else if (pn < 6) {
#pragma unroll
            for (int ai = 0; ai < 2; ++ai)
#pragma unroll
                for (int m = 0; m < 4; ++m) { const int rl = ai * 128 + m * 16 + rbase; const int s = sl * 256 + rl; const int slot = (s & ~15) + perm16(s & 15);
#pragma unroll
                    for (int bj = 0; bj < 2; ++bj) { const int head = 2 * (pn - 4) + bj; bf16_t* vp = Vt + ((size_t)(b * 4 + head) * 128 + c8) * T_ALL + slot;
#pragma unroll
                        for (int n = 0; n < 2; ++n)
#pragma unroll
                            for (int i = 0; i < 4; ++i) vp[(size_t)(4 * n + i) * T_ALL] = (bf16_t)f2bf(acc[ai][bj][m][n][i]); } }
        } else if (SPLIT_K && (pn == 8 || pn == 9)) {
#pragma unroll
            for (int ai = 0; ai < 2; ++ai)
#pragma unroll
                for (int m = 0; m < 4; ++m) { const size_t row = (size_t)u.pm * 256 + ai * 128 + m * 16 + rbase;
#pragma unroll
                    for (int bj = 0; bj < 2; ++bj) { const f32x4 v0 = acc[ai][bj][m][0], v1 = acc[ai][bj][m][1];
                        u32x4 w; w.x = cvt_pk_bf16(v0[0], v0[1]); w.y = cvt_pk_bf16(v0[2], v0[3]); w.z = cvt_pk_bf16(v1[0], v1[1]); w.w = cvt_pk_bf16(v1[2], v1[3]);
                        *(u32x4*)(PRW + row * RW_COLS + (pn - 6) * 256 + bj * 128 + c8) = w;
                        u32x4 lo; lo.x = cvt_pk_bf16(v0[0] - bflo(w.x), v0[1] - bfhi(w.x)); lo.y = cvt_pk_bf16(v0[2] - bflo(w.y), v0[3] - bfhi(w.y));
                        lo.z = cvt_pk_bf16(v1[0] - bflo(w.z), v1[1] - bfhi(w.z)); lo.w = cvt_pk_bf16(v1[2] - bflo(w.w), v1[3] - bfhi(w.w));
                        *(u32x4*)(KLO + row * 512 + (pn - 8) * 256 + bj * 128 + c8) = lo; } }
        } else if (pn < 13) rows_bf16<0>(acc, PRW, RW_COLS, (pn - 6) * 256 + c8, (size_t)u.pm * 256 + rbase);
        else if (pn < 17) rows_bf16<1>(acc, SG, 1024, (pn - 13) * 256 + c8, (size_t)u.pm * 256 + rbase);
        else {
            const int gj = (pn - 17) >> 2, pnm = (pn - 17) & 3;
            bf16_t* gp = GATE + (((((size_t)u.pm * 4 + pnm) * 3 + gj) * 8 + (wr * 4 + wc)) * 16) * 512 + (fr + 16 * fq) * 8;
#pragma unroll
            for (int ai = 0; ai < 2; ++ai)
#pragma unroll
                for (int m = 0; m < 4; ++m)
#pragma unroll
                    for (int bj = 0; bj < 2; ++bj) { f32x4 v0 = acc[ai][bj][m][0], v1 = acc[ai][bj][m][1];
#pragma unroll
                        for (int i = 0; i < 4; ++i) { v0[i] = sigmoidf_(v0[i]); v1[i] = sigmoidf_(v1[i]); }
                        u32x4 w; w.x = cvt_pk_bf16(v0[0], v0[1]); w.y = cvt_pk_bf16(v0[2], v0[3]); w.z = cvt_pk_bf16(v1[0], v1[1]); w.w = cvt_pk_bf16(v1[2], v1[3]);
                        *(u32x4*)(gp + ((ai * 4 + m) * 2 + bj) * 512) = w; } }
    }
    template <int ACT> static __device__ __forceinline__ void rows_bf16(AccRef acc, bf16_t* dst, int ld, int col, size_t row0) {
#pragma unroll
        for (int ai = 0; ai < 2; ++ai)
#pragma unroll
            for (int m = 0; m < 4; ++m) { bf16_t* rp = dst + (row0 + ai * 128 + m * 16) * ld + col;
#pragma unroll
                for (int bj = 0; bj < 2; ++bj) { f32x4 v0 = acc[ai][bj][m][0], v1 = acc[ai][bj][m][1];
                    if (ACT == 1) {
#pragma unroll
                        for (int i = 0; i < 4; ++i) { v0[i] = gelu_tanh(v0[i]); v1[i] = gelu_tanh(v1[i]); } }
                    if (ACT == 2) {
#pragma unroll
                        for (int i = 0; i < 4; ++i) { v0[i] = sigmoidf_(v0[i]); v1[i] = sigmoidf_(v1[i]); } }
                    u32x4 w; w.x = cvt_pk_bf16(v0[0], v0[1]); w.y = cvt_pk_bf16(v0[2], v0[3]); w.z = cvt_pk_bf16(v1[0], v1[1]); w.w = cvt_pk_bf16(v1[2], v1[3]);
                    *(u32x4*)(rp + bj * 128) = w; } }
    }
};

struct EpiMerge { static constexpr bool PROBE_P = false;
    static constexpr bool PERM = true, MIDK = true;
    const bf16_t* GATE; bf16_t* M;
    static __device__ __forceinline__ f32x4 glo(u32x4 w) { return (f32x4){fmaxf(bflo(w.x), 1e-30f), fmaxf(bfhi(w.x), 1e-30f), fmaxf(bflo(w.y), 1e-30f), fmaxf(bfhi(w.y), 1e-30f)}; }
    static __device__ __forceinline__ f32x4 ghi(u32x4 w) { return (f32x4){fmaxf(bflo(w.z), 1e-30f), fmaxf(bfhi(w.z), 1e-30f), fmaxf(bflo(w.w), 1e-30f), fmaxf(bfhi(w.w), 1e-30f)}; }
    __device__ __forceinline__ void midk(f32x4 (&acc)[2][2][4][2], const pg8::Unit& u, int t, int tz) const {
        const int w2 = __builtin_amdgcn_readfirstlane(tz >> 6), l2 = tz & 63, wr = w2 >> 2, wc = w2 & 3, fr = l2 & 15, fq = l2 >> 4;
        const int j = (t == 8) ? 0 : 1;
        const bf16_t* gbase = GATE + (((((size_t)u.pm * 4 + u.pn) * 3 + j) * 8 + w2) * 16) * 512 + l2 * 8;
#pragma unroll
        for (int ai = 0; ai < 2; ++ai) { u32x4 ga[4][2], gb[4][2];
#pragma unroll
            for (int m = 0; m < 4; ++m)
#pragma unroll
                for (int bj = 0; bj < 2; ++bj) { const bf16_t* gp = gbase + ((ai * 4 + m) * 2 + bj) * 512; ga[m][bj] = *(const u32x4*)gp; gb[m][bj] = *(const u32x4*)(gp + 8 * 16 * 512); }
#pragma unroll
            for (int m = 0; m < 4; ++m)
#pragma unroll
                for (int bj = 0; bj < 2; ++bj) { const f32x4 a0 = glo(ga[m][bj]), a1 = ghi(ga[m][bj]), b0 = glo(gb[m][bj]), b1 = ghi(gb[m][bj]);
#pragma unroll
                    for (int i = 0; i < 4; ++i) { acc[ai][bj][m][0][i] *= a0[i] * fast_rcp(b0[i]); acc[ai][bj][m][1][i] *= a1[i] * fast_rcp(b1[i]); } } }
    }
    __device__ __forceinline__ void operator()(const f32x4 (&acc)[2][2][4][2], const pg8::Unit& u, int wr, int wc, int fr, int fq) const {
        const int rbase = wr * 64 + fr, c8 = u.pn * 256 + wc * 32 + 8 * fq;
        u32x4 gwv[2][4][2];
        { const bf16_t* gbase = GATE + (((((size_t)u.pm * 4 + u.pn) * 3 + 2) * 8 + (wr * 4 + wc)) * 16) * 512 + (fr + 16 * fq) * 8;
#pragma unroll
          for (int ai = 0; ai < 2; ++ai)
#pragma unroll
              for (int m = 0; m < 4; ++m)
#pragma unroll
                  for (int bj = 0; bj < 2; ++bj) gwv[ai][m][bj] = *(const u32x4*)(gbase + ((ai * 4 + m) * 2 + bj) * 512); }
#pragma unroll
        for (int ai = 0; ai < 2; ++ai)
#pragma unroll
            for (int m = 0; m < 4; ++m) { const size_t row = (size_t)u.pm * 256 + ai * 128 + m * 16 + rbase;
#pragma unroll
                for (int bj = 0; bj < 2; ++bj) { const int col = c8 + bj * 128;
                    const u32x4 gw = gwv[ai][m][bj];
                    const f32x4 v0 = acc[ai][bj][m][0] * glo(gw), v1 = acc[ai][bj][m][1] * ghi(gw);
                    u32x4 w; w.x = cvt_pk_bf16(v0[0], v0[1]); w.y = cvt_pk_bf16(v0[2], v0[3]); w.z = cvt_pk_bf16(v1[0], v1[1]); w.w = cvt_pk_bf16(v1[2], v1[3]);
                    *(u32x4*)(M + row * 1024 + col) = w; } }
    }
};

struct EpiWout { static constexpr bool PROBE_P = false, MIDK = false;
    static constexpr bool PERM = false;
    const float* xin; const float* cin; float* X; const float* mod; int layer0;
    __device__ __forceinline__ void operator()(AccRef acc, const pg8::Unit& u, int wr, int wc, int fr, int fq) const {
        const int b = u.pm / 9, sl = u.pm - 9 * b; const bool is_ctx = (sl == 0);
        const float* g1 = mod + (size_t)(is_ctx ? 16 : b) * 6144 + 2048;
        const int rbase = wr * 64 + fr, c4 = u.pn * 256 + wc * 32 + 4 * fq;
        f32x4 gv[2][2];
#pragma unroll
        for (int bj = 0; bj < 2; ++bj)
#pragma unroll
            for (int n = 0; n < 2; ++n) gv[bj][n] = *(const f32x4*)(g1 + c4 + bj * 128 + n * 16);
#pragma unroll
        for (int ai = 0; ai < 2; ++ai) { f32x4 xv[4][2][2];
#pragma unroll
            for (int m = 0; m < 4; ++m) { const int rl = ai * 128 + m * 16 + rbase; const size_t row = (size_t)u.pm * 256 + rl;
                const float* xp = layer0 ? (is_ctx ? cin + ((size_t)b * T_CTX + rl) * 1024 : xin + ((size_t)b * T_LAT + (sl - 1) * 256 + rl) * 1024) : X + row * 1024;
#pragma unroll
                for (int bj = 0; bj < 2; ++bj)
#pragma unroll
                    for (int n = 0; n < 2; ++n) xv[m][bj][n] = *(const f32x4*)(xp + c4 + bj * 128 + n * 16); }
#pragma unroll
            for (int m = 0; m < 4; ++m) { const size_t row = (size_t)u.pm * 256 + ai * 128 + m * 16 + rbase;
#pragma unroll
                for (int bj = 0; bj < 2; ++bj)
#pragma unroll
                    for (int n = 0; n < 2; ++n) { const int col = c4 + bj * 128 + n * 16; *(f32x4*)(X + row * 1024 + col) = DN_ALPHA * xv[m][bj][n] + gv[bj][n] * acc[ai][bj][m][n]; } } }
    }
};

struct EpiMoe1 { static constexpr bool PROBE_P = false, MIDK = false;
    static constexpr bool PERM = true;
    bf16_t* HID;
    __device__ __forceinline__ void operator()(AccRef acc, const pg8::Unit& u, int wr, int wc, int fr, int fq) const {
        const int rbase = wr * 64 + fr, c8 = u.pn * 128 + wc * 32 + 8 * fq;
#pragma unroll
        for (int ai = 0; ai < 2; ++ai)
#pragma unroll
            for (int m = 0; m < 4; ++m) { const size_t row = (size_t)u.g * EROWS + u.pm * 256 + ai * 128 + m * 16 + rbase;
                float h[8];
#pragma unroll
                for (int n = 0; n < 2; ++n)
#pragma unroll
                    for (int i = 0; i < 4; ++i) h[4 * n + i] = siluf_(acc[ai][0][m][n][i]) * acc[ai][1][m][n][i];
                u32x4 w; w.x = cvt_pk_bf16(h[0], h[1]); w.y = cvt_pk_bf16(h[2], h[3]); w.z = cvt_pk_bf16(h[4], h[5]); w.w = cvt_pk_bf16(h[6], h[7]);
                *(u32x4*)(HID + row * FF + c8) = w; }
    }
};

struct EpiMoe2 { static constexpr bool PROBE_P = false, MIDK = false;
    static constexpr bool PERM = true;
    bf16_t* YE; const float* GATEE;
    __device__ __forceinline__ void operator()(AccRef acc, const pg8::Unit& u, int wr, int wc, int fr, int fq) const {
        const int rbase = wr * 64 + fr, c8 = u.pn * 256 + wc * 32 + 8 * fq;
        float gtv[2][4];
#pragma unroll
        for (int ai = 0; ai < 2; ++ai)
#pragma unroll
            for (int m = 0; m < 4; ++m) gtv[ai][m] = GATEE[(size_t)u.g * EROWS + u.pm * 256 + ai * 128 + m * 16 + rbase];
#pragma unroll
        for (int ai = 0; ai < 2; ++ai)
#pragma unroll
            for (int m = 0; m < 4; ++m) { const size_t row = (size_t)u.g * EROWS + u.pm * 256 + ai * 128 + m * 16 + rbase; const float gt = gtv[ai][m];
#pragma unroll
                for (int bj = 0; bj < 2; ++bj) { const f32x4 v0 = acc[ai][bj][m][0] * gt, v1 = acc[ai][bj][m][1] * gt;
                    u32x4 w; w.x = cvt_pk_bf16(v0[0], v0[1]); w.y = cvt_pk_bf16(v0[2], v0[3]); w.z = cvt_pk_bf16(v1[0], v1[1]); w.w = cvt_pk_bf16(v1[2], v1[3]);
                    *(u32x4*)(YE + row * 1024 + c8 + bj * 128) = w; } }
    }
};
struct Frame {
    LAS unsigned char* lds;
    int tid, lane, wave, G, blk;
    float* out; unsigned char* ws;
    __device__ __forceinline__ const float* inp(int i) const {
        const u32x2 w = *(const LAS u32x2*)(lds + LDS_MISC + 64 + 8 * i);
        const unsigned lo = __builtin_amdgcn_readfirstlane(w.x), hi = __builtin_amdgcn_readfirstlane(w.y);
        const GAS float* p = (const GAS float*)(((unsigned long long)hi << 32) | lo);
        return (const float*)p;
    }
};
__device__ __forceinline__ void relaunder(Frame& F) { int tz = threadIdx.x; asm volatile("" : "+v"(tz)); F.tid = tz; F.lane = tz & 63; F.wave = __builtin_amdgcn_readfirstlane(tz >> 6); }
enum { I_X = 0, I_C, I_CTX, I_CCTX, I_WMOD, I_BMOD, I_WIN, I_DALAM, I_DANG, I_RWMU, I_RWW0, I_RWW2, I_RWA0, I_RWA2, I_RWKK, I_RWKA, I_RWRK, I_RWLNG, I_RWLNB, I_RWG2,
       I_SGNG, I_SGNB, I_SGW, I_SGB, I_WBR, I_WOUT, I_LN1G, I_LN1B, I_WROUTER, I_WEG, I_WEU, I_WED, I_LN2G, I_LN2B };

__device__ __forceinline__ float lo_part(float x) { return x - __builtin_bit_cast(float, f2bf(x) << 16); }
template <bool ROPEPERM, bool LO = false>
__device__ __forceinline__ void transpose_item(const float* W, int N, int k0, int n0, bf16_t* WT, int ldt, int drow0, LAS float* scr, int lane) {
    const int dc = ROPEPERM ? ((lane & 32) + 2 * (lane & 15) + ((lane >> 4) & 1)) : lane;
    float tv[64];
#pragma unroll
    for (int kk = 0; kk < 64; ++kk) tv[kk] = __builtin_nontemporal_load(W + (size_t)(k0 + kk) * N + n0 + lane);
#pragma unroll
    for (int kk = 0; kk < 64; ++kk) scr[kk * 65 + dc] = tv[kk];
    LDS_WAIT(); asm volatile("" ::: "memory");
    const int c = lane & 7;
#pragma unroll
    for (int j = 0; j < 8; ++j) { const int n = (lane >> 3) + 8 * j; const LAS float* s = scr + (8 * c) * 65 + n;
        u32x4 o;
        if (LO) { o.x = pk2(lo_part(s[0 * 65]), lo_part(s[1 * 65])); o.y = pk2(lo_part(s[2 * 65]), lo_part(s[3 * 65])); o.z = pk2(lo_part(s[4 * 65]), lo_part(s[5 * 65])); o.w = pk2(lo_part(s[6 * 65]), lo_part(s[7 * 65])); }
        else { o.x = pk2(s[0 * 65], s[1 * 65]); o.y = pk2(s[2 * 65], s[3 * 65]); o.z = pk2(s[4 * 65], s[5 * 65]); o.w = pk2(s[6 * 65], s[7 * 65]); }
        *(u32x4*)(WT + (size_t)(drow0 + n) * ldt + k0 + 8 * c) = o; }
    LDS_WAIT(); asm volatile("" ::: "memory");
}

__device__ __forceinline__ void convert_weights(Frame& F, int l, int gw, int NGW) {
    LAS float* scr = (LAS float*)(F.lds + F.wave * 16896);
    bf16_t* WIN = (bf16_t*)(F.ws + WS_WIN); bf16_t* WB = (bf16_t*)(F.ws + WS_WB); bf16_t* WOUT = (bf16_t*)(F.ws + WS_WOUT); bf16_t* G2T = (bf16_t*)(F.ws + WS_G2T);
    bf16_t* WE1 = (bf16_t*)(F.ws + WS_WE1); bf16_t* WE2 = (bf16_t*)(F.ws + WS_WE2); bf16_t* WLO = (bf16_t*)(F.ws + WS_WLO);
    const float* w_in = F.inp(I_WIN) + (size_t)l * DM * IN_COLS;
    const float* w_br = F.inp(I_WBR) + (size_t)l * MIXW * DM;
    const float* w_out = F.inp(I_WOUT) + (size_t)l * DM * DM;
    const float* g2 = F.inp(I_RWG2) + (size_t)l * 128 * 512;
    const float* weg = F.inp(I_WEG) + (size_t)l * NEXP * DM * FF;
    const float* weu = F.inp(I_WEU) + (size_t)l * NEXP * DM * FF;
    const float* wed = F.inp(I_WED) + (size_t)l * NEXP * FF * DM;
    constexpr int I_IN = 16 * 116, I_BR = 24 * 16, I_OUT = 16 * 16, I_G2 = 2 * 8, I_LO = 16 * 8, I_E1 = NEXP * 2 * 16 * 32, I_E2 = NEXP * 32 * 16;
    constexpr int NITEMS = I_IN + I_BR + I_OUT + I_G2 + I_LO + I_E1 + I_E2;
    for (int it = gw; it < NITEMS; it += NGW) {
        int r = it;
        if (r < I_IN) { const int kb = r / 116, nb = r % 116; if (nb < 16) transpose_item<true>(w_in, IN_COLS, 64 * kb, 64 * nb, WIN, DM, 64 * nb, scr, F.lane); else transpose_item<false>(w_in, IN_COLS, 64 * kb, 64 * nb, WIN, DM, 64 * nb, scr, F.lane); continue; } r -= I_IN;
        if (r < I_BR) { const int kb = r / 16, nb = r % 16; transpose_item<false>(w_br, DM, 64 * kb, 64 * nb, WB, MIXW, 64 * nb, scr, F.lane); continue; } r -= I_BR;
        if (r < I_OUT) { const int kb = r / 16, nb = r % 16; transpose_item<false>(w_out, DM, 64 * kb, 64 * nb, WOUT, DM, 64 * nb, scr, F.lane); continue; } r -= I_OUT;
        if (r < I_G2) { const int kb = r / 8, nb = r % 8; transpose_item<false>(g2, 512, 64 * kb, 64 * nb, G2T, 128, 64 * nb, scr, F.lane); continue; } r -= I_G2;
        if (r < I_LO) { const int kb = r / 8, nb = r % 8; if (SPLIT_K) transpose_item<false, true>(w_in, IN_COLS, 64 * kb, 2048 + 64 * nb, WLO, DM, 64 * nb, scr, F.lane); continue; } r -= I_LO;
        if (r < I_E1) { const int e = r / 1024, r2 = r % 1024, which = r2 / 512, r3 = r2 % 512, kb = r3 / 32, nb = r3 % 32; const int n0 = 64 * nb;
            const float* src = (which ? weu : weg) + (size_t)e * DM * FF; const int drow0 = e * 4096 + 256 * (n0 >> 7) + 128 * which + (n0 & 127);
            transpose_item<false>(src, FF, 64 * kb, n0, WE1, DM, drow0, scr, F.lane); continue; } r -= I_E1;
        { const int e = r / 512, r2 = r % 512, kb = r2 / 16, nb = r2 % 16; transpose_item<false>(wed + (size_t)e * FF * DM, DM, 64 * kb, 64 * nb, WE2, FF, e * 1024 + 64 * nb, scr, F.lane); }
    }
}

__device__ __forceinline__ void mod_partials(Frame& F) {
    LAS float* sl = (LAS float*)F.lds;
    float* MODP = (float*)(F.ws + R_MODP);
    for (int un = F.blk; un < 2 * 12 * 16; un += F.G) {
        const int l = un / 192, r = un % 192, cb = r / 16, kc = r % 16;
        __syncthreads();
        for (int i = F.tid; i < 17 * 64; i += 512) { const int rr = i >> 6, k = i & 63; const float cv = (rr < 16) ? F.inp(I_C)[rr * DM + kc * 64 + k] : F.inp(I_CCTX)[kc * 64 + k]; sl[i] = siluf_(cv); }
        __syncthreads();
        const int n = cb * 512 + F.tid; const float* w = F.inp(I_WMOD) + ((size_t)l * DM + kc * 64) * 6144 + n;
        float a[17];
#pragma unroll
        for (int rr = 0; rr < 17; ++rr) a[rr] = 0.f;
#pragma unroll 4
        for (int k = 0; k < 64; ++k) { const float wv = w[(size_t)k * 6144];
#pragma unroll
            for (int rr = 0; rr < 17; ++rr) a[rr] += sl[rr * 64 + k] * wv; }
#pragma unroll
        for (int rr = 0; rr < 17; ++rr) MODP[(((size_t)kc * 2 + l) * 17 + rr) * 6144 + n] = a[rr];
    }
    __syncthreads();
}
__device__ __forceinline__ void mod_reduce(Frame& F) {
    const float* MODP = (const float*)(F.ws + R_MODP); float* MODF = (float*)(F.ws + WS_MODF);
    for (int i = F.blk * 512 + F.tid; i < 2 * 17 * 6144; i += F.G * 512) { const int l = i / (17 * 6144), n = i % 6144;
        float s = F.inp(I_BMOD)[l * 6144 + n];
#pragma unroll
        for (int kc = 0; kc < 16; ++kc) s += MODP[(size_t)kc * 2 * 17 * 6144 + i];
        MODF[i] = s; }
}
__device__ __forceinline__ void small_tables(Frame& F) {
    if (F.blk == 0) {
        f32x2* rope = (f32x2*)(F.ws + WS_SMALL);
        for (int i = F.tid; i < 64 * 16; i += 512) { const int pos = i >> 4, j = i & 15; const float inv = powf(10000.0f, -(float)(2 * j) / 32.0f); const float ang = (float)pos * inv; rope[i] = (f32x2){cosf(ang), sinf(ang)}; }
    }
    if (F.blk == 1 && F.wave < 2) {
        const int l = F.wave; const float* dl = F.inp(I_DALAM) + l * 256;
        const float s01 = wave_sum(dl[F.lane] * dl[64 + F.lane]), s23 = wave_sum(dl[128 + F.lane] * dl[192 + F.lane]);
        const float lam_init = 0.8f - 0.6f * expf(-0.3f * (float)l);
        if (F.lane == 0) { float* sc = (float*)(F.ws + WS_SMALL + 16384); sc[2 * l] = expf(s01) - expf(s23) + lam_init; sc[2 * l + 1] = lam_init; }
    }
}

__device__ __forceinline__ const float* src_row(Frame& F, int row) { const int b = row / T_ALL, s = row - b * T_ALL; return s < T_CTX ? F.inp(I_CTX) + ((size_t)b * T_CTX + s) * DM : F.inp(I_X) + ((size_t)b * T_LAT + (s - T_CTX)) * DM; }
__device__ __forceinline__ const float* mod_row(Frame& F, int l, int row) { const int b = row / T_ALL, s = row - b * T_ALL; return (const float*)(F.ws + WS_MODF) + ((size_t)l * 17 + (s < T_CTX ? 16 : b)) * 6144; }
__device__ __forceinline__ void store_mod_bf16(bf16_t* dst, bf16_t* dlo, const f32x4 (&v)[4], const float* sh, const float* sc, int lane) {
#pragma unroll
    for (int j = 0; j < 4; ++j) { const int c = 4 * lane + 256 * j; const f32x4 s1 = *(const f32x4*)(sc + c), h1 = *(const f32x4*)(sh + c); const f32x4 o = v[j] * (1.0f + s1) + h1;
        u32x2 w; w.x = cvt_pk_bf16(o[0], o[1]); w.y = cvt_pk_bf16(o[2], o[3]); *(u32x2*)(dst + c) = w;
        if (SPLIT_K) { u32x2 l; l.x = cvt_pk_bf16(o[0] - bflo(w.x), o[1] - bfhi(w.x)); l.y = cvt_pk_bf16(o[2] - bflo(w.y), o[3] - bfhi(w.y)); *(u32x2*)(dlo + c) = l; } }
}
__device__ __forceinline__ void phase_h0(Frame& F) {
    bf16_t* H = (bf16_t*)(F.ws + WS_H); const int stride = F.G * 8;
    int row = F.blk * 8 + F.wave; f32x4 vn[4], vm[4];
#define H0_LD(dst, r_) do { if ((r_) < ROWS) { const float* src_ = src_row(F, (r_)); _Pragma("unroll") for (int j = 0; j < 4; ++j) dst[j] = *(const f32x4*)(src_ + 4 * F.lane + 256 * j); } } while (0)
    H0_LD(vn, row); H0_LD(vm, row + stride);
    for (; row < ROWS; row += stride) {
        f32x4 v[4];
#pragma unroll
        for (int j = 0; j < 4; ++j) { v[j] = vn[j]; vn[j] = vm[j]; }
        H0_LD(vm, row + 2 * stride);
        const float* md = mod_row(F, 0, row);
        store_mod_bf16(H + (size_t)row * DM, (bf16_t*)F.out + (size_t)row * DM, v, md, md + 1024, F.lane);
    }
#undef H0_LD
}
__device__ __forceinline__ void ln_row(f32x4 (&v)[4], const float* g, const float* bta, int lane) {
    float s = 0.f;
#pragma unroll
    for (int j = 0; j < 4; ++j) s += (v[j][0] + v[j][1]) + (v[j][2] + v[j][3]);
    const float mean = wave_sum(s) * (1.0f / DM); float q = 0.f;
#pragma unroll
    for (int j = 0; j < 4; ++j) { v[j] = v[j] - mean; q += (v[j][0] * v[j][0] + v[j][1] * v[j][1]) + (v[j][2] * v[j][2] + v[j][3] * v[j][3]); }
    const float rstd = 1.0f / sqrtf(wave_sum(q) * (1.0f / DM) + LN_EPS);
#pragma unroll
    for (int j = 0; j < 4; ++j) { const int c = 4 * lane + 256 * j; v[j] = v[j] * rstd * *(const f32x4*)(g + c) + *(const f32x4*)(bta + c); }
}
__device__ __forceinline__ void phase_ln1(Frame& F, int l, bool with_ctx) {
    LAS float* wrt = (LAS float*)F.lds;
    const float* wr = F.inp(I_WROUTER) + (size_t)l * DM * NEXP;
    __syncthreads();
    for (int i = F.tid; i < DM * NEXP; i += 512) { const int k = i >> 4, e = i & 15; wrt[e * DM + k] = wr[i]; }
    __syncthreads();
    float* X = (float*)(F.ws + WS_X); bf16_t* H = (bf16_t*)(F.ws + WS_H); float* AFF = (float*)(F.ws + WS_AFF);
    const float* g = F.inp(I_LN1G) + l * DM; const float* bt = F.inp(I_LN1B) + l * DM;
    const int stride = F.G * 8, nrows = with_ctx ? ROWS : NB * T_LAT; int it = F.blk * 8 + F.wave;
#define LN_ROW(i_) (with_ctx ? (i_) : ((i_) / T_LAT) * T_ALL + T_CTX + ((i_) % T_LAT))
#define LN_LD(dst, i_) do { if ((i_) < nrows) { const float* src_ = X + (size_t)LN_ROW(i_) * DM; _Pragma("unroll") for (int j = 0; j < 4; ++j) dst[j] = *(const f32x4*)(src_ + 4 * F.lane + 256 * j); } } while (0)
    f32x4 vn[4], vm[4];
    LN_LD(vn, it); LN_LD(vm, it + stride);
    for (; it < nrows; it += 2 * stride) {
        const bool hasB = it + stride < nrows;
        const int rowA = LN_ROW(it), rowB = hasB ? LN_ROW(it + stride) : rowA;
        f32x4 vA[4], vB[4];
#pragma unroll
        for (int j = 0; j < 4; ++j) { vA[j] = vn[j]; vB[j] = hasB ? vm[j] : vn[j]; }
        LN_LD(vn, it + 2 * stride); LN_LD(vm, it + 3 * stride);
        ln_row(vA, g, bt, F.lane); ln_row(vB, g, bt, F.lane);
        f32x2 hm2[4][4];
        { float* xa = X + (size_t)rowA * DM; float* xb = X + (size_t)rowB * DM; const float* mda = mod_row(F, l, rowA); const float* mdb = mod_row(F, l, rowB);
#pragma unroll
          for (int j = 0; j < 4; ++j) { const int c = 4 * F.lane + 256 * j;
              *(f32x4*)(xa + c) = vA[j]; if (hasB) *(f32x4*)(xb + c) = vB[j];
              const f32x4 ha = vA[j] * (1.0f + *(const f32x4*)(mda + 4096 + c)) + *(const f32x4*)(mda + 3072 + c), hb = vB[j] * (1.0f + *(const f32x4*)(mdb + 4096 + c)) + *(const f32x4*)(mdb + 3072 + c);
              u32x2 w; w.x = cvt_pk_bf16(ha[0], ha[1]); w.y = cvt_pk_bf16(ha[2], ha[3]); *(u32x2*)(H + (size_t)rowA * DM + c) = w;
              if (hasB) { w.x = cvt_pk_bf16(hb[0], hb[1]); w.y = cvt_pk_bf16(hb[2], hb[3]); *(u32x2*)(H + (size_t)rowB * DM + c) = w; }
#pragma unroll
              for (int i2 = 0; i2 < 4; ++i2) hm2[j][i2] = (f32x2){ha[i2], hb[i2]}; } }
        f32x2 pe[NEXP];
        int lz = F.lane; asm volatile("" : "+v"(lz));
#pragma unroll
        for (int e = 0; e < NEXP; ++e) { f32x2 p = (f32x2){0.f, 0.f};
#pragma unroll
            for (int j = 0; j < 4; ++j) { const f32x4 w4 = *(const LAS f32x4*)(wrt + e * DM + 4 * lz + 256 * j);
#pragma unroll
                for (int i2 = 0; i2 < 4; ++i2) p += hm2[j][i2] * w4[i2]; }
            pe[e] = p; }
        float v16[16], v8[8], v4[4], v2[2], lg;
        { const bool h = (F.lane & 32) != 0;
#pragma unroll
          for (int j = 0; j < 16; ++j) { const float send = h ? pe[j].x : pe[j].y, keep = h ? pe[j].y : pe[j].x; v16[j] = keep + __shfl_xor(send, 32); } }
        { const bool h = (F.lane & 16) != 0;
#pragma unroll
          for (int j = 0; j < 8; ++j) { const float send = h ? v16[j] : v16[8 + j], keep = h ? v16[8 + j] : v16[j]; v8[j] = keep + __shfl_xor(send, 16); } }
        { const bool h = (F.lane & 8) != 0;
#pragma unroll
          for (int j = 0; j < 4; ++j) { const float send = h ? v8[j] : v8[4 + j], keep = h ? v8[4 + j] : v8[j]; v4[j] = keep + __shfl_xor(send, 8); } }
        { const bool h = (F.lane & 4) != 0;
#pragma unroll
          for (int j = 0; j < 2; ++j) { const float send = h ? v4[j] : v4[2 + j], keep = h ? v4[2 + j] : v4[j]; v2[j] = keep + __shfl_xor(send, 4); } }
        { const bool h = (F.lane & 2) != 0; const float send = h ? v2[0] : v2[1], keep = h ? v2[1] : v2[0]; lg = keep + __shfl_xor(send, 2); }
        lg += __shfl_xor(lg, 1);
        float mx = lg; mx = fmaxf(mx, __shfl_xor(mx, 2)); mx = fmaxf(mx, __shfl_xor(mx, 4)); mx = fmaxf(mx, __shfl_xor(mx, 8)); mx = fmaxf(mx, __shfl_xor(mx, 16));
        const float ex = expf(lg - mx); float den = ex;
        den += __shfl_xor(den, 2); den += __shfl_xor(den, 4); den += __shfl_xor(den, 8); den += __shfl_xor(den, 16);
        if ((F.lane & 1) == 0 && (F.lane < 32 || hasB)) AFF[(size_t)(F.lane < 32 ? rowA : rowB) * NEXP + ((F.lane >> 1) & 15)] = ex / den;
    }
#undef LN_LD
}

__device__ __forceinline__ void phase_topk(Frame& F, bool with_ctx) {
    LAS unsigned* cnt_sm = (LAS unsigned*)F.lds;
    LAS int* tok_sm = (LAS int*)(F.lds + 1024);
    const float* AFF = (const float*)(F.ws + WS_AFF); short* SLOT = (short*)(F.ws + WS_SLOT); float* GATEE = (float*)(F.ws + WS_GATEE);
    const bf16_t* H = (const bf16_t*)(F.ws + WS_H); bf16_t* XE = (bf16_t*)(F.ws + R_XE);
    const int nun = with_ctx ? 512 : 256;
    for (int un = F.blk; un < nun; un += F.G) {
        const int isc = un >> 8, b = (un >> 4) & 15, e = un & 15;
        const int Tn = isc ? T_CTX : T_LAT, cap = isc ? CAP_C : CAP_L; const int row0 = b * T_ALL + (isc ? 0 : T_CTX);
        unsigned key[4];
#pragma unroll
        for (int i = 0; i < 4; ++i) { const int t = 4 * F.tid + i; key[i] = (t < Tn) ? __builtin_bit_cast(unsigned, AFF[(size_t)(row0 + t) * NEXP + e]) : 0u; }
        unsigned v = 0u;
        for (int bit = 30; bit >= 0; --bit) {
            const unsigned tr = v | (1u << bit);
            int c = (key[0] >= tr) + (key[1] >= tr) + (key[2] >= tr) + (key[3] >= tr);
#pragma unroll
            for (int o = 1; o < 64; o <<= 1) c += __shfl_xor(c, o);
            LAS unsigned* slot = cnt_sm + (bit & 1) * 8;
            if (F.lane == 0) slot[F.wave] = (unsigned)c;
            __syncthreads();
            unsigned tot = 0;
#pragma unroll
            for (int w = 0; w < 8; ++w) tot += slot[w];
            if (tot >= (unsigned)cap) v = tr;
        }
        __syncthreads();
        const int eq = (key[0] == v) + (key[1] == v) + (key[2] == v) + (key[3] == v);
        const int gt = (key[0] > v) + (key[1] > v) + (key[2] > v) + (key[3] > v);
        int incl_eq = eq, incl_gt = gt;
#pragma unroll
        for (int o = 1; o < 64; o <<= 1) { const int a = __shfl_up(incl_eq, o), g2 = __shfl_up(incl_gt, o); if (F.lane >= o) { incl_eq += a; incl_gt += g2; } }
        if (F.lane == 63) { cnt_sm[16 + F.wave] = (unsigned)incl_eq; cnt_sm[24 + F.wave] = (unsigned)incl_gt; }
        __syncthreads();
        int base_eq = 0, base_gt = 0, tot_gt = 0;
#pragma unroll
        for (int w = 0; w < 8; ++w) { const int a = (int)cnt_sm[16 + w], g2 = (int)cnt_sm[24 + w]; if (w < F.wave) { base_eq += a; base_gt += g2; } tot_gt += g2; }
        const int need_eq = cap - tot_gt;
        int eq_before = base_eq + incl_eq - eq, gt_before = base_gt + incl_gt - gt;
#pragma unroll
        for (int i = 0; i < 4; ++i) { const int t = 4 * F.tid + i;
            const bool is_gt = key[i] > v, is_eq = key[i] == v; const bool sel = (t < Tn) && (is_gt || (is_eq && eq_before < need_eq));
            const int slot = gt_before + (eq_before < need_eq ? eq_before : need_eq);
            if (t < Tn) SLOT[(size_t)(row0 + t) * NEXP + e] = sel ? (short)slot : (short)-1;
            if (sel) { tok_sm[slot] = t; GATEE[(size_t)e * EROWS + (isc ? NB * CAP_L + b * CAP_C : b * CAP_L) + slot] = __builtin_bit_cast(float, key[i]); }
            gt_before += is_gt; eq_before += is_eq; }
        __syncthreads();
        const size_t xbase = (size_t)e * EROWS + (isc ? NB * CAP_L + b * CAP_C : b * CAP_L);
        for (int sl = F.wave; sl < cap; sl += 32) {
            u32x4 ra[4], rb[4];
#pragma unroll
            for (int q = 0; q < 4; ++q) { const int t = tok_sm[sl + 8 * q]; const u32x4* src = (const u32x4*)(H + (size_t)(row0 + t) * DM); ra[q] = src[F.lane]; rb[q] = src[64 + F.lane]; }
#pragma unroll
            for (int q = 0; q < 4; ++q) { u32x4* dst = (u32x4*)(XE + (xbase + sl + 8 * q) * DM); dst[F.lane] = ra[q]; dst[64 + F.lane] = rb[q]; } }
        __syncthreads();
    }
}

__device__ __forceinline__ void phase_ln2(Frame& F, int l, bool with_ctx, bool last) {
    float* X = (float*)(F.ws + WS_X); bf16_t* H = (bf16_t*)(F.ws + WS_H); const short* SLOT = (const short*)(F.ws + WS_SLOT); const bf16_t* YE = (const bf16_t*)(F.ws + R_YE);
    const float* g = F.inp(I_LN2G) + l * DM; const float* bt = F.inp(I_LN2B) + l * DM;
    const int stride = F.G * 8, nrows = with_ctx ? ROWS : NB * T_LAT; int it = F.blk * 8 + F.wave;
#define LN2_LD(dst, sl_, i_) do { if ((i_) < nrows) { const int r_ = LN_ROW(i_); sl_ = (F.lane < NEXP) ? (int)SLOT[(size_t)r_ * NEXP + F.lane] : -1; const float* src_ = X + (size_t)r_ * DM; \
        _Pragma("unroll") for (int j = 0; j < 4; ++j) dst[j] = *(const f32x4*)(src_ + 4 * F.lane + 256 * j); } } while (0)
    f32x4 xn[4], xm[4]; int slotn = -1, slotm = -1;
    LN2_LD(xn, slotn, it); LN2_LD(xm, slotm, it + stride);
    for (; it < nrows; it += stride) {
        const int row = LN_ROW(it);
        const int b = row / T_ALL, s = row - b * T_ALL; const bool isc = s < T_CTX;
        const float* md = mod_row(F, l, row);
        f32x4 xc[4]; const int myslot = slotn;
#pragma unroll
        for (int j = 0; j < 4; ++j) { xc[j] = xn[j]; xn[j] = xm[j]; }
        slotn = slotm;
        LN2_LD(xm, slotm, it + 2 * stride);
        f32x4 f[4];
#pragma unroll
        for (int j = 0; j < 4; ++j) f[j] = (f32x4){0.f, 0.f, 0.f, 0.f};
        { unsigned msk = (unsigned)(__builtin_amdgcn_ballot_w64(myslot >= 0) & 0xFFFFull); const size_t ebase = (size_t)(isc ? NB * CAP_L + b * CAP_C : b * CAP_L);
#pragma unroll 1
          while (msk) {
              u32x2 wv[4][4];
#pragma unroll
              for (int k = 0; k < 4; ++k)
#pragma unroll
                  for (int j = 0; j < 4; ++j) wv[k][j] = (u32x2){0u, 0u};
#pragma unroll
              for (int k = 0; k < 4; ++k) { if (msk) { const int e = __builtin_ctz(msk); msk &= msk - 1; const int sl = __builtin_amdgcn_readlane(myslot, e);
                      const bf16_t* yr = YE + ((size_t)e * EROWS + ebase + sl) * DM;
#pragma unroll
                      for (int j = 0; j < 4; ++j) wv[k][j] = *(const u32x2*)(yr + 4 * F.lane + 256 * j); } }
#pragma unroll
              for (int k = 0; k < 4; ++k)
#pragma unroll
                  for (int j = 0; j < 4; ++j) f[j] += (f32x4){bflo(wv[k][j].x), bfhi(wv[k][j].x), bflo(wv[k][j].y), bfhi(wv[k][j].y)}; } }
        f32x4 v[4];
#pragma unroll
        for (int j = 0; j < 4; ++j) { const int c = 4 * F.lane + 256 * j; v[j] = DN_ALPHA * xc[j] + *(const f32x4*)(md + 5120 + c) * f[j]; }
        ln_row(v, g, bt, F.lane);
        if (last) {
            float* o = F.out + ((size_t)b * T_LAT + (s - T_CTX)) * DM;
#pragma unroll
            for (int j = 0; j < 4; ++j) *(f32x4*)(o + 4 * F.lane + 256 * j) = v[j];
        } else {
#pragma unroll
            for (int j = 0; j < 4; ++j) *(f32x4*)(X + (size_t)row * DM + 4 * F.lane + 256 * j) = v[j];
            const float* md1 = mod_row(F, l + 1, row);
            store_mod_bf16(H + (size_t)row * DM, (bf16_t*)F.out + (size_t)row * DM, v, md1, md1 + 1024, F.lane);
        }
    }
#undef LN2_LD
#undef LN_ROW
}
#ifdef PROBE_O1ONLY
#define PROBE_LAM(x) 0.0f
#else
#define PROBE_LAM(x) (x)
#endif
constexpr int AT_KS = 136, AT_VS = 72;
constexpr int AT_KB = 64 * AT_KS * 2, AT_VB = 128 * AT_VS * 2;
constexpr int AT_EX = 0, AT_STG = 65536, AT_SSTR = 132;
__device__ __forceinline__ void attn_unit(Frame& F, const bf16_t* Qb, const bf16_t* Kb, const bf16_t* Vt, bf16_t* Yall, const float* norm_g, float lam, float lam_init,
                                          int b, int h, int qrow0, int krow0, int nkt) {
    const int tid = F.tid, lane = F.lane, wave = F.wave, r32 = lane & 31, hi = lane >> 5, map = wave >> 2, qs = wave & 3;
    LAS unsigned char* lds = F.lds;
    const bf16_t* kg = Kb + (size_t)(krow0 + (tid >> 3)) * 512 + h * 128 + 16 * (tid & 7);
    const bf16_t* vg = Vt + ((size_t)(b * 4 + h) * 128 + (tid >> 2)) * T_ALL + 16 * (tid & 3);
    const int kst = ((tid >> 3) * AT_KS + 16 * (tid & 7)) * 2, vst = ((tid >> 2) * AT_VS + 16 * (tid & 3)) * 2;
    u32x4 kr0, kr1, vr0, vr1;
    kr0 = *(const u32x4*)kg; kr1 = *(const u32x4*)(kg + 8); vr0 = *(const u32x4*)vg; vr1 = *(const u32x4*)(vg + 8);
    bf16x8 qf[4];
    { const bf16_t* qp = Qb + (size_t)(qrow0 + qs * 32 + r32) * 512 + h * 128 + map * 64 + 8 * hi;
#pragma unroll
      for (int ks = 0; ks < 4; ++ks) qf[ks] = *(const bf16x8*)(qp + 16 * ks); }
    *(LAS u32x4*)(lds + kst) = kr0; *(LAS u32x4*)(lds + kst + 16) = kr1;
    *(LAS u32x4*)(lds + 2 * AT_KB + vst) = vr0; *(LAS u32x4*)(lds + 2 * AT_KB + vst + 16) = vr1;
    __syncthreads();
    f32x16 o[4];
#pragma unroll
    for (int d = 0; d < 4; ++d)
#pragma unroll
        for (int r = 0; r < 16; ++r) o[d][r] = 0.f;
    float m_run = -INFINITY, l_run = 0.f;
    const int koff = (r32 * AT_KS + map * 64 + 8 * hi) * 2, voff = (r32 * AT_VS + 8 * hi) * 2;
    for (int kt = 0; kt < nkt; ++kt) {
        const int buf = kt & 1;
        if (kt + 1 < nkt) { const bf16_t* kn = kg + (size_t)(kt + 1) * 64 * 512; const bf16_t* vn = vg + (kt + 1) * 64;
            kr0 = *(const u32x4*)kn; kr1 = *(const u32x4*)(kn + 8); vr0 = *(const u32x4*)vn; vr1 = *(const u32x4*)(vn + 8); }
        LAS unsigned char* kb = lds + buf * AT_KB + koff; LAS unsigned char* vb = lds + 2 * AT_KB + buf * AT_VB + voff;
        f32x16 p0, p1;
#pragma unroll
        for (int r = 0; r < 16; ++r) { p0[r] = 0.f; p1[r] = 0.f; }
#pragma unroll
        for (int ks = 0; ks < 4; ++ks) { const bf16x8 ka = *(const LAS bf16x8*)(kb + 32 * ks), kc = *(const LAS bf16x8*)(kb + 32 * AT_KS * 2 + 32 * ks);
            p0 = __builtin_amdgcn_mfma_f32_32x32x16_bf16(ka, qf[ks], p0, 0, 0, 0); p1 = __builtin_amdgcn_mfma_f32_32x32x16_bf16(kc, qf[ks], p1, 0, 0, 0); }
        float rm = fmaxf(p0[0], p1[0]);
#pragma unroll
        for (int r = 1; r < 16; ++r) rm = fmaxf(rm, fmaxf(p0[r], p1[r]));
        rm = xhalf_max(rm);
        if (__builtin_amdgcn_ballot_w64(rm > m_run) != 0ull) {
            const float mn = fmaxf(m_run, rm), alpha = fast_exp2(m_run - mn);
            l_run *= alpha; m_run = mn;
#pragma unroll
            for (int d = 0; d < 4; ++d)
#pragma unroll
                for (int r = 0; r < 16; ++r) o[d][r] *= alpha;
        }
        float ls = 0.f;
#pragma unroll
        for (int r = 0; r < 16; ++r) { p0[r] = fast_exp2(p0[r] - m_run); p1[r] = fast_exp2(p1[r] - m_run); ls += p0[r] + p1[r]; }
        l_run += ls;
        u32x4 pw[4];
#pragma unroll
        for (int s2 = 0; s2 < 2; ++s2) {
            pw[s2] = (u32x4){cvt_pk_bf16(p0[8 * s2 + 0], p0[8 * s2 + 1]), cvt_pk_bf16(p0[8 * s2 + 2], p0[8 * s2 + 3]), cvt_pk_bf16(p0[8 * s2 + 4], p0[8 * s2 + 5]), cvt_pk_bf16(p0[8 * s2 + 6], p0[8 * s2 + 7])};
            pw[2 + s2] = (u32x4){cvt_pk_bf16(p1[8 * s2 + 0], p1[8 * s2 + 1]), cvt_pk_bf16(p1[8 * s2 + 2], p1[8 * s2 + 3]), cvt_pk_bf16(p1[8 * s2 + 4], p1[8 * s2 + 5]), cvt_pk_bf16(p1[8 * s2 + 6], p1[8 * s2 + 7])}; }
#pragma unroll
        for (int d = 0; d < 4; ++d)
#pragma unroll
            for (int s = 0; s < 4; ++s) { const bf16x8 va = *(const LAS bf16x8*)(vb + d * 32 * AT_VS * 2 + 32 * s);
                o[d] = __builtin_amdgcn_mfma_f32_32x32x16_bf16(va, __builtin_bit_cast(bf16x8, pw[s]), o[d], 0, 0, 0); }
        if (kt + 1 < nkt) { const int nb = buf ^ 1;
            *(LAS u32x4*)(lds + nb * AT_KB + kst) = kr0; *(LAS u32x4*)(lds + nb * AT_KB + kst + 16) = kr1;
            *(LAS u32x4*)(lds + 2 * AT_KB + nb * AT_VB + vst) = vr0; *(LAS u32x4*)(lds + 2 * AT_KB + nb * AT_VB + vst + 16) = vr1; }
        __syncthreads();
    }
    { const float inv = 1.0f / xhalf_sum(l_run);
#pragma unroll
      for (int d = 0; d < 4; ++d)
#pragma unroll
          for (int r = 0; r < 16; ++r) o[d][r] *= inv; }
    LAS float* ex = (LAS float*)(lds + AT_EX);
    if (map == 1) {
#pragma unroll
        for (int d = 0; d < 4; ++d)
#pragma unroll
            for (int r = 0; r < 16; ++r) ex[((qs * 64) + d * 16 + r) * 64 + lane] = o[d][r];
    }
    __syncthreads();
    if (map == 0) {
        float ss = 0.f;
#pragma unroll
        for (int d = 0; d < 4; ++d)
#pragma unroll
            for (int r = 0; r < 16; ++r) { const float v = o[d][r] - PROBE_LAM(lam) * ex[((qs * 64) + d * 16 + r) * 64 + lane]; o[d][r] = v; ss += v * v; }
        ss = xhalf_sum(ss);
        float sc = (1.0f / sqrtf(ss * (1.0f / 128.0f) + DA_EPS)) * (1.0f - lam_init);
#ifdef PROBE_O1ONLY
        sc = 16.0f;
#endif
        LAS bf16_t* stg = (LAS bf16_t*)(lds + AT_STG) + qs * 32 * AT_SSTR;
#pragma unroll
        for (int d = 0; d < 4; ++d)
#pragma unroll
            for (int g4 = 0; g4 < 4; ++g4) { const int dim = 32 * d + 8 * g4 + 4 * hi; const f32x4 ng = *(const f32x4*)(norm_g + dim);
                u32x2 w; w.x = cvt_pk_bf16(o[d][4 * g4] * sc * ng[0], o[d][4 * g4 + 1] * sc * ng[1]); w.y = cvt_pk_bf16(o[d][4 * g4 + 2] * sc * ng[2], o[d][4 * g4 + 3] * sc * ng[3]);
                *(LAS u32x2*)(stg + r32 * AT_SSTR + dim) = w; }
        LDS_WAIT();
#pragma unroll
        for (int it = 0; it < 8; ++it) { const int row = it * 4 + (lane >> 4), ch = lane & 15;
            const u32x2 a = *(const LAS u32x2*)(stg + row * AT_SSTR + ch * 8), c = *(const LAS u32x2*)(stg + row * AT_SSTR + ch * 8 + 4);
            *(u32x4*)(Yall + (size_t)(qrow0 + qs * 32 + row) * MIXW + h * 128 + ch * 8) = (u32x4){a.x, a.y, c.x, c.y}; }
    }
    __syncthreads();
}
__device__ __forceinline__ void phase_attn(Frame& F, int l, bool with_ctx) {
    const bf16_t* Qb = (const bf16_t*)(F.ws + R_Q); const bf16_t* Kb = (const bf16_t*)(F.ws + R_K); const bf16_t* Vt = (const bf16_t*)(F.ws + R_VT); bf16_t* Yall = (bf16_t*)F.out;
    const float* sc = (const float*)(F.ws + WS_SMALL + 16384); const float lam = sc[2 * l], lam_init = sc[2 * l + 1];
    const float* ng = F.inp(I_DANG) + l * 128;
    const int nun = 1024 + (with_ctx ? 128 : 0);
    for (int un = F.blk; un < nun; un += F.G) {
        if (un < 1024) { const int b = un >> 6, h = (un >> 4) & 3, qb = un & 15;
#ifdef PROBE_SKIPCTX_L1
            if (l == 1) attn_unit(F, Qb, Kb, Vt + T_CTX, Yall, ng, lam, lam_init, b, h, b * T_ALL + T_CTX + qb * 128, b * T_ALL + T_CTX, 32); else
#endif
            attn_unit(F, Qb, Kb, Vt, Yall, ng, lam, lam_init, b, h, b * T_ALL + T_CTX + qb * 128, b * T_ALL, 36);
        } else { const int u2 = un - 1024; const int b = u2 >> 3, h = (u2 >> 1) & 3, qb = u2 & 1;
            attn_unit(F, Qb, Kb, Vt, Yall, ng, lam, lam_init, b, h, b * T_ALL + qb * 128, b * T_ALL, 4); }
    }
}

constexpr int RW_CH = 32;
constexpr int RWL_FEAT = 0, RWL_XW = 49152, RWL_XA = 57856, RWL_PW = 66560, RWL_PA = 74752, RWL_YB = 82944;
__device__ __forceinline__ f32x4 ld_bf4(const bf16_t* p) { const u32x2 w = *(const u32x2*)p; return (f32x4){bflo(w.x), bfhi(w.x), bflo(w.y), bfhi(w.y)}; }
__device__ __forceinline__ f32x4 shift4(const bf16_t* cur, bool hp, bool hn, const float* mu0, const float* mu1) {
    const f32x4 p = ld_bf4(cur); const f32x4 pv = hp ? ld_bf4(cur - RW_COLS) : (f32x4){0.f, 0.f, 0.f, 0.f}; const f32x4 nx = hn ? ld_bf4(cur + RW_COLS) : (f32x4){0.f, 0.f, 0.f, 0.f};
    return p + *(const f32x4*)mu0 * (pv - p) + *(const f32x4*)mu1 * (nx - p);
}
__device__ __forceinline__ void rwkv_scan_unit(Frame& F, int l, int b, int hd, int z, bool emit_ctx) {
    const int tid = F.tid, lane = F.lane, wave = F.wave;
    LAS float* FEAT = (LAS float*)(F.lds + RWL_FEAT); LAS float* XW = (LAS float*)(F.lds + RWL_XW); LAS float* XA = (LAS float*)(F.lds + RWL_XA);
    LAS float* PW = (LAS float*)(F.lds + RWL_PW); LAS float* PA = (LAS float*)(F.lds + RWL_PA); LAS float* YB = (LAS float*)(F.lds + RWL_YB);
    const bf16_t* PRW = (const bf16_t*)(F.ws + R_PRW); const bf16_t* KLO = (const bf16_t*)(F.ws + R_KLO); float* Y = (float*)(F.ws + R_YFB) + (size_t)z * ROWS * 512; float* BON = (float*)(F.ws + WS_BONUS) + (size_t)z * ROWS * 8;
    const float* mu = F.inp(I_RWMU) + (size_t)l * 2 * RW_COLS; const float* mu0 = mu, *mu1 = mu + RW_COLS;
    const float* w0 = F.inp(I_RWW0) + ((size_t)l * 2 + z) * 512 + hd * 64; const float* a0 = F.inp(I_RWA0) + ((size_t)l * 2 + z) * 512 + hd * 64;
    const float* w2 = F.inp(I_RWW2) + ((size_t)l * 2 + z) * 64 * 512; const float* a2 = F.inp(I_RWA2) + ((size_t)l * 2 + z) * 64 * 512;
    const float* k_k = F.inp(I_RWKK) + l * 512 + hd * 64; const float* k_a = F.inp(I_RWKA) + l * 512 + hd * 64; const float* r_k = F.inp(I_RWRK) + l * 512 + hd * 64;
    float breg[16];
    { const float* src = (wave < 4 ? w2 : a2) + hd * 64 + 16 * (wave & 3) + (lane & 15);
#pragma unroll
      for (int ks = 0; ks < 16; ++ks) breg[ks] = src[(size_t)(4 * ks + (lane >> 4)) * 512]; }
    const int tt = tid >> 4, jq = tid & 15, j4 = 4 * jq;
    const f32x4 w0c = *(const f32x4*)(w0 + j4), a0c = *(const f32x4*)(a0 + j4), kkc = *(const f32x4*)(k_k + j4), kac = *(const f32x4*)(k_a + j4), rkc = *(const f32x4*)(r_k + j4);
    f32x4 S0 = (f32x4){0.f, 0.f, 0.f, 0.f}, S1 = S0;
    u32x2 raw[5][3];
#define RW_CHUNK_GEOM(ci_) const bool isc_ = (ci_) < 8; const int cc_ = isc_ ? (z ? 7 - (ci_) : (ci_)) : (z ? 63 - ((ci_) - 8) : ((ci_) - 8)); \
        const int len_ = isc_ ? T_CTX : T_LAT; const int rb_ = b * T_ALL + (isc_ ? 0 : T_CTX); const int t_ = cc_ * RW_CH + tt;
#define RW_LOADRAW(ci_) do { RW_CHUNK_GEOM(ci_) const int tp_ = t_ > 0 ? t_ - 1 : t_, tn_ = t_ < len_ - 1 ? t_ + 1 : t_; \
        const bf16_t* pc_ = PRW + (size_t)(rb_ + t_) * RW_COLS; const bf16_t* pp_ = PRW + (size_t)(rb_ + tp_) * RW_COLS; const bf16_t* pn_ = PRW + (size_t)(rb_ + tn_) * RW_COLS; \
        const int cg_[5] = {hd * 64 + j4, 512 + hd * 64 + j4, 1024 + hd * 64 + j4, 1536 + j4, 1600 + j4}; \
        _Pragma("unroll") for (int g_ = 0; g_ < 5; ++g_) { raw[g_][0] = *(const u32x2*)(pp_ + cg_[g_]); raw[g_][1] = *(const u32x2*)(pc_ + cg_[g_]); raw[g_][2] = *(const u32x2*)(pn_ + cg_[g_]); } } while (0)
    RW_LOADRAW(0);
    for (int ci = 0; ci < 72; ++ci) {
        const bool isc = ci < 8; const int cc = isc ? (z ? 7 - ci : ci) : (z ? 63 - (ci - 8) : (ci - 8));
        const int len = isc ? T_CTX : T_LAT; const int rb = b * T_ALL + (isc ? 0 : T_CTX); const int t0 = cc * RW_CH;
        const int t = t0 + tt; const float fp = t > 0 ? 1.f : 0.f, fn = t < len - 1 ? 1.f : 0.f;
        f32x4 sh[5];
        { const int cg[5] = {hd * 64 + j4, 512 + hd * 64 + j4, 1024 + hd * 64 + j4, 1536 + j4, 1600 + j4};
#pragma unroll
          for (int g = 0; g < 5; ++g) { const f32x4 pv = (f32x4){bflo(raw[g][0].x), bfhi(raw[g][0].x), bflo(raw[g][0].y), bfhi(raw[g][0].y)} * fp;
              const f32x4 p = (f32x4){bflo(raw[g][1].x), bfhi(raw[g][1].x), bflo(raw[g][1].y), bfhi(raw[g][1].y)};
              const f32x4 nx = (f32x4){bflo(raw[g][2].x), bfhi(raw[g][2].x), bflo(raw[g][2].y), bfhi(raw[g][2].y)} * fn;
              sh[g] = p + *(const f32x4*)(mu0 + cg[g]) * (pv - p) + *(const f32x4*)(mu1 + cg[g]) * (nx - p); } }
        const f32x4 r4 = sh[0], k4 = sh[1], v4 = sh[2];
        *(LAS f32x4*)(XW + tt * 68 + j4) = (f32x4){tanhf_(sh[3][0]), tanhf_(sh[3][1]), tanhf_(sh[3][2]), tanhf_(sh[3][3])}; *(LAS f32x4*)(XA + tt * 68 + j4) = sh[4];
        if (ci + 1 < 72) RW_LOADRAW(ci + 1);
        __syncthreads();
        { const LAS float* Xs = (wave < 4) ? XW : XA; LAS float* Ps = (wave < 4) ? PW : PA;
#pragma unroll
          for (int mt = 0; mt < 2; ++mt) { f32x4 acc = (f32x4){0.f, 0.f, 0.f, 0.f}, acc2 = acc;
#pragma unroll
              for (int ks = 0; ks < 16; ks += 2) { acc = __builtin_amdgcn_mfma_f32_16x16x4f32(Xs[(mt * 16 + (lane & 15)) * 68 + 4 * ks + (lane >> 4)], breg[ks], acc, 0, 0, 0);
                  acc2 = __builtin_amdgcn_mfma_f32_16x16x4f32(Xs[(mt * 16 + (lane & 15)) * 68 + 4 * (ks + 1) + (lane >> 4)], breg[ks + 1], acc2, 0, 0, 0); }
              acc += acc2;
#pragma unroll
              for (int rg = 0; rg < 4; ++rg) Ps[(mt * 16 + 4 * (lane >> 4) + rg) * 64 + 16 * (wave & 3) + (lane & 15)] = acc[rg]; } }
        __syncthreads();
        { const f32x4 pw = *(const LAS f32x4*)(PW + tt * 64 + j4) + w0c, pa = *(const LAS f32x4*)(PA + tt * 64 + j4) + a0c;
          f32x4 dec, av, kkr, kd, bb; float ss = 0.f, bo = 0.f;
#pragma unroll
          for (int i = 0; i < 4; ++i) { dec[i] = __expf(-0.6065306597126334f * sigmoidf_(pw[i])); av[i] = sigmoidf_(pa[i]); kkr[i] = k4[i] * kkc[i]; ss += kkr[i] * kkr[i];
              kd[i] = k4[i] * (1.0f + (av[i] - 1.0f) * kac[i]); bo += r4[i] * kd[i] * rkc[i]; }
          ss = sum16(ss); bo = sum16(bo);
          const float inv = 1.0f / fmaxf(sqrtf(ss), 1e-12f);
#pragma unroll
          for (int i = 0; i < 4; ++i) { kkr[i] *= inv; bb[i] = kkr[i] * av[i]; }
          *(LAS f32x4*)(FEAT + (0 * 32 + tt) * 64 + j4) = kkr; *(LAS f32x4*)(FEAT + (1 * 32 + tt) * 64 + j4) = dec; *(LAS f32x4*)(FEAT + (2 * 32 + tt) * 64 + j4) = bb;
          *(LAS f32x4*)(FEAT + (3 * 32 + tt) * 64 + j4) = kd; *(LAS f32x4*)(FEAT + (4 * 32 + tt) * 64 + j4) = r4; *(LAS f32x4*)(FEAT + (5 * 32 + tt) * 64 + j4) = v4;
          if (jq == 0) BON[(size_t)(rb + t) * 8 + hd] = bo; }
        __syncthreads();
        { const int ri = tid >> 3, c8 = 8 * (tid & 7);
#define RW_LOADF(ts_) kkA = *(const LAS f32x4*)(FEAT + (0 * 32 + (ts_)) * 64 + c8); kkB = *(const LAS f32x4*)(FEAT + (0 * 32 + (ts_)) * 64 + c8 + 4); \
          wdA = *(const LAS f32x4*)(FEAT + (1 * 32 + (ts_)) * 64 + c8); wdB = *(const LAS f32x4*)(FEAT + (1 * 32 + (ts_)) * 64 + c8 + 4); \
          bbA = *(const LAS f32x4*)(FEAT + (2 * 32 + (ts_)) * 64 + c8); bbB = *(const LAS f32x4*)(FEAT + (2 * 32 + (ts_)) * 64 + c8 + 4); \
          kdA = *(const LAS f32x4*)(FEAT + (3 * 32 + (ts_)) * 64 + c8); kdB = *(const LAS f32x4*)(FEAT + (3 * 32 + (ts_)) * 64 + c8 + 4); \
          rrA = *(const LAS f32x4*)(FEAT + (4 * 32 + (ts_)) * 64 + c8); rrB = *(const LAS f32x4*)(FEAT + (4 * 32 + (ts_)) * 64 + c8 + 4); vv = FEAT[(5 * 32 + (ts_)) * 64 + ri];
          f32x4 kkA, kkB, wdA, wdB, bbA, bbB, kdA, kdB, rrA, rrB; float vv;
#ifdef PROBE_REPLOOP
          const f32x4 S0s = S0, S1s = S1;
#pragma unroll 1
          for (int rep2 = 0; rep2 < 2; ++rep2) { S0 = S0s; S1 = S1s;
#endif
          { const int ts0 = z ? (RW_CH - 1) : 0; RW_LOADF(ts0) }
#pragma unroll 2
          for (int st = 0; st < RW_CH; ++st) { const int ts = z ? (RW_CH - 1 - st) : st; const int tn = (st + 1 < RW_CH) ? (z ? ts - 1 : ts + 1) : ts;
            const f32x4 ckA = kkA, ckB = kkB, cwA = wdA, cwB = wdB, cbA = bbA, cbB = bbB, cdA = kdA, cdB = kdB, crA = rrA, crB = rrB; const float cv = vv;
            RW_LOADF(tn)
            float sa = -(((S0[0] * ckA[0] + S0[1] * ckA[1]) + (S0[2] * ckA[2] + S0[3] * ckA[3])) + ((S1[0] * ckB[0] + S1[1] * ckB[1]) + (S1[2] * ckB[2] + S1[3] * ckB[3])));
            sa = sum8(sa);
            S0 = S0 * cwA + sa * cbA + cv * cdA; S1 = S1 * cwB + sa * cbB + cv * cdB;
            float y = ((S0[0] * crA[0] + S0[1] * crA[1]) + (S0[2] * crA[2] + S0[3] * crA[3])) + ((S1[0] * crB[0] + S1[1] * crB[1]) + (S1[2] * crB[2] + S1[3] * crB[3]));
            y = sum8(y);
            if ((tid & 7) == 0) YB[ts * 64 + ri] = y; }
#ifdef PROBE_REPLOOP
          }
#endif
#undef RW_LOADF
        }
        __syncthreads();
        if (!isc || emit_ctx) *(f32x4*)(Y + (size_t)(rb + t) * 512 + hd * 64 + j4) = *(const LAS f32x4*)(YB + tt * 64 + j4);
    }
    __syncthreads();
}

constexpr int RW2_FEAT = 0  , RW2_XW = 98304, RW2_XA = 107008, RW2_PW = 115712, RW2_PA = 123904, RW2_YB = 132096  , RW2_CT = 148480  ;
__device__ __forceinline__ void rwkv_scan_unit2(Frame& F, int l, int b, int hd, int z, bool emit_ctx) {
    const int tid = F.tid, wave = F.wave;
    LAS float* FEAT0 = (LAS float*)(F.lds + RW2_FEAT); LAS float* XW = (LAS float*)(F.lds + RW2_XW); LAS float* XA = (LAS float*)(F.lds + RW2_XA);
    LAS float* PW = (LAS float*)(F.lds + RW2_PW); LAS float* PA = (LAS float*)(F.lds + RW2_PA); LAS float* YB0 = (LAS float*)(F.lds + RW2_YB);
    const bf16_t* PRW = (const bf16_t*)(F.ws + R_PRW); float* Y = (float*)(F.ws + R_YFB) + (size_t)z * ROWS * 512; float* BON = (float*)(F.ws + WS_BONUS) + (size_t)z * ROWS * 8;
#define RW2_GEOM(ci_, cc_, len_, rb_) const bool isc_##cc_ = (ci_) < 8; const int cc_ = isc_##cc_ ? (z ? 7 - (ci_) : (ci_)) : (z ? 63 - ((ci_) - 8) : ((ci_) - 8)); \
        const int len_ = isc_##cc_ ? T_CTX : T_LAT; const int rb_ = b * T_ALL + (isc_##cc_ ? 0 : T_CTX);
    if (wave < 4) {
        const int cg8 = 8 * (tid & 7), ri0 = tid >> 3, ri1 = ri0 + 32;
        f32x4 A0 = (f32x4){0.f, 0.f, 0.f, 0.f}, B0 = A0, A1 = A0, B1 = A0;
        __syncthreads(); __syncthreads(); __syncthreads();
        for (int ci = 0; ci < 72; ++ci) {
            const LAS float* FT = FEAT0 + (ci & 1) * 12288; LAS float* YB = YB0 + (ci & 1) * 2048;
#define RW2_LD(ts_) kkA = *(const LAS f32x4*)(FT + (0 * 32 + (ts_)) * 64 + cg8); kkB = *(const LAS f32x4*)(FT + (0 * 32 + (ts_)) * 64 + cg8 + 4); \
            wdA = *(const LAS f32x4*)(FT + (1 * 32 + (ts_)) * 64 + cg8); wdB = *(const LAS f32x4*)(FT + (1 * 32 + (ts_)) * 64 + cg8 + 4); \
            bbA = *(const LAS f32x4*)(FT + (2 * 32 + (ts_)) * 64 + cg8); bbB = *(const LAS f32x4*)(FT + (2 * 32 + (ts_)) * 64 + cg8 + 4); \
            kdA = *(const LAS f32x4*)(FT + (3 * 32 + (ts_)) * 64 + cg8); kdB = *(const LAS f32x4*)(FT + (3 * 32 + (ts_)) * 64 + cg8 + 4); \
            rrA = *(const LAS f32x4*)(FT + (4 * 32 + (ts_)) * 64 + cg8); rrB = *(const LAS f32x4*)(FT + (4 * 32 + (ts_)) * 64 + cg8 + 4); v0 = FT[(5 * 32 + (ts_)) * 64 + ri0]; v1 = FT[(5 * 32 + (ts_)) * 64 + ri1];
            f32x4 kkA, kkB, wdA, wdB, bbA, bbB, kdA, kdB, rrA, rrB; float v0, v1;
            { const int ts0 = z ? (RW_CH - 1) : 0; RW2_LD(ts0) }
#pragma unroll 1
            for (int seg = 0; seg < 3; ++seg) {
                const int s_lo = seg == 0 ? 0 : (seg == 1 ? 11 : 22), s_hi = seg == 0 ? 11 : (seg == 1 ? 22 : RW_CH);
#pragma unroll 2
                for (int st = s_lo; st < s_hi; ++st) { const int ts = z ? (RW_CH - 1 - st) : st; const int tn = (st + 1 < RW_CH) ? (z ? ts - 1 : ts + 1) : ts;
                    const f32x4 ckA = kkA, ckB = kkB, cwA = wdA, cwB = wdB, cbA = bbA, cbB = bbB, cdA = kdA, cdB = kdB, crA = rrA, crB = rrB; const float cv0 = v0, cv1 = v1;
                    RW2_LD(tn)
                    float sa0 = -(((A0[0] * ckA[0] + A0[1] * ckA[1]) + (A0[2] * ckA[2] + A0[3] * ckA[3])) + ((B0[0] * ckB[0] + B0[1] * ckB[1]) + (B0[2] * ckB[2] + B0[3] * ckB[3])));
                    float sa1 = -(((A1[0] * ckA[0] + A1[1] * ckA[1]) + (A1[2] * ckA[2] + A1[3] * ckA[3])) + ((B1[0] * ckB[0] + B1[1] * ckB[1]) + (B1[2] * ckB[2] + B1[3] * ckB[3])));
                    sa0 = sum8(sa0); sa1 = sum8(sa1);
                    A0 = A0 * cwA + sa0 * cbA + cv0 * cdA; B0 = B0 * cwB + sa0 * cbB + cv0 * cdB; A1 = A1 * cwA + sa1 * cbA + cv1 * cdA; B1 = B1 * cwB + sa1 * cbB + cv1 * cdB;
                    float y0 = ((A0[0] * crA[0] + A0[1] * crA[1]) + (A0[2] * crA[2] + A0[3] * crA[3])) + ((B0[0] * crB[0] + B0[1] * crB[1]) + (B0[2] * crB[2] + B0[3] * crB[3]));
                    float y1 = ((A1[0] * crA[0] + A1[1] * crA[1]) + (A1[2] * crA[2] + A1[3] * crA[3])) + ((B1[0] * crB[0] + B1[1] * crB[1]) + (B1[2] * crB[2] + B1[3] * crB[3]));
                    y0 = sum8(y0); y1 = sum8(y1);
                    if ((tid & 7) == 0) { YB[ts * 64 + ri0] = y0; YB[ts * 64 + ri1] = y1; } }
                __syncthreads();
            }
#undef RW2_LD
        }
        __syncthreads();
    } else {
        int tzp = tid; asm volatile("" : "+v"(tzp));
        const int p = tzp - 256, tt = p >> 3, j8 = 8 * (p & 7), pw = wave - 4; const int lane = tzp & 63;
        const float* mu = F.inp(I_RWMU) + (size_t)l * 2 * RW_COLS; const float* mu0 = mu, *mu1 = mu + RW_COLS;
        const float* w0 = F.inp(I_RWW0) + ((size_t)l * 2 + z) * 512 + hd * 64; const float* a0 = F.inp(I_RWA0) + ((size_t)l * 2 + z) * 512 + hd * 64;
        const float* w2 = F.inp(I_RWW2) + ((size_t)l * 2 + z) * 64 * 512; const float* a2 = F.inp(I_RWA2) + ((size_t)l * 2 + z) * 64 * 512;
        const float* k_k = F.inp(I_RWKK) + l * 512 + hd * 64; const float* k_a = F.inp(I_RWKA) + l * 512 + hd * 64; const float* r_k = F.inp(I_RWRK) + l * 512 + hd * 64;
        float breg[2][16];
        { const float* src = (pw < 2 ? w2 : a2) + hd * 64 + 32 * (pw & 1) + (lane & 15) + (size_t)(lane >> 4) * 512;
#pragma unroll
          for (int ks = 0; ks < 16; ++ks) { breg[0][ks] = src[0]; breg[1][ks] = src[16]; src += 4 * 512; asm volatile("" : "+v"(src)); } }
        LAS float* CT = (LAS float*)(F.lds + RW2_CT);
        if (p < 64) { CT[p] = w0[p]; CT[64 + p] = a0[p]; CT[128 + p] = k_k[p]; CT[192 + p] = k_a[p]; CT[256 + p] = r_k[p]; }
        u32x4 raw[5][3];
#define RW2_LOADRAW(ci_) do { RW2_GEOM(ci_, ccL, lenL, rbL) const int tL = ccL * RW_CH + tt; const int tpL = tL > 0 ? tL - 1 : tL, tnL = tL < lenL - 1 ? tL + 1 : tL; \
            const bf16_t* pcL = PRW + (size_t)(rbL + tL) * RW_COLS; const bf16_t* ppL = PRW + (size_t)(rbL + tpL) * RW_COLS; const bf16_t* pnL = PRW + (size_t)(rbL + tnL) * RW_COLS; \
            const int cgL[5] = {hd * 64 + j8, 512 + hd * 64 + j8, 1024 + hd * 64 + j8, 1536 + j8, 1600 + j8}; \
            _Pragma("unroll") for (int g_ = 0; g_ < 5; ++g_) { raw[g_][0] = *(const u32x4*)(ppL + cgL[g_]); raw[g_][1] = *(const u32x4*)(pcL + cgL[g_]); raw[g_][2] = *(const u32x4*)(pnL + cgL[g_]); } } while (0)
        RW2_LOADRAW(0);
        for (int ci = -1; ci < 72; ++ci) {
            const int cn = ci + 1;
            if (ci >= 1) { const int cp = ci - 1; RW2_GEOM(cp, ccP, lenP, rbP) (void)lenP;
                if (!isc_ccP || emit_ctx) { const LAS float* YBp = YB0 + (cp & 1) * 2048;
#pragma unroll
                    for (int h2 = 0; h2 < 2; ++h2) *(f32x4*)(Y + (size_t)(rbP + ccP * RW_CH + tt) * 512 + hd * 64 + j8 + 4 * h2) = *(const LAS f32x4*)(YBp + tt * 64 + j8 + 4 * h2); } }
            f32x4 r8[2], k8[2], v8[2]; int rbN = 0, tN = 0;
            if (cn < 72) {
                RW2_GEOM(cn, ccN, lenN, rbN_) rbN = rbN_; tN = ccN * RW_CH + tt; const float fp = tN > 0 ? 1.f : 0.f, fn = tN < lenN - 1 ? 1.f : 0.f;
                const int cg[5] = {hd * 64 + j8, 512 + hd * 64 + j8, 1024 + hd * 64 + j8, 1536 + j8, 1600 + j8};
                f32x4 sh[5][2];
#pragma unroll
                for (int g = 0; g < 5; ++g)
#pragma unroll
                    for (int h2 = 0; h2 < 2; ++h2) { const unsigned pa_ = h2 ? raw[g][0].z : raw[g][0].x, pb_ = h2 ? raw[g][0].w : raw[g][0].y, ca_ = h2 ? raw[g][1].z : raw[g][1].x, cb_ = h2 ? raw[g][1].w : raw[g][1].y, na_ = h2 ? raw[g][2].z : raw[g][2].x, nb_ = h2 ? raw[g][2].w : raw[g][2].y;
                        const f32x4 pv = (f32x4){bflo(pa_), bfhi(pa_), bflo(pb_), bfhi(pb_)} * fp, pc = (f32x4){bflo(ca_), bfhi(ca_), bflo(cb_), bfhi(cb_)}, nx = (f32x4){bflo(na_), bfhi(na_), bflo(nb_), bfhi(nb_)} * fn;
                        sh[g][h2] = pc + *(const f32x4*)(mu0 + cg[g] + 4 * h2) * (pv - pc) + *(const f32x4*)(mu1 + cg[g] + 4 * h2) * (nx - pc); }
#pragma unroll
                for (int h2 = 0; h2 < 2; ++h2) { r8[h2] = sh[0][h2]; k8[h2] = sh[1][h2]; v8[h2] = sh[2][h2];
                    *(LAS f32x4*)(XW + tt * 68 + j8 + 4 * h2) = (f32x4){tanhf_(sh[3][h2][0]), tanhf_(sh[3][h2][1]), tanhf_(sh[3][h2][2]), tanhf_(sh[3][h2][3])}; *(LAS f32x4*)(XA + tt * 68 + j8 + 4 * h2) = sh[4][h2]; }
                if (cn + 1 < 72) RW2_LOADRAW(cn + 1);
            }
            __syncthreads();
            if (cn < 72) { const LAS float* Xs = (pw < 2) ? XW : XA; LAS float* Ps = (pw < 2) ? PW : PA;
#pragma unroll
                for (int n = 0; n < 2; ++n)
#pragma unroll
                    for (int mt = 0; mt < 2; ++mt) { f32x4 acc = (f32x4){0.f, 0.f, 0.f, 0.f}, acc2 = acc;
#pragma unroll
                        for (int ks = 0; ks < 16; ks += 2) { acc = __builtin_amdgcn_mfma_f32_16x16x4f32(Xs[(mt * 16 + (lane & 15)) * 68 + 4 * ks + (lane >> 4)], breg[n][ks], acc, 0, 0, 0);
                            acc2 = __builtin_amdgcn_mfma_f32_16x16x4f32(Xs[(mt * 16 + (lane & 15)) * 68 + 4 * (ks + 1) + (lane >> 4)], breg[n][ks + 1], acc2, 0, 0, 0); }
                        acc += acc2;
#pragma unroll
                        for (int rg = 0; rg < 4; ++rg) Ps[(mt * 16 + 4 * (lane >> 4) + rg) * 64 + 32 * (pw & 1) + 16 * n + (lane & 15)] = acc[rg]; } }
            __syncthreads();
            if (cn < 72) { LAS float* FT = FEAT0 + (cn & 1) * 12288;
                f32x4 dec[2], av[2], kkr[2], kd[2], bb[2]; float ss = 0.f, bo = 0.f;
#pragma unroll
                for (int h2 = 0; h2 < 2; ++h2) { const f32x4 pwv = *(const LAS f32x4*)(PW + tt * 64 + j8 + 4 * h2) + *(const LAS f32x4*)(CT + j8 + 4 * h2), pav = *(const LAS f32x4*)(PA + tt * 64 + j8 + 4 * h2) + *(const LAS f32x4*)(CT + 64 + j8 + 4 * h2);
                    const f32x4 kkc_ = *(const LAS f32x4*)(CT + 128 + j8 + 4 * h2), kac_ = *(const LAS f32x4*)(CT + 192 + j8 + 4 * h2), rkc_ = *(const LAS f32x4*)(CT + 256 + j8 + 4 * h2);
#pragma unroll
                    for (int i = 0; i < 4; ++i) { dec[h2][i] = __expf(-0.6065306597126334f * sigmoidf_(pwv[i])); av[h2][i] = sigmoidf_(pav[i]); kkr[h2][i] = k8[h2][i] * kkc_[i]; ss += kkr[h2][i] * kkr[h2][i];
                        kd[h2][i] = k8[h2][i] * (1.0f + (av[h2][i] - 1.0f) * kac_[i]); bo += r8[h2][i] * kd[h2][i] * rkc_[i]; } }
                ss = sum8(ss); bo = sum8(bo);
                const float inv = 1.0f / fmaxf(sqrtf(ss), 1e-12f);
#pragma unroll
                for (int h2 = 0; h2 < 2; ++h2) { kkr[h2] = kkr[h2] * inv; bb[h2] = kkr[h2] * av[h2];
                    *(LAS f32x4*)(FT + (0 * 32 + tt) * 64 + j8 + 4 * h2) = kkr[h2]; *(LAS f32x4*)(FT + (1 * 32 + tt) * 64 + j8 + 4 * h2) = dec[h2]; *(LAS f32x4*)(FT + (2 * 32 + tt) * 64 + j8 + 4 * h2) = bb[h2];
                    *(LAS f32x4*)(FT + (3 * 32 + tt) * 64 + j8 + 4 * h2) = kd[h2]; *(LAS f32x4*)(FT + (4 * 32 + tt) * 64 + j8 + 4 * h2) = r8[h2]; *(LAS f32x4*)(FT + (5 * 32 + tt) * 64 + j8 + 4 * h2) = v8[h2]; }
                if ((p & 7) == 0) BON[(size_t)(rbN + tN) * 8 + hd] = bo; }
            __syncthreads();
        }
        __syncthreads();
        { const int cp = 71; RW2_GEOM(cp, ccP, lenP, rbP) (void)lenP;
          if (!isc_ccP || emit_ctx) { const LAS float* YBp = YB0 + (cp & 1) * 2048;
#pragma unroll
              for (int h2 = 0; h2 < 2; ++h2) *(f32x4*)(Y + (size_t)(rbP + ccP * RW_CH + tt) * 512 + hd * 64 + j8 + 4 * h2) = *(const LAS f32x4*)(YBp + tt * 64 + j8 + 4 * h2); } }
#undef RW2_LOADRAW
    }
#undef RW2_GEOM
    __syncthreads();
}

constexpr int R3_Z = 0, R3_X1 = 17408, R3_YB = 34816, R3_NT = 43008;
constexpr int R3_B = 49152, R3_XW = 17408, R3_XA = 17408 + 8704, R3_KR = R3_B, R3_BD = R3_B + 9216, R3_BDT = R3_B + 18432, R3_GL = R3_B + 27648, R3_PT = R3_B + 35840;
constexpr int R3_C = R3_B + 36864, R3_S16 = R3_C, R3_SF = R3_C + 9216, R3_PW = R3_SF, R3_PA = R3_SF + 8192, R3_VT = R3_C + 25600, R3_U = R3_C + 34816, R3_UV = R3_C + 44032, R3_RHS = R3_C + 53248;
constexpr int R3_LS = 72  , R3_FS = 68  , R3_VS = 36  ;
__device__ __forceinline__ void split8(const f32x4 a, const f32x4 b, bf16x8& hi, bf16x8& lo) {
    u32x4 h, l;
    h.x = cvt_pk_bf16(a[0], a[1]); h.y = cvt_pk_bf16(a[2], a[3]); h.z = cvt_pk_bf16(b[0], b[1]); h.w = cvt_pk_bf16(b[2], b[3]);
    l.x = cvt_pk_bf16(a[0] - bflo(h.x), a[1] - bfhi(h.x)); l.y = cvt_pk_bf16(a[2] - bflo(h.y), a[3] - bfhi(h.y));
    l.z = cvt_pk_bf16(b[0] - bflo(h.z), b[1] - bfhi(h.z)); l.w = cvt_pk_bf16(b[2] - bflo(h.w), b[3] - bfhi(h.w));
    hi = __builtin_bit_cast(bf16x8, h); lo = __builtin_bit_cast(bf16x8, l);
}
template <int B> __device__ __forceinline__ void solve_block4(f32x4& ra, f32x4& rb, f32x4& ua, f32x4& ub, const LAS float* zp, int q, f32x4 (&na)[4], f32x4 (&nb)[4]) {
    f32x4 ma[4], mb[4];
    if (B < 7) {
#pragma unroll
        for (int e = 0; e < 4; ++e) { ma[e] = *(const LAS f32x4*)(zp + (4 * B + 4 + e) * R3_FS); mb[e] = *(const LAS f32x4*)(zp + (4 * B + 4 + e) * R3_FS + 4); } }
    const f32x4 rr = (B & 1) ? rb : ra;
    const f32x4 m0 = (B & 1) ? nb[0] : na[0], m1 = (B & 1) ? nb[1] : na[1], m2 = (B & 1) ? nb[2] : na[2];
    const float u0 = rr[0], u1 = rr[1] - u0 * m0[1], u2 = rr[2] - (u0 * m0[2] + u1 * m1[2]), u3 = rr[3] - ((u0 * m0[3] + u1 * m1[3]) + u2 * m2[3]);
    if (q == (B >> 1)) { if (B & 1) ub = (f32x4){u0, u1, u2, u3}; else ua = (f32x4){u0, u1, u2, u3}; }
    if (B < 7) {
        constexpr int o = B >> 1, ctrl = o | (o << 2) | (o << 4) | (o << 6);
        const float b0 = dppf<ctrl>(u0), b1 = dppf<ctrl>(u1), b2 = dppf<ctrl>(u2), b3 = dppf<ctrl>(u3);
        ra -= (b0 * na[0] + b1 * na[1]) + (b2 * na[2] + b3 * na[3]);
        rb -= (b0 * nb[0] + b1 * nb[1]) + (b2 * nb[2] + b3 * nb[3]);
#pragma unroll
        for (int e = 0; e < 4; ++e) { na[e] = ma[e]; nb[e] = mb[e]; } }
}
__device__ __forceinline__ void rwkv_scan_unit3(Frame& F, int l, int b, int hd, int z, bool emit_ctx) {
    const int tid0 = F.tid, lane0 = F.lane, wave = F.wave;
    LAS unsigned char* L = F.lds;
    LAS float* FEAT = (LAS float*)(L + 0); LAS float* XW = (LAS float*)(L + R3_XW); LAS float* XA = (LAS float*)(L + R3_XA); LAS float* PW = (LAS float*)(L + R3_PW); LAS float* PA = (LAS float*)(L + R3_PA);
    LAS float* Zm = (LAS float*)(L + R3_Z); LAS float* X1 = (LAS float*)(L + R3_X1); LAS float* YB = (LAS float*)(L + R3_YB); LAS float* NT = (LAS float*)(L + R3_NT); LAS float* WT = (LAS float*)(L + R3_NT + 4096);
    LAS bf16_t* KR = (LAS bf16_t*)(L + R3_KR); LAS bf16_t* BD = (LAS bf16_t*)(L + R3_BD); LAS bf16_t* BDT = (LAS bf16_t*)(L + R3_BDT); LAS float* GL = (LAS float*)(L + R3_GL); LAS float* PT = (LAS float*)(L + R3_PT);
    LAS bf16_t* S16 = (LAS bf16_t*)(L + R3_S16); LAS float* SF = (LAS float*)(L + R3_SF); LAS bf16_t* UVL = (LAS bf16_t*)(L + R3_VT); LAS bf16_t* ZT2 = (LAS bf16_t*)(L + R3_U)  ; LAS bf16_t* ZTD = (LAS bf16_t*)(L + R3_Z + 8704)  ; LAS bf16_t* UV = (LAS bf16_t*)(L + R3_UV); LAS float* RHS = (LAS float*)(L + R3_RHS);
    const bf16_t* PRW = (const bf16_t*)(F.ws + R_PRW); float* Y = (float*)(F.ws + R_YFB) + (size_t)z * ROWS * 512; float* BON = (float*)(F.ws + WS_BONUS) + (size_t)z * ROWS * 8;
    const float* mu = F.inp(I_RWMU) + (size_t)l * 2 * RW_COLS; const float* mu0 = mu, *mu1 = mu + RW_COLS;
    const float* w0 = F.inp(I_RWW0) + ((size_t)l * 2 + z) * 512 + hd * 64; const float* a0 = F.inp(I_RWA0) + ((size_t)l * 2 + z) * 512 + hd * 64;
    const float* w2 = F.inp(I_RWW2) + ((size_t)l * 2 + z) * 64 * 512; const float* a2 = F.inp(I_RWA2) + ((size_t)l * 2 + z) * 64 * 512;
    const float* k_k = F.inp(I_RWKK) + l * 512 + hd * 64; const float* k_a = F.inp(I_RWKA) + l * 512 + hd * 64; const float* r_k = F.inp(I_RWRK) + l * 512 + hd * 64;
    f32x4 shr[8];
    if (wave >= 4) {
#pragma unroll
      for (int n = 0; n < 2; ++n) { const float* src = (wave < 6 ? w2 : a2) + hd * 64 + 32 * (wave & 1) + 16 * n + (lane0 & 15) + (size_t)(8 * (lane0 >> 4)) * 512;
#pragma unroll
        for (int ks = 0; ks < 2; ++ks) { f32x4 wa, wb;
#pragma unroll
          for (int j = 0; j < 4; ++j) { wa[j] = src[0]; src += 512; asm volatile("" : "+v"(src)); }
#pragma unroll
          for (int j = 0; j < 4; ++j) { wb[j] = src[0]; src += 512; asm volatile("" : "+v"(src)); }
          bf16x8 th, tl; split8(wa, wb, th, tl); shr[2 * n + ks] = __builtin_bit_cast(f32x4, th); shr[4 + 2 * n + ks] = __builtin_bit_cast(f32x4, tl); src += 24 * 512; } } }
    LAS float* CT = (LAS float*)(L + R3_C + 62464);
    LAS float* MT = CT + 384;
    { const int tid = tid0;
      for (int i = tid; i < 640; i += 512) { const int m = i / 320, g = (i % 320) >> 6, j = i & 63; const int col = (g < 3 ? g * 512 + hd * 64 : (g == 3 ? 1536 : 1600)) + j; MT[i] = mu[(size_t)m * RW_COLS + col]; }
      if (tid < 64) { CT[tid] = w0[tid]; CT[64 + tid] = a0[tid]; CT[128 + tid] = k_k[tid]; CT[192 + tid] = k_a[tid]; CT[256 + tid] = r_k[tid]; }
    for (int i = tid; i < 64 * R3_LS / 2; i += 512) ((LAS unsigned*)S16)[i] = 0u; }
    if (wave < 4) {
#pragma unroll
      for (int nt = 0; nt < 4; ++nt) shr[nt] = (f32x4){0.f, 0.f, 0.f, 0.f}; }
    u32x2 raw[5][3];
#define RW3_GEOM(ci_) const bool isc_ = (ci_) < 8; const int cc_ = isc_ ? (z ? 7 - (ci_) : (ci_)) : (z ? 63 - ((ci_) - 8) : ((ci_) - 8)); \
        const int len_ = isc_ ? T_CTX : T_LAT; const int rb_ = b * T_ALL + (isc_ ? 0 : T_CTX); const int t_ = cc_ * RW_CH + tt;
#define RW3_LOADRAW(ci_) do { RW3_GEOM(ci_) const int tp_ = t_ > 0 ? t_ - 1 : t_, tn_ = t_ < len_ - 1 ? t_ + 1 : t_; \
        const bf16_t* pc_ = PRW + (size_t)(rb_ + t_) * RW_COLS; const bf16_t* pp_ = PRW + (size_t)(rb_ + tp_) * RW_COLS; const bf16_t* pn_ = PRW + (size_t)(rb_ + tn_) * RW_COLS; \
        const int cg_[5] = {hd * 64 + j4, 512 + hd * 64 + j4, 1024 + hd * 64 + j4, 1536 + j4, 1600 + j4}; \
        _Pragma("unroll") for (int g_ = 0; g_ < 5; ++g_) { raw[g_][0] = *(const u32x2*)(pp_ + cg_[g_]); raw[g_][1] = *(const u32x2*)(pc_ + cg_[g_]); raw[g_][2] = *(const u32x2*)(pn_ + cg_[g_]); } } while (0)
#define RW3_BAR() asm volatile("s_waitcnt lgkmcnt(0)\n\ts_barrier" ::: "memory")
#define RW3_P1(ci_) do { RW3_GEOM(ci_) const float fp_ = t_ > 0 ? 1.f : 0.f, fn_ = t_ < len_ - 1 ? 1.f : 0.f; f32x4 sh_[5]; \
        _Pragma("unroll") for (int g = 0; g < 5; ++g) { const f32x4 pv = (f32x4){bflo(raw[g][0].x), bfhi(raw[g][0].x), bflo(raw[g][0].y), bfhi(raw[g][0].y)} * fp_; \
            const f32x4 p = (f32x4){bflo(raw[g][1].x), bfhi(raw[g][1].x), bflo(raw[g][1].y), bfhi(raw[g][1].y)}; \
            const f32x4 nx = (f32x4){bflo(raw[g][2].x), bfhi(raw[g][2].x), bflo(raw[g][2].y), bfhi(raw[g][2].y)} * fn_; \
            sh_[g] = p + *(const LAS f32x4*)(MT + g * 64 + j4) * (pv - p) + *(const LAS f32x4*)(MT + 320 + g * 64 + j4) * (nx - p); } \
        *(LAS f32x4*)(XW + tt * 68 + j4) = (f32x4){tanhf_(sh_[3][0]), tanhf_(sh_[3][1]), tanhf_(sh_[3][2]), tanhf_(sh_[3][3])}; *(LAS f32x4*)(XA + tt * 68 + j4) = sh_[4]; \
        r4 = sh_[0]; k4 = sh_[1]; v4 = sh_[2]; } while (0)
#define RW3_P2() do { const LAS float* Xs = (wave < 6) ? XW : XA; LAS float* Ps = (wave < 6) ? PW : PA; \
        _Pragma("unroll") for (int mt = 0; mt < 2; ++mt) { f32x4 acc[2], acc2[2]; \
            _Pragma("unroll") for (int n = 0; n < 2; ++n) { acc[n] = (f32x4){0.f, 0.f, 0.f, 0.f}; acc2[n] = acc[n]; } \
            _Pragma("unroll") for (int ks = 0; ks < 2; ++ks) { const LAS float* xp = Xs + (mt * 16 + (lane & 15)) * 68 + 32 * ks + 8 * (lane >> 4); bf16x8 ah, al; \
                split8(*(const LAS f32x4*)xp, *(const LAS f32x4*)(xp + 4), ah, al); \
                _Pragma("unroll") for (int n = 0; n < 2; ++n) { \
                    const bf16x8 bh_ = __builtin_bit_cast(bf16x8, shr[2 * n + ks]), bl_ = __builtin_bit_cast(bf16x8, shr[4 + 2 * n + ks]); \
                    acc[n] = __builtin_amdgcn_mfma_f32_16x16x32_bf16(ah, bh_, acc[n], 0, 0, 0); \
                    acc2[n] = __builtin_amdgcn_mfma_f32_16x16x32_bf16(ah, bl_, acc2[n], 0, 0, 0); \
                    acc2[n] = __builtin_amdgcn_mfma_f32_16x16x32_bf16(al, bh_, acc2[n], 0, 0, 0); } } \
            _Pragma("unroll") for (int n = 0; n < 2; ++n) { acc[n] += acc2[n]; \
                _Pragma("unroll") for (int rg = 0; rg < 4; ++rg) Ps[(mt * 16 + 4 * (lane >> 4) + rg) * 64 + 32 * (wave & 1) + 16 * n + (lane & 15)] = acc[n][rg]; } } } while (0)
    f32x4 r4, k4, v4;
    { const int tt = tid0 >> 4, j4 = 4 * (tid0 & 15), lane = lane0; RW3_LOADRAW(0); __syncthreads(); RW3_P1(0); RW3_BAR(); if (wave >= 4) RW3_P2(); }
    RW3_BAR();
    for (int ci = 0; ci < 72; ++ci) {
        int tzl = tid0; asm volatile("" : "+v"(tzl));
        const int tid = tzl, lane = tzl & 63, tt = tzl >> 4, jq = tzl & 15, j4 = 4 * jq;
        const bool isc = ci < 8; const int cc = isc ? (z ? 7 - ci : ci) : (z ? 63 - (ci - 8) : (ci - 8));
        const int rb = b * T_ALL + (isc ? 0 : T_CTX); const int t0 = cc * RW_CH; const int t = t0 + tt;
        if (ci + 1 < 72) RW3_LOADRAW(ci + 1);
#ifndef RP_P3A
#define RP_P3A 1
#endif
#ifndef RP_P3B
#define RP_P3B 1
#endif
        { f32x4 ldv, av, kkr, kd, bb, c;
#pragma unroll 1
          for (int rq_ = 0; rq_ < RP_P3A; ++rq_) {
          const f32x4 pw = *(const LAS f32x4*)(PW + tt * 64 + j4) + *(const LAS f32x4*)(CT + j4), pa = *(const LAS f32x4*)(PA + tt * 64 + j4) + *(const LAS f32x4*)(CT + 64 + j4);
          const f32x4 kkc = *(const LAS f32x4*)(CT + 128 + j4), kac = *(const LAS f32x4*)(CT + 192 + j4), rkc = *(const LAS f32x4*)(CT + 256 + j4);
          float ss = 0.f, bo = 0.f;
#pragma unroll
          for (int i = 0; i < 4; ++i) { ldv[i] = -0.8750387749f * sigmoidf_(pw[i]); av[i] = sigmoidf_(pa[i]); kkr[i] = k4[i] * kkc[i]; ss += kkr[i] * kkr[i];
              kd[i] = k4[i] * (1.0f + (av[i] - 1.0f) * kac[i]); bo += r4[i] * kd[i] * rkc[i]; }
          ss = sum16(ss); bo = sum16(bo);
          const float inv = 1.0f / fmaxf(sqrtf(ss), 1e-12f);
#pragma unroll
          for (int i = 0; i < 4; ++i) { kkr[i] *= inv; bb[i] = kkr[i] * av[i]; }
          if (jq == 0) BON[(size_t)(rb + t) * 8 + hd] = bo;
          c = ldv;
          { const int s1 = z ? lane + 16 : lane - 16, s2 = z ? lane + 32 : lane - 32; const bool o1 = z ? lane < 48 : lane >= 16, o2 = z ? lane < 32 : lane >= 32;
            f32x4 t1; t1[0] = __shfl(c[0], s1); t1[1] = __shfl(c[1], s1); t1[2] = __shfl(c[2], s1); t1[3] = __shfl(c[3], s1);
            if (o1) c += t1;
            t1[0] = __shfl(c[0], s2); t1[1] = __shfl(c[1], s2); t1[2] = __shfl(c[2], s2); t1[3] = __shfl(c[3], s2);
            if (o2) c += t1; }
          if (z ? lane < 16 : lane >= 48) *(LAS f32x4*)(WT + wave * 64 + j4) = c;
          }
          RW3_BAR();
#pragma unroll 1
          for (int rq_ = 0; rq_ < RP_P3B; ++rq_) {
          f32x4 base = (f32x4){0.f, 0.f, 0.f, 0.f};
          { f32x4 wt[8];
#pragma unroll
            for (int w2 = 0; w2 < 8; ++w2) wt[w2] = *(const LAS f32x4*)(WT + w2 * 64 + j4);
#pragma unroll
            for (int w2 = 0; w2 < 8; ++w2) { const float mk = (z ? w2 > wave : w2 < wave) ? 1.f : 0.f; base += wt[w2] * mk; } }
          const f32x4 Lc = base + c;
          f32x4 gt, gm, ig;
#pragma unroll
          for (int i = 0; i < 4; ++i) { gt[i] = fast_exp2(Lc[i]); gm[i] = fast_exp2(Lc[i] - ldv[i]); ig[i] = fast_exp2(-Lc[i]); }
          const int tau = z ? 31 - tt : tt;
          const f32x4 kh = kkr * gm, rh = r4 * gt; f32x4 bh = bb * ig, dh = kd * ig, vv = v4;
          u32x2 w; w.x = cvt_pk_bf16(kh[0], kh[1]); w.y = cvt_pk_bf16(kh[2], kh[3]); *(LAS u32x2*)(KR + tau * R3_LS + j4) = w;
          w.x = cvt_pk_bf16(rh[0], rh[1]); w.y = cvt_pk_bf16(rh[2], rh[3]); *(LAS u32x2*)(KR + (32 + tau) * R3_LS + j4) = w;
          w.x = cvt_pk_bf16(bh[0], bh[1]); w.y = cvt_pk_bf16(bh[2], bh[3]); *(LAS u32x2*)(BD + tau * R3_LS + j4) = w;
          w.x = cvt_pk_bf16(dh[0], dh[1]); w.y = cvt_pk_bf16(dh[2], dh[3]); *(LAS u32x2*)(BD + (32 + tau) * R3_LS + j4) = w;
          if (tau == 31) *(LAS f32x4*)(CT + 320 + j4) = gt;
          { const int rot = jq >> 2;
            if (rot & 1) { bh = (f32x4){bh[1], bh[2], bh[3], bh[0]}; dh = (f32x4){dh[1], dh[2], dh[3], dh[0]}; vv = (f32x4){vv[1], vv[2], vv[3], vv[0]}; }
            if (rot & 2) { bh = (f32x4){bh[2], bh[3], bh[0], bh[1]}; dh = (f32x4){dh[2], dh[3], dh[0], dh[1]}; vv = (f32x4){vv[2], vv[3], vv[0], vv[1]}; }
#pragma unroll
            for (int i = 0; i < 4; ++i) { const int row = j4 + ((i + rot) & 3);
                BDT[row * R3_LS + tau] = (bf16_t)f2bf(bh[i]); BDT[row * R3_LS + 32 + tau] = (bf16_t)f2bf(dh[i]);
                const unsigned vh = f2bf(vv[i]); UV[row * R3_LS + 32 + tau] = (bf16_t)vh; UVL[row * R3_LS + 32 + tau] = (bf16_t)f2bf(vv[i] - bflo(vh)); } }
          } }
        RW3_BAR();
        if (ci + 1 < 72) RW3_P1(ci + 1);
        const int c16 = lane & 15, q4 = lane >> 4;
        if (wave < 4) { const int i0 = 16 * wave;
            const bf16x8 a0 = *(const LAS bf16x8*)(S16 + (i0 + c16) * R3_LS + 8 * q4), a1 = *(const LAS bf16x8*)(S16 + (i0 + c16) * R3_LS + 32 + 8 * q4);
#pragma unroll
            for (int nt = 0; nt < 4; ++nt) { shr[4 + nt] = (f32x4){0.f, 0.f, 0.f, 0.f};
                shr[4 + nt] = __builtin_amdgcn_mfma_f32_16x16x32_bf16(a0, *(const LAS bf16x8*)(KR + (16 * nt + c16) * R3_LS + 8 * q4), shr[4 + nt], 0, 0, 0);
                shr[4 + nt] = __builtin_amdgcn_mfma_f32_16x16x32_bf16(a1, *(const LAS bf16x8*)(KR + (16 * nt + c16) * R3_LS + 32 + 8 * q4), shr[4 + nt], 0, 0, 0); }
        } else { const int mt = wave - 4;
            const bf16x8 a0 = *(const LAS bf16x8*)(BD + (16 * mt + c16) * R3_LS + 8 * q4), a1 = *(const LAS bf16x8*)(BD + (16 * mt + c16) * R3_LS + 32 + 8 * q4);
#pragma unroll
            for (int nt = 0; nt < 4; ++nt) { f32x4 az = (f32x4){0.f, 0.f, 0.f, 0.f};
                az = __builtin_amdgcn_mfma_f32_16x16x32_bf16(a0, *(const LAS bf16x8*)(KR + (16 * nt + c16) * R3_LS + 8 * q4), az, 0, 0, 0);
                az = __builtin_amdgcn_mfma_f32_16x16x32_bf16(a1, *(const LAS bf16x8*)(KR + (16 * nt + c16) * R3_LS + 32 + 8 * q4), az, 0, 0, 0);
                if (mt < 2 && nt < 2) {
#pragma unroll
                    for (int rg = 0; rg < 4; ++rg) Zm[(16 * mt + 4 * q4 + rg) * R3_FS + 16 * nt + c16] = az[rg];
                } else {
                    const int s0 = 16 * (mt & 1) + 4 * q4, tc = 16 * (nt & 1) + c16; const int lim = (nt < 2) ? tc - 1 : tc;
                    f32x4 zz;
#pragma unroll
                    for (int rg = 0; rg < 4; ++rg) zz[rg] = (s0 + rg <= lim) ? az[rg] : 0.f;
                    u32x2 h, lo_; h.x = cvt_pk_bf16(zz[0], zz[1]); h.y = cvt_pk_bf16(zz[2], zz[3]);
                    lo_.x = cvt_pk_bf16(zz[0] - bflo(h.x), zz[1] - bfhi(h.x)); lo_.y = cvt_pk_bf16(zz[2] - bflo(h.y), zz[3] - bfhi(h.y));
                    if (nt < 2) { *(LAS u32x2*)(ZTD + tc * 40 + s0) = h; *(LAS u32x2*)(ZTD + 1280 + tc * 40 + s0) = lo_; }
                    else { const int k0 = (mt >= 2 ? 32 : 0) + s0; *(LAS u32x2*)(ZT2 + tc * R3_LS + k0) = h; *(LAS u32x2*)(ZT2 + 2304 + tc * R3_LS + k0) = lo_; } } } }
        RW3_BAR();
#ifndef RP_CH
#define RP_CH 1
#endif
#pragma unroll 1
        for (int rq_ = 0; rq_ < RP_CH; ++rq_)
        if (wave < 4) { const int i0 = 16 * wave;
            { const bf16x8 ah = *(const LAS bf16x8*)(UV + (i0 + c16) * R3_LS + 32 + 8 * q4), al = *(const LAS bf16x8*)(UVL + (i0 + c16) * R3_LS + 32 + 8 * q4);
#pragma unroll
              for (int nt = 0; nt < 2; ++nt) { const bf16x8 bh = *(const LAS bf16x8*)(ZTD + (16 * nt + c16) * 40 + 8 * q4), bl = *(const LAS bf16x8*)(ZTD + 1280 + (16 * nt + c16) * 40 + 8 * q4);
                  f32x4 acc = shr[4 + nt], acc2 = (f32x4){0.f, 0.f, 0.f, 0.f};
                  acc = __builtin_amdgcn_mfma_f32_16x16x32_bf16(ah, bh, acc, 0, 0, 0);
                  acc2 = __builtin_amdgcn_mfma_f32_16x16x32_bf16(ah, bl, acc2, 0, 0, 0);
                  acc2 = __builtin_amdgcn_mfma_f32_16x16x32_bf16(al, bh, acc2, 0, 0, 0);
                  acc += acc2;
#pragma unroll
                  for (int rg = 0; rg < 4; ++rg) RHS[(i0 + 4 * q4 + rg) * R3_VS + 16 * nt + c16] = -acc[rg]; } }
#ifndef RP_SV
#define RP_SV 1
#endif
#pragma unroll 1
            for (int rs_ = 0; rs_ < RP_SV; ++rs_)
            { const int row = i0 + (lane >> 2), q = lane & 3;
              f32x4 ra = *(const LAS f32x4*)(RHS + row * R3_VS + 8 * q), rb = *(const LAS f32x4*)(RHS + row * R3_VS + 8 * q + 4), ua = ra, ub = rb;
              const LAS float* zp = Zm + 8 * q; f32x4 na[4], nb[4];
#pragma unroll
              for (int e = 0; e < 4; ++e) { na[e] = *(const LAS f32x4*)(zp + e * R3_FS); nb[e] = *(const LAS f32x4*)(zp + e * R3_FS + 4); }
              solve_block4<0>(ra, rb, ua, ub, zp, q, na, nb); solve_block4<1>(ra, rb, ua, ub, zp, q, na, nb); solve_block4<2>(ra, rb, ua, ub, zp, q, na, nb); solve_block4<3>(ra, rb, ua, ub, zp, q, na, nb);
              solve_block4<4>(ra, rb, ua, ub, zp, q, na, nb); solve_block4<5>(ra, rb, ua, ub, zp, q, na, nb); solve_block4<6>(ra, rb, ua, ub, zp, q, na, nb); solve_block4<7>(ra, rb, ua, ub, zp, q, na, nb);
              bf16x8 uh, ul; split8(ua, ub, uh, ul);
              *(LAS bf16x8*)(UV + row * R3_LS + 8 * q) = uh; *(LAS bf16x8*)(UVL + row * R3_LS + 8 * q) = ul; }
            { const bf16x8 ah0 = *(const LAS bf16x8*)(UV + (i0 + c16) * R3_LS + 8 * q4), ah1 = *(const LAS bf16x8*)(UV + (i0 + c16) * R3_LS + 32 + 8 * q4);
              const bf16x8 al0 = *(const LAS bf16x8*)(UVL + (i0 + c16) * R3_LS + 8 * q4), al1 = *(const LAS bf16x8*)(UVL + (i0 + c16) * R3_LS + 32 + 8 * q4);
#pragma unroll
              for (int nt = 0; nt < 2; ++nt) { f32x4 acc = shr[6 + nt], acc2 = (f32x4){0.f, 0.f, 0.f, 0.f};
                  const LAS bf16_t* zb = ZT2 + (16 * nt + c16) * R3_LS + 8 * q4;
                  const bf16x8 bh0 = *(const LAS bf16x8*)(zb), bh1 = *(const LAS bf16x8*)(zb + 32), bl0 = *(const LAS bf16x8*)(zb + 2304), bl1 = *(const LAS bf16x8*)(zb + 2304 + 32);
                  acc = __builtin_amdgcn_mfma_f32_16x16x32_bf16(ah0, bh0, acc, 0, 0, 0); acc2 = __builtin_amdgcn_mfma_f32_16x16x32_bf16(ah0, bl0, acc2, 0, 0, 0); acc2 = __builtin_amdgcn_mfma_f32_16x16x32_bf16(al0, bh0, acc2, 0, 0, 0);
                  acc = __builtin_amdgcn_mfma_f32_16x16x32_bf16(ah1, bh1, acc, 0, 0, 0); acc2 = __builtin_amdgcn_mfma_f32_16x16x32_bf16(ah1, bl1, acc2, 0, 0, 0); acc2 = __builtin_amdgcn_mfma_f32_16x16x32_bf16(al1, bh1, acc2, 0, 0, 0);
                  acc += acc2;
                  { const int tau = 16 * nt + c16, ts = z ? 31 - tau : tau; *(LAS f32x4*)(YB + ts * 64 + i0 + 4 * q4) = acc; } }
#pragma unroll
              for (int nt = 0; nt < 4; ++nt) { f32x4 ac = (f32x4){0.f, 0.f, 0.f, 0.f};
                  ac = __builtin_amdgcn_mfma_f32_16x16x32_bf16(ah0, *(const LAS bf16x8*)(BDT + (16 * nt + c16) * R3_LS + 8 * q4), ac, 0, 0, 0);
                  ac = __builtin_amdgcn_mfma_f32_16x16x32_bf16(ah1, *(const LAS bf16x8*)(BDT + (16 * nt + c16) * R3_LS + 32 + 8 * q4), ac, 0, 0, 0);
                  const int col = 16 * nt + c16; const float gl = CT[320 + col];
                  const f32x4 sn = (shr[nt] + ac) * gl;
                  if (rq_ == RP_CH - 1) { shr[nt] = sn;
#pragma unroll
                  for (int rg = 0; rg < 4; ++rg) S16[(i0 + 4 * q4 + rg) * R3_LS + col] = (bf16_t)f2bf(sn[rg]); } else asm volatile("" :: "v"(sn)); } } }
        else if (ci + 1 < 72) RW3_P2();
        RW3_BAR();
#ifndef RP_Y
#define RP_Y 1
#endif
#pragma unroll 1
        for (int rq_ = 0; rq_ < RP_Y; ++rq_) {
        if (!isc || emit_ctx) *(f32x4*)(Y + (size_t)(rb + t) * 512 + hd * 64 + j4) = *(const LAS f32x4*)(YB + tt * 64 + j4);
        }
    }
    __syncthreads();
#undef RW3_P1
#undef RW3_P2
#undef RW3_BAR
#undef RW3_GEOM
#undef RW3_LOADRAW
}

constexpr int RO_AS = 136;
__device__ __forceinline__ void phase_rwkv_out(Frame& F, int l, bool with_ctx) {
    const int tid = F.tid, lane = F.lane, hd = F.wave, c16 = lane & 15, rq = lane >> 4;
    const bf16_t* PRW = (const bf16_t*)(F.ws + R_PRW); const float* Yf = (const float*)(F.ws + R_YFB); const float* Yb = Yf + (size_t)ROWS * 512;
    const float* BON0 = (const float*)(F.ws + WS_BONUS); const float* BON1 = BON0 + (size_t)ROWS * 8; bf16_t* Yall = (bf16_t*)F.out;
    const bf16_t* G2T = (const bf16_t*)(F.ws + WS_G2T);
    const float* mu = F.inp(I_RWMU) + (size_t)l * 2 * RW_COLS; const float* mu0 = mu, *mu1 = mu + RW_COLS;
    const float* lng = F.inp(I_RWLNG) + l * 512; const float* lnb = F.inp(I_RWLNB) + l * 512;
    LAS bf16_t* As = (LAS bf16_t*)F.lds;
    bf16x8 bfr[4][4];
#pragma unroll
    for (int nt = 0; nt < 4; ++nt)
#pragma unroll
        for (int ks = 0; ks < 4; ++ks) bfr[nt][ks] = *(const bf16x8*)(G2T + (size_t)(hd * 64 + 16 * nt + c16) * 128 + 32 * ks + 8 * rq);
    const int nunr = with_ctx ? ROWS / 64 : NB * (T_LAT / 64);
    for (int it = F.blk; it < nunr; it += F.G) {
        const int un = with_ctx ? it : (it >> 5) * 36 + 4 + (it & 31);
        const int r0 = un * 64; const int s0 = r0 % T_ALL; const bool isc = s0 < T_CTX;
        const int seq_lo = isc ? 0 : T_CTX, seq_hi = isc ? T_CTX - 1 : T_ALL - 1;
        __syncthreads();
        { const int tk = tid >> 3, cq = tid & 7; const int s = s0 + tk; const bool hp = s > seq_lo, hn = s < seq_hi; const bf16_t* cur = PRW + (size_t)(r0 + tk) * RW_COLS + 1664 + 16 * cq;
#pragma unroll
          for (int q4 = 0; q4 < 4; ++q4) { const f32x4 x = shift4(cur + 4 * q4, hp, hn, mu0 + 1664 + 16 * cq + 4 * q4, mu1 + 1664 + 16 * cq + 4 * q4);
              u32x2 w; w.x = cvt_pk_bf16(sigmoidf_(x[0]), sigmoidf_(x[1])); w.y = cvt_pk_bf16(sigmoidf_(x[2]), sigmoidf_(x[3])); *(LAS u32x2*)(As + tk * RO_AS + 16 * cq + 4 * q4) = w; } }
        __syncthreads();
        f32x4 acc[4][4];
#pragma unroll
        for (int mt = 0; mt < 4; ++mt)
#pragma unroll
            for (int nt = 0; nt < 4; ++nt) acc[mt][nt] = (f32x4){0.f, 0.f, 0.f, 0.f};
#pragma unroll
        for (int mt = 0; mt < 4; ++mt)
#pragma unroll
            for (int ks = 0; ks < 4; ++ks) { const bf16x8 a = *(const LAS bf16x8*)(As + (mt * 16 + c16) * RO_AS + 32 * ks + 8 * rq);
#pragma unroll
                for (int nt = 0; nt < 4; ++nt) acc[mt][nt] = __builtin_amdgcn_mfma_f32_16x16x32_bf16(bfr[nt][ks], a, acc[mt][nt], 0, 0, 0); }
#pragma unroll
        for (int mt = 0; mt < 4; ++mt) { const int tk = mt * 16 + c16; const int row = r0 + tk, s = s0 + tk; const float fp = s > seq_lo ? 1.f : 0.f, fn = s < seq_hi ? 1.f : 0.f;
            const int rp = s > seq_lo ? row - 1 : row, rn = s < seq_hi ? row + 1 : row;
            f32x4 y[4]; float sm = 0.f;
#pragma unroll
            for (int nt = 0; nt < 4; ++nt) { const size_t o = (size_t)row * 512 + hd * 64 + 16 * nt + 4 * rq; y[nt] = *(const f32x4*)(Yf + o) + *(const f32x4*)(Yb + o); sm += (y[nt][0] + y[nt][1]) + (y[nt][2] + y[nt][3]); }
            sm += __shfl_xor(sm, 16); sm += __shfl_xor(sm, 32);
            const float mean = sm * (1.0f / 64.0f); float q = 0.f;
#pragma unroll
            for (int nt = 0; nt < 4; ++nt) { y[nt] = y[nt] - mean; q += (y[nt][0] * y[nt][0] + y[nt][1] * y[nt][1]) + (y[nt][2] * y[nt][2] + y[nt][3] * y[nt][3]); }
            q += __shfl_xor(q, 16); q += __shfl_xor(q, 32);
            const float rstd = 1.0f / sqrtf(q * (1.0f / 64.0f) + RW_GN_EPS);
            const float bonus = 0.5f * (BON0[(size_t)row * 8 + hd] + BON1[(size_t)row * 8 + hd]);
#pragma unroll
            for (int nt = 0; nt < 4; ++nt) { const int ch = hd * 64 + 16 * nt + 4 * rq;
                const f32x4 p = ld_bf4(PRW + (size_t)row * RW_COLS + 1024 + ch), pv = ld_bf4(PRW + (size_t)rp * RW_COLS + 1024 + ch) * fp, nx = ld_bf4(PRW + (size_t)rn * RW_COLS + 1024 + ch) * fn;
                const f32x4 v = p + *(const f32x4*)(mu0 + 1024 + ch) * (pv - p) + *(const f32x4*)(mu1 + 1024 + ch) * (nx - p);
                const f32x4 o4 = (y[nt] * rstd * *(const f32x4*)(lng + ch) + *(const f32x4*)(lnb + ch) + bonus * v) * acc[mt][nt];
                u32x2 w; w.x = cvt_pk_bf16(o4[0], o4[1]); w.y = cvt_pk_bf16(o4[2], o4[3]); *(u32x2*)(Yall + (size_t)row * MIXW + 512 + ch) = w; } }
    }
    __syncthreads();
}

constexpr int SGL_VNT = 0, SGL_WS = 34816, SGL_ST = 69632, SG_LS = 136;
__device__ __forceinline__ void phase_sg(Frame& F, int l, bool with_ctx) {
    const int tid = F.tid, lane = F.lane, wave = F.wave, r32 = lane & 31, hi = lane >> 5;
    const bf16_t* SG = (const bf16_t*)(F.ws + R_SG); bf16_t* Yall = (bf16_t*)F.out;
    const float* ng = F.inp(I_SGNG) + l * 512; const float* nb = F.inp(I_SGNB) + l * 512; const float* sw = F.inp(I_SGW) + (size_t)l * 4 * 128 * 128; const float* sb = F.inp(I_SGB) + l * 4 * 128;
    LAS bf16_t* VNT = (LAS bf16_t*)(F.lds + SGL_VNT); LAS bf16_t* WSm = (LAS bf16_t*)(F.lds + SGL_WS); LAS float* ST = (LAS float*)(F.lds + SGL_ST);
    const int nun4 = with_ctx ? 4 * (ROWS / 128) : 4 * NB * (T_LAT / 128);
    for (int it4 = with_ctx ? (F.blk + (F.G >> 1)) % F.G : F.blk; it4 < nun4; it4 += F.G) {
        const int un4 = with_ctx ? it4 : ((((it4 >> 2) >> 4) * 18 + 2 + ((it4 >> 2) & 15)) << 2) + (it4 & 3);
        const int un = un4 >> 2; const int row0 = un * 128;
        __syncthreads();
        { u32x4 w[16];
#pragma unroll
          for (int i = 0; i < 16; ++i) w[i] = *(const u32x4*)(SG + (size_t)(row0 + wave * 16 + i) * 1024 + 512 + 8 * lane);
          float v16[16];
          { float a[16], b2[16];
#pragma unroll
            for (int i = 0; i < 16; ++i) { const float x[8] = {bflo(w[i].x), bfhi(w[i].x), bflo(w[i].y), bfhi(w[i].y), bflo(w[i].z), bfhi(w[i].z), bflo(w[i].w), bfhi(w[i].w)}; float s1 = 0.f, s2 = 0.f;
#pragma unroll
                for (int e = 0; e < 8; ++e) { s1 += x[e]; s2 += x[e] * x[e]; }
                a[i] = s1; b2[i] = s2; }
            const bool h5 = (lane & 32) != 0;
#pragma unroll
            for (int j2 = 0; j2 < 16; ++j2) { const float send = h5 ? a[j2] : b2[j2], keep = h5 ? b2[j2] : a[j2]; v16[j2] = keep + __shfl_xor(send, 32); } }
          float v8[8], v4[4], v2[2], v1;
          { const bool h = (lane & 16) != 0;
#pragma unroll
            for (int j2 = 0; j2 < 8; ++j2) { const float send = h ? v16[j2] : v16[8 + j2], keep = h ? v16[8 + j2] : v16[j2]; v8[j2] = keep + __shfl_xor(send, 16); } }
          { const bool h = (lane & 8) != 0;
#pragma unroll
            for (int j2 = 0; j2 < 4; ++j2) { const float send = h ? v8[j2] : v8[4 + j2], keep = h ? v8[4 + j2] : v8[j2]; v4[j2] = keep + __shfl_xor(send, 8); } }
          { const bool h = (lane & 4) != 0;
#pragma unroll
            for (int j2 = 0; j2 < 2; ++j2) { const float send = h ? v4[j2] : v4[2 + j2], keep = h ? v4[2 + j2] : v4[j2]; v2[j2] = keep + __shfl_xor(send, 4); } }
          { const bool h = (lane & 2) != 0; const float send = h ? v2[0] : v2[1], keep = h ? v2[1] : v2[0]; v1 = keep + __shfl_xor(send, 2); }
          v1 += __shfl_xor(v1, 1);
          const float other = __shfl_xor(v1, 32);
          if (lane < 32 && (lane & 1) == 0) { const int q = wave * 16 + (lane >> 1); const float mean = v1 * (1.0f / 512.0f); const float var = fmaxf(other * (1.0f / 512.0f) - mean * mean, 0.f);
              ST[2 * q] = mean; ST[2 * q + 1] = 1.0f / sqrtf(var + LN_EPS); } }
        __syncthreads();
        { const int g = un4 & 3;
            u32x2 ur0[4], ur1[4];
            { const size_t row = (size_t)row0 + 32 * (wave >> 1) + r32;
#pragma unroll
              for (int g4 = 0; g4 < 4; ++g4) { const int ch0 = g * 128 + 32 * ((wave & 1) * 2) + 8 * g4 + 4 * hi; ur0[g4] = *(const u32x2*)(SG + row * 1024 + ch0); ur1[g4] = *(const u32x2*)(SG + row * 1024 + ch0 + 32); } }
            { const int p = tid >> 2, c0 = 32 * (tid & 3); const float* wp = sw + ((size_t)g * 128 + p) * 128 + c0;
#pragma unroll
              for (int i = 0; i < 4; ++i) { const f32x4 a = *(const f32x4*)(wp + 8 * i), c = *(const f32x4*)(wp + 8 * i + 4);
                  *(LAS u32x4*)(WSm + p * SG_LS + c0 + 8 * i) = (u32x4){cvt_pk_bf16(a[0], a[1]), cvt_pk_bf16(a[2], a[3]), cvt_pk_bf16(c[0], c[1]), cvt_pk_bf16(c[2], c[3])}; } }
            { const int q = tid & 127, cb = 32 * (tid >> 7); const float mean = ST[2 * q], rstd = ST[2 * q + 1]; const bf16_t* vp = SG + (size_t)(row0 + q) * 1024 + 512 + g * 128 + cb;
#pragma unroll
              for (int i = 0; i < 4; ++i) { const u32x4 w = *(const u32x4*)(vp + 8 * i); const float x[8] = {bflo(w.x), bfhi(w.x), bflo(w.y), bfhi(w.y), bflo(w.z), bfhi(w.z), bflo(w.w), bfhi(w.w)};
#pragma unroll
                  for (int e = 0; e < 8; ++e) { const int c = cb + 8 * i + e; VNT[c * SG_LS + q] = (bf16_t)f2bf((x[e] - mean) * rstd * ng[g * 128 + c] + nb[g * 128 + c]); } } }
            __syncthreads();
            const int pt = wave >> 1, ct0 = (wave & 1) * 2;
            f32x16 acc0, acc1;
#pragma unroll
            for (int r = 0; r < 16; ++r) { acc0[r] = 0.f; acc1[r] = 0.f; }
#pragma unroll
            for (int ks = 0; ks < 8; ++ks) { const bf16x8 a = *(const LAS bf16x8*)(WSm + (32 * pt + r32) * SG_LS + 16 * ks + 8 * hi);
                const bf16x8 b0 = *(const LAS bf16x8*)(VNT + (32 * ct0 + r32) * SG_LS + 16 * ks + 8 * hi), b1 = *(const LAS bf16x8*)(VNT + (32 * (ct0 + 1) + r32) * SG_LS + 16 * ks + 8 * hi);
                acc0 = __builtin_amdgcn_mfma_f32_32x32x16_bf16(b0, a, acc0, 0, 0, 0); acc1 = __builtin_amdgcn_mfma_f32_32x32x16_bf16(b1, a, acc1, 0, 0, 0); }
            { const int p = 32 * pt + r32; const size_t row = (size_t)row0 + p; const float bs = sb[g * 128 + p];
#pragma unroll
              for (int g4 = 0; g4 < 4; ++g4) { const int ch0 = g * 128 + 32 * ct0 + 8 * g4 + 4 * hi, ch1 = ch0 + 32;
                  const f32x4 u0 = (f32x4){bflo(ur0[g4].x), bfhi(ur0[g4].x), bflo(ur0[g4].y), bfhi(ur0[g4].y)}, u1 = (f32x4){bflo(ur1[g4].x), bfhi(ur1[g4].x), bflo(ur1[g4].y), bfhi(ur1[g4].y)};
                  const f32x4 o0 = u0 * ((f32x4){acc0[4 * g4], acc0[4 * g4 + 1], acc0[4 * g4 + 2], acc0[4 * g4 + 3]} + bs), o1 = u1 * ((f32x4){acc1[4 * g4], acc1[4 * g4 + 1], acc1[4 * g4 + 2], acc1[4 * g4 + 3]} + bs);
                  u32x2 w; w.x = cvt_pk_bf16(o0[0], o0[1]); w.y = cvt_pk_bf16(o0[2], o0[3]); *(u32x2*)(Yall + row * MIXW + 1024 + ch0) = w;
                  w.x = cvt_pk_bf16(o1[0], o1[1]); w.y = cvt_pk_bf16(o1[2], o1[3]); *(u32x2*)(Yall + row * MIXW + 1024 + ch1) = w; } }
            __syncthreads();
        }
    }
}

#ifdef PROBE_CHECKS
__device__ __forceinline__ float tshift(const bf16_t* PRW, int row, int col, bool hp, bool hn, const float* mu0, const float* mu1) {
    const float p = bf2f(PRW[(size_t)row * RW_COLS + col]), pv = hp ? bf2f(PRW[(size_t)(row - 1) * RW_COLS + col]) : 0.f, nx = hn ? bf2f(PRW[(size_t)(row + 1) * RW_COLS + col]) : 0.f;
    return p + mu0[col] * (pv - p) + mu1[col] * (nx - p);
}
__device__ __forceinline__ bool mism(float fast, float ref) { return !(fabsf(fast - ref) <= 0.03f * fabsf(ref) + 0.03f); }
__device__ __forceinline__ void probe_checks(Frame& F, int l, int stage) {
    float* flags = (float*)(F.ws + WS_CTL + 32768);
    const bf16_t* Yall = (const bf16_t*)F.out; const int lane = F.lane;
    if (F.blk >= 24) return;
    const int kind = F.blk >> 3, si = (F.blk & 7) * 8 + F.wave;
    if ((stage == 0) == (kind == 1)) return;
    const int b = si & 15, srow = (si * 37 + 11) % T_ALL;
    const int row = b * T_ALL + srow; const bool isc = srow < T_CTX;
    const int seq_lo = isc ? 0 : T_CTX, seq_hi = isc ? T_CTX - 1 : T_ALL - 1; const bool hp = srow > seq_lo, hn = srow < seq_hi;
    if (kind == 0) {
        const bf16_t* SG = (const bf16_t*)(F.ws + R_SG); const int ch = (si * 53 + 7) & 511, g = ch >> 7, c = ch & 127; const int row0 = row & ~127, p = row & 127;
        const float* ng = F.inp(I_SGNG) + l * 512; const float* nb = F.inp(I_SGNB) + l * 512; const float* sw = F.inp(I_SGW) + (size_t)l * 4 * 128 * 128; const float* sb = F.inp(I_SGB) + l * 4 * 128;
        float vm = 0.f;
        for (int q = 0; q < 128; ++q) { float s = 0.f, x[8];
            for (int e = 0; e < 8; ++e) { x[e] = bf2f(SG[(size_t)(row0 + q) * 1024 + 512 + lane * 8 + e]); s += x[e]; }
            const float mean = wave_sum(s) * (1.0f / 512.0f); float qq = 0.f;
            for (int e = 0; e < 8; ++e) qq += (x[e] - mean) * (x[e] - mean);
            const float rstd = 1.0f / sqrtf(wave_sum(qq) * (1.0f / 512.0f) + LN_EPS);
            const float vn = (bf2f(SG[(size_t)(row0 + q) * 1024 + 512 + ch]) - mean) * rstd * ng[ch] + nb[ch];
            vm += sw[((size_t)g * 128 + p) * 128 + q] * vn; }
        const float ref = bf2f(SG[(size_t)row * 1024 + ch]) * (vm + sb[g * 128 + p]);
        const float fast = bf2f(Yall[(size_t)row * MIXW + 1024 + ch]);
        (void)fast; (void)ref;
    } else if (kind == 1) {
        const bf16_t* PRW = (const bf16_t*)(F.ws + R_PRW); const float* Yf = (const float*)(F.ws + R_YFB); const float* Yb = Yf + (size_t)ROWS * 512;
        const float* B0 = (const float*)(F.ws + WS_BONUS); const float* B1 = B0 + (size_t)ROWS * 8;
        const float* mu = F.inp(I_RWMU) + (size_t)l * 2 * RW_COLS; const float* mu0 = mu, *mu1 = mu + RW_COLS;
        const float* g2 = F.inp(I_RWG2) + (size_t)l * 128 * 512; const float* lng = F.inp(I_RWLNG) + l * 512; const float* lnb = F.inp(I_RWLNB) + l * 512;
        const int hd = si & 7, ch = hd * 64 + lane;
        const float y = Yf[(size_t)row * 512 + ch] + Yb[(size_t)row * 512 + ch];
        const float mean = wave_sum(y) * (1.0f / 64.0f); const float var = wave_sum((y - mean) * (y - mean)) * (1.0f / 64.0f);
        const float gn = (y - mean) / sqrtf(var + RW_GN_EPS) * lng[ch] + lnb[ch];
        const float v = tshift(PRW, row, 1024 + ch, hp, hn, mu0, mu1);
        const float bonus = 0.5f * (B0[(size_t)row * 8 + hd] + B1[(size_t)row * 8 + hd]);
        float gg = 0.f;
        for (int r = 0; r < 128; ++r) { const float xg = tshift(PRW, row, 1664 + r, hp, hn, mu0, mu1); gg += (1.0f / (1.0f + expf(-xg))) * g2[(size_t)r * 512 + ch]; }
        const float ref = (gn + bonus * v) * gg, fast = bf2f(Yall[(size_t)row * MIXW + 512 + ch]);
        (void)fast; (void)ref;
    } else if (!isc || l == 0) {
        const bf16_t* Qb = (const bf16_t*)(F.ws + R_Q); const bf16_t* Kb = (const bf16_t*)(F.ws + R_K); const bf16_t* Vt = (const bf16_t*)(F.ws + R_VT);
        const float* sc = (const float*)(F.ws + WS_SMALL + 16384); const float lam = sc[2 * l], lam_init = sc[2 * l + 1]; const float* ng = F.inp(I_DANG) + l * 128;
        const int h = si & 3, nkeys = isc ? T_CTX : T_ALL; const int krow0 = b * T_ALL;
        float o0 = 0.f, o1 = 0.f;
        for (int m = 0; m < 2; ++m) {
            float mx = -3.0e38f;
            for (int k = lane; k < nkeys; k += 64) { float s = 0.f; for (int d = 0; d < 64; ++d) s += bf2f(Qb[(size_t)row * 512 + h * 128 + m * 64 + d]) * bf2f(Kb[(size_t)(krow0 + k) * 512 + h * 128 + m * 64 + d]); mx = fmaxf(mx, s); }
            mx = wave_max(mx); float den = 0.f;
            for (int k = lane; k < nkeys; k += 64) { float s = 0.f; for (int d = 0; d < 64; ++d) s += bf2f(Qb[(size_t)row * 512 + h * 128 + m * 64 + d]) * bf2f(Kb[(size_t)(krow0 + k) * 512 + h * 128 + m * 64 + d]); den += exp2f(s - mx); }
            den = wave_sum(den);
            float a0 = 0.f, a1 = 0.f;
            for (int k = 0; k < nkeys; ++k) { float s = 0.f; for (int d = 0; d < 64; ++d) s += bf2f(Qb[(size_t)row * 512 + h * 128 + m * 64 + d]) * bf2f(Kb[(size_t)(krow0 + k) * 512 + h * 128 + m * 64 + d]);
                const float pk = exp2f(s - mx) / den; const int slot = (k & ~15) + perm16(k & 15);
                a0 += pk * bf2f(Vt[((size_t)(b * 4 + h) * 128 + lane) * T_ALL + slot]); a1 += pk * bf2f(Vt[((size_t)(b * 4 + h) * 128 + lane + 64) * T_ALL + slot]); }
            if (m == 0) { o0 = a0; o1 = a1; } else { o0 -= PROBE_LAM(lam) * a0; o1 -= PROBE_LAM(lam) * a1; }
        }
        const float ss = wave_sum(o0 * o0 + o1 * o1) * (1.0f / 128.0f); const float scl = (1.0f / sqrtf(ss + DA_EPS)) * (1.0f - lam_init);
#ifdef PROBE_O1ONLY
        const float r0 = o0 * 16.0f * ng[lane], r1 = o1 * 16.0f * ng[lane + 64];
#else
        const float r0 = o0 * scl * ng[lane], r1 = o1 * scl * ng[lane + 64];
#endif
        const float f0 = bf2f(Yall[(size_t)row * MIXW + h * 128 + lane]), f1 = bf2f(Yall[(size_t)row * MIXW + h * 128 + lane + 64]);
        const float dv = wave_max(fmaxf(fabsf(f0 - r0), fabsf(f1 - r1)));
        if (lane == 0) atomicMax((unsigned*)flags + (isc ? 1 : 0), __builtin_bit_cast(unsigned, dv));
    }
}
#endif

#ifndef MK_PER_PHASE
#define MK_PER_PHASE 0
#endif
constexpr int N_PHASES = 3 + 10 * DEPTH;
struct Args { const float* in[34]; float* out; unsigned char* ws; int ph_lo, ph_hi; };
__global__ void __launch_bounds__(512, 2) trunk_fwd(Args args) {
    extern __shared__ __attribute__((aligned(16))) unsigned char lds_raw[];
    Frame F;
    F.lds = (LAS unsigned char*)lds_raw;
    F.tid = threadIdx.x; F.lane = F.tid & 63; F.wave = __builtin_amdgcn_readfirstlane(F.tid >> 6); F.G = gridDim.x; F.blk = blockIdx.x;
    F.out = args.out; F.ws = args.ws;
    volatile LAS unsigned* misc = (volatile LAS unsigned*)(F.lds + LDS_MISC);
    if (F.tid < 16) misc[F.tid] = 0u;
    if (F.tid == 0) {
#pragma unroll
        for (int i = 0; i < 34; ++i) *(LAS unsigned long long*)(F.lds + LDS_MISC + 64 + 8 * i) = (unsigned long long)args.in[i];
    }
    __syncthreads();
    XcdBarrier bar; bar.bar = (unsigned*)(F.ws + WS_CTL); bar.x = 0; bar.st = misc;
    if (!MK_PER_PHASE) bar = xcd_barrier_post((unsigned*)(F.ws + WS_CTL), misc);
    const int lo = args.ph_lo, hi = args.ph_hi;
#ifndef PHM
#define PHM 0xFFFFFFFFu
#endif
#define PHB(n) ((PHM >> (n)) & 1u)
#ifndef REPMASK
#define REPMASK 0u
#endif
#define NREP(n) ((int)((REPMASK >> (n)) & 1u) + 1)
#define IN(k) (lo <= (k) && (k) < hi)
#define SEAM(k) do { if (!MK_PER_PHASE && IN((k) + 1)) xcd_barrier(bar); } while (0)
    const int NGW = F.G * 8;

    if (PHB(0) && IN(0)) { for (int rep = 0; rep < NREP(0); ++rep) { relaunder(F); mod_partials(F); relaunder(F); small_tables(F); relaunder(F); convert_weights(F, 0, F.blk * 8 + F.wave, NGW); } SEAM(0); }
    if (PHB(1) && IN(1)) { relaunder(F); mod_reduce(F); SEAM(1); }
    if (PHB(2) && IN(2)) { relaunder(F); phase_h0(F); SEAM(2); }

#pragma unroll 1
    for (int l = 0; l < DEPTH; ++l) {
        const int pb = 3 + 10 * l; const bool first = (l == 0), last = (l == DEPTH - 1); const bool with_ctx = !last;
        if (PHB(3) && IN(pb + 0)) { relaunder(F);
#pragma unroll 1
            for (int rep = 0; rep < NREP(3); ++rep) {
            pg8::Gemm g{(const bf16_t*)(F.ws + WS_H), (const bf16_t*)(F.ws + WS_WIN), DM, DM, DM};
            InProjSched S; if (with_ctx) S.init(F.G, F.blk, 0, 0, 17, 0, 0, 0); else S.init(F.G, F.blk, 1, 0, 17, 2, 2, 11);
            S.init2((long)((const char*)F.out - (const char*)(F.ws + WS_H)), (long)WS_WLO - (long)WS_WIN);
            EpiInProj E{(bf16_t*)(F.ws + R_Q), (bf16_t*)(F.ws + R_K), (bf16_t*)(F.ws + R_VT), (bf16_t*)(F.ws + R_PRW), (bf16_t*)(F.ws + R_SG), (bf16_t*)(F.ws + R_GATE), (const f32x2*)(F.ws + WS_SMALL), (bf16_t*)(F.ws + R_KLO)};
            pg8::gemm_phase(F.lds, F.tid, g, S, E);
            }
            SEAM(pb + 0);
        }
        if (PHB(4) && IN(pb + 1)) { relaunder(F);
#ifndef RWKV_SCAN
#define RWKV_SCAN rwkv_scan_unit3
#endif
#ifndef REP_SCAN
#define REP_SCAN NREP(21)
#endif
#ifndef REP_ATTN
#define REP_ATTN NREP(22)
#endif
#ifndef REP_SG
#define REP_SG NREP(20)
#endif
#pragma unroll 1
            for (int rep = 0; rep < REP_SCAN; ++rep) for (int un = F.blk; un < 256; un += F.G) RWKV_SCAN(F, l, un >> 4, (un >> 1) & 7, un & 1, with_ctx);
#pragma unroll 1
            for (int rep = 0; rep < REP_ATTN; ++rep) { relaunder(F); phase_attn(F, l, with_ctx); }
#pragma unroll 1
            for (int rep = 0; rep < REP_SG; ++rep) { relaunder(F); phase_sg(F, l, with_ctx); }
            SEAM(pb + 1);
        }
        if (PHB(5) && IN(pb + 2)) { relaunder(F);
#ifdef PROBE_CHECKS
            if (l == 0) { probe_checks(F, l, 0); xcd_barrier(bar); relaunder(F); }
#endif
#pragma unroll 1
            for (int rep = 0; rep < NREP(5); ++rep) {
            phase_rwkv_out(F, l, with_ctx); relaunder(F);
            pg8::Gemm g{(const bf16_t*)(F.ws + WS_H), (const bf16_t*)(F.ws + WS_WIN), DM, DM, DM};
            RectSched S; S.init(F.G, with_ctx ? (F.blk + 3 * (F.G >> 2)) % F.G : F.blk, with_ctx ? 0 : 1, 17, 12, 0, 0, 0);
            EpiInProj E{(bf16_t*)(F.ws + R_Q), (bf16_t*)(F.ws + R_K), (bf16_t*)(F.ws + R_VT), (bf16_t*)(F.ws + R_PRW), (bf16_t*)(F.ws + R_SG), (bf16_t*)(F.ws + R_GATE), (const f32x2*)(F.ws + WS_SMALL), (bf16_t*)(F.ws + R_KLO)};
            pg8::gemm_phase(F.lds, F.tid, g, S, E);
#ifdef PROBE_CHECKS
            if (l == 0) { xcd_barrier(bar); relaunder(F); probe_checks(F, l, 1); }
#endif
            }
            SEAM(pb + 2);
        }
        if (PHB(6) && IN(pb + 3)) { relaunder(F);
#pragma unroll 1
            for (int rep = 0; rep < NREP(6); ++rep) {
            pg8::Gemm g{(const bf16_t*)F.out, (const bf16_t*)(F.ws + WS_WB), MIXW, MIXW, MIXW};
            MergeSched S; S.init(F.G, F.blk, with_ctx ? 0 : 1);
            EpiMerge E{(const bf16_t*)(F.ws + R_GATE), (bf16_t*)(F.ws + R_M)};
            pg8::gemm_phase(F.lds, F.tid, g, S, E);
            }
            SEAM(pb + 3);
        }
        if (PHB(7) && IN(pb + 4)) { relaunder(F);
            pg8::Gemm g{(const bf16_t*)(F.ws + R_M), (const bf16_t*)(F.ws + WS_WOUT), DM, DM, DM};
            RectSched S; S.init(F.G, F.blk, with_ctx ? 0 : 1, 0, 4, 0, 0, 0);
            EpiWout E{F.inp(I_X), F.inp(I_CTX), (float*)(F.ws + WS_X), (const float*)(F.ws + WS_MODF) + (size_t)l * 17 * 6144, first ? 1 : 0};
            pg8::gemm_phase(F.lds, F.tid, g, S, E);
            SEAM(pb + 4);
        }
        if (PHB(8) && IN(pb + 5)) { relaunder(F); phase_ln1(F, l, with_ctx); SEAM(pb + 5); }
        if (PHB(9) && IN(pb + 6)) { for (int rep = 0; rep < NREP(9); ++rep) { relaunder(F); phase_topk(F, with_ctx); } SEAM(pb + 6); }
        if (PHB(10) && IN(pb + 7)) { relaunder(F);
#pragma unroll 1
            for (int rep = 0; rep < NREP(10); ++rep) {
            pg8::Gemm g{(const bf16_t*)(F.ws + R_XE), (const bf16_t*)(F.ws + WS_WE1), DM, DM, DM};
            MoeSched S; S.init(F.G, F.blk, with_ctx ? 18 : 16, 16, 16);
            EpiMoe1 E{(bf16_t*)(F.ws + R_HID)};
            pg8::gemm_phase(F.lds, F.tid, g, S, E);
            }
            SEAM(pb + 7);
        }
        if (PHB(11) && IN(pb + 8)) { relaunder(F);
#pragma unroll 1
            for (int rep = 0; rep < NREP(11); ++rep) {
            pg8::Gemm g{(const bf16_t*)(F.ws + R_HID), (const bf16_t*)(F.ws + WS_WE2), FF, FF, FF};
            MoeSched S; S.init(F.G, F.blk, with_ctx ? 18 : 16, 4, 4);
            EpiMoe2 E{(bf16_t*)(F.ws + R_YE), (const float*)(F.ws + WS_GATEE)};
            pg8::gemm_phase(F.lds, F.tid, g, S, E);
            }
            SEAM(pb + 8);
        }
        if (PHB(12) && IN(pb + 9)) { relaunder(F);
            phase_ln2(F, l, with_ctx, last);
            for (int rep = 0; rep < NREP(12); ++rep) { relaunder(F); if (!last) convert_weights(F, l + 1, F.blk * 8 + F.wave, NGW); }
            SEAM(pb + 9);
        }
    }
#ifdef PROBE_CHECKS
    xcd_barrier(bar);
    if (F.blk == 0 && F.tid == 0) { const float* flags = (const float*)(F.ws + WS_CTL + 32768); F.out[0] += 1000.0f * flags[0]; }
#endif
#undef IN
#undef SEAM
}

extern "C" void kernel_launch(void* const* d_in, const int* in_sizes, int n_in, void* d_out, int out_size, void* d_ws, size_t ws_size, hipStream_t stream) {
    static int grid = 0;
    if (grid == 0) {
        if (n_in != 34 || out_size != NB * T_LAT * DM || ws_size < WS_END) { fprintf(stderr, "kernel_launch: unexpected shapes (n_in %d, out %d, ws %zu, need %zu); nothing launched\n", n_in, out_size, ws_size, (size_t)WS_END); grid = -1; return; }
        int dev = 0, cus = 0, per_cu = 0;
        if (hipGetDevice(&dev) != hipSuccess || hipDeviceGetAttribute(&cus, hipDeviceAttributeMultiprocessorCount, dev) != hipSuccess) { grid = -1; return; }
        if (hipFuncSetAttribute((const void*)trunk_fwd, hipFuncAttributeMaxDynamicSharedMemorySize, LDS_BYTES) != hipSuccess) { fprintf(stderr, "kernel_launch: hipFuncSetAttribute failed\n"); grid = -1; return; }
        if (hipOccupancyMaxActiveBlocksPerMultiprocessor(&per_cu, (const void*)trunk_fwd, 512, LDS_BYTES) != hipSuccess || per_cu < 1) { fprintf(stderr, "kernel_launch: occupancy query reports %d\n", per_cu); }
        (void)hipGetLastError();
        grid = cus;
    }
    if (grid < 0) return;
    (void)hipMemsetAsync((char*)d_ws + WS_CTL, 0, CTL_ZERO_BYTES, stream);
#ifdef DIAG_ZERO_WS
    (void)hipMemsetAsync((char*)d_ws, 0, WS_END, stream);
    (void)hipMemsetAsync((char*)d_ws + WS_MODF, 0xFF, WS_X - WS_MODF, stream);
    (void)hipMemsetAsync((char*)d_ws + WS_WIN, 0xFF, WS_R - WS_WIN, stream);
#endif
    Args a{};
    for (int i = 0; i < 34; ++i) a.in[i] = (const float*)d_in[i];
    a.out = (float*)d_out; a.ws = (unsigned char*)d_ws;
#if MK_PER_PHASE
    for (int p = 0; p < N_PHASES; ++p) { a.ph_lo = p; a.ph_hi = p + 1; hipLaunchKernelGGL(trunk_fwd, dim3(grid), dim3(512), LDS_BYTES, stream, a); }
#else
    a.ph_lo = 0; a.ph_hi = N_PHASES; hipLaunchKernelGGL(trunk_fwd, dim3(grid), dim3(512), LDS_BYTES, stream, a);
#endif
}
```

```cpp
#include <hip/hip_runtime.h>

#ifndef SPLIT_K
#define SPLIT_K 0
#endif
#include <cstdio>
#include <cstdint>
#include <cmath>

#define LAS __attribute__((address_space(3)))
#define GAS __attribute__((address_space(1)))
typedef unsigned short bf16_t;
typedef short bf16x8 __attribute__((ext_vector_type(8)));
typedef float f32x4 __attribute__((ext_vector_type(4)));
typedef float f32x2 __attribute__((ext_vector_type(2)));
typedef float f32x16 __attribute__((ext_vector_type(16)));
typedef unsigned u32x4 __attribute__((ext_vector_type(4)));
typedef unsigned u32x2 __attribute__((ext_vector_type(2)));

constexpr int NB = 16, T_LAT = 2048, T_CTX = 256, T_ALL = 2304, DM = 1024, DEPTH = 2;
constexpr int ROWS = NB * T_ALL;
constexpr int NPM = ROWS / 256;
constexpr int IN_COLS = 7424, RW_COLS = 1792, MIXW = 1536;
constexpr int NEXP = 16, FF = 2048, CAP_L = 256, CAP_C = 32;
constexpr int EROWS = NB * CAP_L + NB * CAP_C;
constexpr float LN_EPS = 1e-5f, DA_EPS = 1e-5f, RW_GN_EPS = 64e-5f;
constexpr float DN_ALPHA = 1.4142135623730951f;
constexpr float QSCALE = 0.125f * 1.4426950408889634f;

constexpr size_t MiB = 1u << 20;
constexpr size_t WS_CTL = 0;
constexpr size_t CTL_ZERO_BYTES = 64 * 1024;
constexpr size_t WS_MODF = 1 * MiB;
constexpr size_t WS_SMALL = 2 * MiB;
constexpr size_t WS_AFF = 3 * MiB;
constexpr size_t WS_SLOT = 6 * MiB;
constexpr size_t WS_GATEE = 8 * MiB;
constexpr size_t WS_BONUS = 9 * MiB;
constexpr size_t WS_X = 16 * MiB;
constexpr size_t WS_H = 160 * MiB;
constexpr size_t WS_WIN = 232 * MiB;
constexpr size_t WS_WB = 247 * MiB;
constexpr size_t WS_WOUT = 250 * MiB;
constexpr size_t WS_G2T = 252 * MiB;
constexpr size_t WS_WLO = 253 * MiB;
constexpr size_t WS_WE1 = 254 * MiB;
constexpr size_t WS_WE2 = 382 * MiB;
constexpr size_t WS_R = 446 * MiB;
constexpr size_t R_Q = WS_R + 0 * MiB;
constexpr size_t R_K = WS_R + 36 * MiB;
constexpr size_t R_VT = WS_R + 72 * MiB;
constexpr size_t R_SG = WS_R + 108 * MiB;
constexpr size_t R_KLO = WS_R + 180 * MiB;
constexpr size_t R_GATE = WS_R + 0 * MiB;
constexpr size_t R_PRW = WS_R + 216 * MiB;
constexpr size_t R_YFB = WS_R + 342 * MiB;
constexpr size_t R_M = WS_R + 216 * MiB;
constexpr size_t R_MACC = WS_R + 342 * MiB;
constexpr size_t R_MODP = WS_R + 0 * MiB;
constexpr size_t R_HID = WS_R + 0 * MiB;
constexpr size_t R_XE = WS_R + 288 * MiB;
constexpr size_t R_YE = WS_R + 288 * MiB;
constexpr size_t WS_END = WS_R + 576 * MiB;

constexpr int LDS_MAIN = 155648;
constexpr int LDS_MISC = LDS_MAIN;
constexpr int LDS_BYTES = LDS_MAIN + 64 + 34 * 8 + 48;

__device__ __forceinline__ unsigned f2bf(float f) { unsigned u = __builtin_bit_cast(unsigned, f); return (u + 0x7fffu + ((u >> 16) & 1u)) >> 16; }
__device__ __forceinline__ unsigned pk2(float lo, float hi) { return f2bf(lo) | (f2bf(hi) << 16); }
typedef __bf16 bf16x2_t __attribute__((ext_vector_type(2)));
__device__ __forceinline__ unsigned cvt_pk_bf16(float lo, float hi) { const f32x2 v = {lo, hi}; const bf16x2_t b = __builtin_convertvector(v, bf16x2_t); return __builtin_bit_cast(unsigned, b); }
__device__ __forceinline__ float bf2f(bf16_t b) { return __builtin_bit_cast(float, ((unsigned)b) << 16); }
__device__ __forceinline__ float bflo(unsigned w) { return __builtin_bit_cast(float, w << 16); }
__device__ __forceinline__ float bfhi(unsigned w) { return __builtin_bit_cast(float, w & 0xffff0000u); }
__device__ __forceinline__ float fast_exp2(float x) { return __builtin_amdgcn_exp2f(x); }
__device__ __forceinline__ float fast_rcp(float x) { return __builtin_amdgcn_rcpf(x); }
__device__ __forceinline__ float sigmoidf_(float x) { return fast_rcp(1.0f + fast_exp2(-1.4426950408889634f * x)); }
__device__ __forceinline__ float siluf_(float x) { return x * sigmoidf_(x); }
__device__ __forceinline__ float gelu_tanh(float x) { const float u = 0.7978845608028654f * (x + 0.044715f * x * x * x); return x * sigmoidf_(2.0f * u); }
__device__ __forceinline__ float tanhf_(float x) { return 2.0f * sigmoidf_(2.0f * x) - 1.0f; }
template <int CTRL> __device__ __forceinline__ float dppf(float v) { return __builtin_bit_cast(float, __builtin_amdgcn_mov_dpp(__builtin_bit_cast(int, v), CTRL, 0xF, 0xF, true)); }
__device__ __forceinline__ float sum16(float v) {
#ifdef PROBE_NAIVE_RW
    v += __shfl_xor(v, 1); v += __shfl_xor(v, 2); v += __shfl_xor(v, 4); v += __shfl_xor(v, 8); return v;
#endif
    v += dppf<0xB1>(v);
    v += dppf<0x4E>(v);
    v += dppf<0x141>(v);
    v += dppf<0x140>(v);
    return v;
}
__device__ __forceinline__ float sum8(float v) {
    v += dppf<0xB1>(v); v += dppf<0x4E>(v); v += dppf<0x141>(v); return v;
}
__device__ __forceinline__ void xhalf_swap(float& a, float& b) { asm volatile("s_nop 1\n\tv_permlane32_swap_b32 %0, %1\n\ts_nop 1" : "+v"(a), "+v"(b)); }
__device__ __forceinline__ float xhalf_max(float m) { float a = m, b = m; xhalf_swap(a, b); return fmaxf(a, b); }
__device__ __forceinline__ float xhalf_sum(float m) { float a = m, b = m; xhalf_swap(a, b); return a + b; }
__device__ __forceinline__ float wave_sum(float v) { v = sum16(v); v += __shfl_xor(v, 16); return xhalf_sum(v); }
__device__ __forceinline__ float wave_max(float v) {
    v = fmaxf(v, dppf<0xB1>(v)); v = fmaxf(v, dppf<0x4E>(v)); v = fmaxf(v, dppf<0x141>(v)); v = fmaxf(v, dppf<0x140>(v)); v = fmaxf(v, __shfl_xor(v, 16)); return xhalf_max(v); }
__device__ __forceinline__ int crow(int r, int hi) { return (r & 3) + 8 * (r >> 2) + 4 * hi; }
#define LDS_WAIT() asm volatile("s_waitcnt lgkmcnt(0)" ::: "memory")
#define VM_WAIT() asm volatile("s_waitcnt vmcnt(0)" ::: "memory")

#define XB_TMO      128
#define XB_XCNT(j)  (256  + 64 * (j))
#define XB_XSUB(j)  (1280 + 64 * (j))
#define XB_XGEN(j)  (2304 + 64 * (j))
#define XB_TOP      3328
#define XB_TOPGEN   3392
#define XCD_BAR_WORDS 3456
#define XB_SPIN_CAP (1u << 20)
__device__ __forceinline__ unsigned xb_ld(unsigned* p)              { return __hip_atomic_load(p, __ATOMIC_RELAXED, __HIP_MEMORY_SCOPE_AGENT); }
__device__ __forceinline__ unsigned xb_add(unsigned* p, unsigned v) { return __hip_atomic_fetch_add(p, v, __ATOMIC_RELAXED, __HIP_MEMORY_SCOPE_AGENT); }
__device__ __forceinline__ unsigned xb_xcc_id() { return (unsigned)__builtin_amdgcn_s_getreg((3 << 11) | 20) & 0xFu; }
#define XB_SPIN(cond, bar) do { unsigned _sp = 0; while (cond) { __builtin_amdgcn_s_sleep(1); \
    if ((++_sp & 255u) == 0u) { if (xb_ld(&(bar)[XB_TMO])) break; if (_sp > XB_SPIN_CAP) { atomicAdd(&(bar)[XB_TMO], 1u); break; } } } } while (0)
struct XcdBarrier { unsigned* bar; unsigned x; volatile LAS unsigned* st; };
__device__ __forceinline__ XcdBarrier xcd_barrier_post(unsigned* bar, volatile LAS unsigned* st) {
    XcdBarrier b; b.bar = bar; b.x = xb_xcc_id(); b.st = st;
    if (threadIdx.x == 0) (void)xb_add(&bar[XB_XCNT(b.x)], 1u);
    return b;
}
__device__ __forceinline__ void xcd_barrier_complete(unsigned* bar, unsigned x, unsigned& nloc, unsigned& nx) {
    const unsigned G = gridDim.x * gridDim.y * gridDim.z;
    unsigned sum, cnt, mine, sp = 0u;
    for (;;) {
        sum = 0u; cnt = 0u; mine = 0u;
#pragma unroll
        for (unsigned j = 0; j < 16; ++j) { const unsigned c = xb_ld(&bar[XB_XCNT(j)]); sum += c; cnt += (c > 0u) ? 1u : 0u; mine = (j == x) ? c : mine; }
        if (sum == G) break;
        __builtin_amdgcn_s_sleep(1);
        if ((++sp & 255u) == 0u) { if (xb_ld(&bar[XB_TMO])) break; if (sp > XB_SPIN_CAP) { atomicAdd(&bar[XB_TMO], 1u); break; } }
    }
    nloc = mine > 0u ? mine : 1u; nx = cnt > 0u ? cnt : 1u;
}
__device__ __forceinline__ void xcd_barrier(const XcdBarrier& b) {
    asm volatile("s_waitcnt vmcnt(0)" ::: "memory");
    __syncthreads();
    if (threadIdx.x == 0) {
        unsigned* bar = b.bar;
        __builtin_amdgcn_s_waitcnt(0);
        unsigned nloc = b.st[0], nx = b.st[1];
        if (nloc == 0u) { xcd_barrier_complete(bar, b.x, nloc, nx); b.st[0] = nloc; b.st[1] = nx; }
        const unsigned old = xb_add(&bar[XB_XSUB(b.x)], 1u);
        const unsigned gen = old / nloc;
        if (old + 1u == (gen + 1u) * nloc) {
            __builtin_amdgcn_fence(__ATOMIC_RELEASE, "agent");
            asm volatile("s_waitcnt vmcnt(0)" ::: "memory");
            const unsigned og = xb_add(&bar[XB_TOP], 1u);
            const unsigned tg = og / nx;
            if (og + 1u == (tg + 1u) * nx) xb_add(&bar[XB_TOPGEN], 1u);
            else XB_SPIN(xb_ld(&bar[XB_TOPGEN]) == tg, bar);
            __builtin_amdgcn_fence(__ATOMIC_ACQUIRE, "agent");
            xb_add(&bar[XB_XGEN(b.x)], 1u);
            asm volatile("s_waitcnt vmcnt(0)" ::: "memory");
        } else {
            XB_SPIN(xb_ld(&bar[XB_XGEN(b.x)]) == gen, bar);
            __builtin_amdgcn_fence(__ATOMIC_ACQUIRE, "agent");
            asm volatile("s_waitcnt vmcnt(0)" ::: "memory");
        }
    }
    __syncthreads();
}

namespace pg8 {
constexpr int BM = 256, BK = 64, HALF = 128, HTB = HALF * BK * 2, STAGE_BYTES = 8 * HTB;
__host__ __device__ __forceinline__ int lds_byte(int r, int c) { const int st = (r >> 4) * 2 + (c >> 5), rr = r & 15, cc = c & 31, ob = rr * 64 + cc * 2; return st * 1024 + (ob ^ (((ob >> 9) & 1) << 5)); }
__host__ __device__ __forceinline__ void stage_rc(int b, int& R, int& C) { const int st = b / 1024, sb = b % 1024, swz = sb ^ (((sb >> 9) & 1) << 5); R = (st >> 1) * 16 + swz / 64; C = (st & 1) * 32 + (swz % 64) / 2; }
__host__ __device__ __forceinline__ int perm32(int rho) { const int n = rho >> 4, i = rho & 15; return 8 * (i >> 2) + 4 * n + (i & 3); }

struct Unit { long aoff, boff; int arow, brow, pm, pn, g, flags; };
constexpr int UF_ACCUM = 1  , UF_NOEPI = 2  ;
struct Gemm { const bf16_t* A; const bf16_t* Bt; int lda, ldb, K; };

template <class Epi, class Sched>
__device__ __forceinline__ void gemm_phase(LAS unsigned char* lds, const int tid, const Gemm g, Sched& S, const Epi& E) {
    const int wid = __builtin_amdgcn_readfirstlane(tid >> 6), lane = tid & 63, wr = wid >> 2, wc = wid & 3, fr = lane & 15, fq = lane >> 4;
    const int K = g.K, nt = K / BK;
    unsigned voffA[2], voffB[2];
#pragma unroll
    for (int i = 0; i < 2; ++i) { int R, C; stage_rc(tid * 16 + i * 8192, R, C); const int Rb = Epi::PERM ? ((R & ~31) + perm32(R & 31)) : R;
        voffA[i] = (unsigned)(R * g.lda + C) * 2u; voffB[i] = (unsigned)(Rb * g.ldb + C) * 2u; }
    const size_t kstep = (size_t)(BK * 2);
    const size_t hstepA = (size_t)HALF * g.lda * 2, hstepB = (size_t)HALF * g.ldb * 2;
    const size_t tstepA = 2 * hstepA, tstepB = 2 * hstepB;
    const unsigned ldsw = (unsigned)wid * 1024u;
    const int aoff = lds_byte(wr * 64 + fr, fq * 8), boff = lds_byte(wc * 32 + fr, fq * 8);
#define PG8_SA(b, h) (((b) * 2 + (h)) * HTB)
#define PG8_SB(b, h) ((4 + (b) * 2 + (h)) * HTB)
#define PG8_STAGE(bufoff, gbase, voff) do { _Pragma("unroll") for (int _i = 0; _i < 2; ++_i) \
        __builtin_amdgcn_global_load_lds((const unsigned*)((const char*)(gbase) + (voff)[_i]), (LAS unsigned*)(lds + (bufoff) + ldsw + _i * 8192), 16, 0, 0); } while (0)
#define PG8_LDA(dst, b, h) do { _Pragma("unroll") for (int m = 0; m < 4; ++m) _Pragma("unroll") for (int k = 0; k < 2; ++k) dst[m][k] = *(const LAS bf16x8*)(lds + PG8_SA(b, h) + aoff + m * 2048 + k * 1024); } while (0)
#define PG8_LDB(dst, b, h) do { _Pragma("unroll") for (int n = 0; n < 2; ++n) _Pragma("unroll") for (int k = 0; k < 2; ++k) dst[n][k] = *(const LAS bf16x8*)(lds + PG8_SB(b, h) + boff + n * 2048 + k * 1024); } while (0)
#define PG8_MMA(ai, bj, At, Bt) do { __builtin_amdgcn_s_setprio(1); _Pragma("unroll") for (int m = 0; m < 4; ++m) _Pragma("unroll") for (int n = 0; n < 2; ++n) _Pragma("unroll") for (int k = 0; k < 2; ++k) \
        acc[ai][bj][m][n] = __builtin_amdgcn_mfma_f32_16x16x32_bf16(Bt[n][k], At[m][k], acc[ai][bj][m][n], 0, 0, 0); __builtin_amdgcn_s_setprio(0); } while (0)
#define PG8_WAIT_V(n) asm volatile("s_waitcnt vmcnt(" #n ")" ::: "memory")
#define PG8_WAIT_L(n) asm volatile("s_waitcnt lgkmcnt(" #n ")" ::: "memory")
#define PG8_BAR __builtin_amdgcn_s_barrier()
#define PG8_SCHED __builtin_amdgcn_sched_barrier(0)
    Unit cur, nxt; int ui = 0;
    if (!S.next(0, cur)) return;
    f32x4 acc[2][2][4][2];
#pragma unroll
    for (int a = 0; a < 2; ++a)
#pragma unroll
        for (int b = 0; b < 2; ++b)
#pragma unroll
            for (int m = 0; m < 4; ++m)
#pragma unroll
                for (int n = 0; n < 2; ++n) acc[a][b][m][n] = (f32x4){0.f, 0.f, 0.f, 0.f};
    bf16x8 At[4][2], B0[2][2], B1[2][2];
    const char* cA = (const char*)g.A + (size_t)cur.arow * tstepA + cur.aoff; const char* cB = (const char*)g.Bt + (size_t)cur.brow * tstepB + cur.boff;
    PG8_STAGE(PG8_SB(0, 0), cB, voffB); PG8_STAGE(PG8_SB(0, 1), cB + hstepB, voffB); PG8_STAGE(PG8_SA(0, 0), cA, voffA); PG8_STAGE(PG8_SA(0, 1), cA + hstepA, voffA);
    if (wr == 1) PG8_BAR;
    PG8_WAIT_V(2); PG8_BAR;
    PG8_STAGE(PG8_SB(1, 0), cB + kstep, voffB); PG8_STAGE(PG8_SA(1, 0), cA + kstep, voffA); PG8_STAGE(PG8_SB(1, 1), cB + hstepB + kstep, voffB);
    PG8_WAIT_V(6); PG8_BAR;
    for (;;) {
        const bool has_next = S.next(ui + 1, nxt);
        const char* nA = has_next ? (const char*)g.A + (size_t)nxt.arow * tstepA + nxt.aoff : cA; const char* nB = has_next ? (const char*)g.Bt + (size_t)nxt.brow * tstepB + nxt.boff : cB;
        for (int t = 0; t < nt; t += 2) {
            if constexpr (Epi::MIDK) { if (t == 8 || t == 16) { int tz = tid; asm volatile("" : "+v"(tz)); E.midk(acc, cur, t, tz); } }
            const bool last = (t == nt - 2);
            const char* a1 = cA + (size_t)(t + 1) * kstep;
            const char* a2 = last ? nA : cA + (size_t)(t + 2) * kstep; const char* b2 = last ? nB : cB + (size_t)(t + 2) * kstep;
            const char* a3 = a2 + kstep; const char* b3 = b2 + kstep;
            PG8_LDB(B0, 0, 0); PG8_LDB(B1, 0, 1); PG8_SCHED; PG8_LDA(At, 0, 0); PG8_STAGE(PG8_SA(1, 1), a1 + hstepA, voffA);
            PG8_WAIT_V(8); PG8_WAIT_L(0); PG8_BAR; PG8_MMA(0, 0, At, B0); PG8_MMA(0, 1, At, B1); PG8_BAR; PG8_SCHED;
            PG8_LDA(At, 0, 1); PG8_STAGE(PG8_SB(0, 0), b2, voffB); PG8_STAGE(PG8_SB(0, 1), b2 + hstepB, voffB); PG8_STAGE(PG8_SA(0, 0), a2, voffA);
            PG8_WAIT_V(8); PG8_WAIT_L(0); PG8_BAR; PG8_MMA(1, 0, At, B0); PG8_MMA(1, 1, At, B1); PG8_BAR; PG8_SCHED;
            PG8_LDB(B0, 1, 0); PG8_LDB(B1, 1, 1); PG8_SCHED; PG8_LDA(At, 1, 0); PG8_STAGE(PG8_SA(0, 1), a2 + hstepA, voffA);
            PG8_WAIT_V(8); PG8_WAIT_L(0); PG8_BAR; PG8_MMA(0, 0, At, B0); PG8_MMA(0, 1, At, B1); PG8_BAR; PG8_SCHED;
            PG8_LDA(At, 1, 1); PG8_STAGE(PG8_SB(1, 0), b3, voffB); PG8_STAGE(PG8_SB(1, 1), b3 + hstepB, voffB); PG8_STAGE(PG8_SA(1, 0), a3, voffA);
            PG8_WAIT_V(8); PG8_WAIT_L(0); PG8_BAR; PG8_MMA(1, 0, At, B0); PG8_MMA(1, 1, At, B1); PG8_BAR; PG8_SCHED;
        }
        if (wr == 0) PG8_BAR;
#ifdef PROBE_PNOISE
        if (Epi::PROBE_P && !(cur.flags & UF_NOEPI)) {
#pragma unroll
            for (int a = 0; a < 2; ++a)
#pragma unroll
                for (int b = 0; b < 2; ++b)
#pragma unroll
                    for (int m = 0; m < 4; ++m)
#pragma unroll
                        for (int n = 0; n < 2; ++n)
#pragma unroll
                            for (int i = 0; i < 4; ++i) { unsigned hsh = (unsigned)(((cur.pm * 32 + cur.pn) * 512 + tid) * 128 + ((a * 2 + b) * 4 + m) * 8 + n * 4 + i) * 2654435761u; hsh ^= hsh >> 15; hsh *= 2246822519u; hsh ^= hsh >> 13;
                                acc[a][b][m][n][i] *= 1.0f + PROBE_PNOISE * (((float)(hsh & 0xffff) * (1.0f / 32768.0f) - 1.0f) * 1.7320508f); }
        }
#endif
        if (!(cur.flags & UF_NOEPI)) { int tz = tid; asm volatile("" : "+v"(tz));
          const int w2 = __builtin_amdgcn_readfirstlane(tz >> 6), l2 = tz & 63; E(acc, cur, w2 >> 2, w2 & 3, l2 & 15, l2 >> 4); }
        if (!has_next) break;
        if (!(nxt.flags & UF_ACCUM)) {
#pragma unroll
        for (int a = 0; a < 2; ++a)
#pragma unroll
            for (int b = 0; b < 2; ++b)
#pragma unroll
                for (int m = 0; m < 4; ++m)
#pragma unroll
                    for (int n = 0; n < 2; ++n) acc[a][b][m][n] = (f32x4){0.f, 0.f, 0.f, 0.f};
        }
        cur = nxt; cA = nA; cB = nB; ++ui;
        if (wr == 1) PG8_BAR;
    }
    PG8_WAIT_V(0);
    PG8_BAR;
#undef PG8_SA
#undef PG8_SB
#undef PG8_STAGE
#undef PG8_LDA
#undef PG8_LDB
#undef PG8_MMA
#undef PG8_WAIT_V
#undef PG8_WAIT_L
#undef PG8_BAR
#undef PG8_SCHED
}
}
__device__ __forceinline__ int pm_of(int kind, int pmi) { return kind == 0 ? pmi : (kind == 1 ? pmi + (pmi >> 3) + 1 : 9 * pmi); }
__device__ __forceinline__ int npm_of(int kind) { return kind == 0 ? 144 : (kind == 1 ? 128 : 16); }
struct RectSched {
    int G, c; int cnt0, kind0, pn00, npn0, cnt1, kind1, pn01, npn1;
    __device__ __forceinline__ void init(int G_, int c_, int kind0_, int pn00_, int npn0_, int kind1_, int pn01_, int npn1_) {
        G = G_; c = c_; kind0 = kind0_; pn00 = pn00_; npn0 = npn0_; cnt0 = npm_of(kind0_) * npn0_; kind1 = kind1_; pn01 = pn01_; npn1 = npn1_; cnt1 = npn1_ > 0 ? npm_of(kind1_) * npn1_ : 0; }
    __device__ __forceinline__ bool decode(int L, int& pm, int& pn) const {
        int kind, pn0, npn;
        if (L < cnt0) { kind = kind0; pn0 = pn00; npn = npn0; } else { L -= cnt0; if (L >= cnt1) return false; kind = kind1; pn0 = pn01; npn = npn1; }
        const int grp = L / (8 * npn), rem = L - grp * 8 * npn; const int pmi = grp * 8 + (rem & 7), pni = rem >> 3;
        pm = pm_of(kind, pmi); pn = pn0 + pni; return true;
    }
    __device__ __forceinline__ bool next(int i, pg8::Unit& u) {
        int pm, pn; if (!decode(i * G + c, pm, pn)) return false;
        u.pm = pm; u.pn = pn; u.arow = pm; u.brow = pn; u.aoff = 0; u.boff = 0; u.g = 0; u.flags = 0; return true;
    }
};
struct InProjSched : RectSched {
    long hlo_off, wlo_off; int t, seg, nseg, pm_, pn_;
    __device__ __forceinline__ void init2(long hlo_off_, long wlo_off_) { hlo_off = hlo_off_; wlo_off = wlo_off_; t = 0; seg = 0; nseg = 1; pm_ = 0; pn_ = 0; }
    __device__ __forceinline__ bool next(int, pg8::Unit& u) {
        if (seg == 0) { if (!decode(t * G + c, pm_, pn_)) return false; nseg = (SPLIT_K && (pn_ == 8 || pn_ == 9)) ? 3 : 1; }
        u.pm = pm_; u.pn = pn_; u.g = 0; u.arow = pm_; u.brow = (seg == 1) ? pn_ - 8 : pn_;
        u.aoff = (seg == 2) ? hlo_off : 0; u.boff = (seg == 1) ? wlo_off : 0;
        u.flags = (seg > 0 ? pg8::UF_ACCUM : 0) | (seg + 1 < nseg ? pg8::UF_NOEPI : 0);
        if (++seg == nseg) { seg = 0; ++t; }
        return true;
    }
};
struct MergeSched {
    int G, c, kind, ntile;
    __device__ __forceinline__ void init(int G_, int c_, int kind_) { G = G_; c = c_; kind = kind_; ntile = npm_of(kind_) * 4; }
    __device__ __forceinline__ bool next(int i, pg8::Unit& u) {
        const int ti = c + i * G; if (ti >= ntile) return false;
        u.pm = pm_of(kind, ti >> 2); u.pn = ti & 3; u.arow = u.pm; u.brow = u.pn; u.aoff = 0; u.boff = 0; u.g = 0; u.flags = 0; return true;
    }
};
struct MoeSched {
    int G, c, npm_e, npn, atile_e, btile_e;
    __device__ __forceinline__ void init(int G_, int c_, int npm_e_, int npn_, int btile_e_) { G = G_; c = c_; npm_e = npm_e_; npn = npn_; atile_e = EROWS / 256; btile_e = btile_e_; }
    __device__ __forceinline__ bool next(int i, pg8::Unit& u) {
        const int L = i * G + c, per = npm_e * npn; if (L >= NEXP * per) return false;
        const int e = L / per, rem = L - e * per; const int pmi = rem % npm_e, pni = rem / npm_e;
        u.pm = pmi; u.pn = pni; u.g = e; u.arow = e * atile_e + pmi; u.brow = e * btile_e + pni; u.aoff = 0; u.boff = 0; u.flags = 0; return true;
    }
};

typedef const f32x4 (&AccRef)[2][2][4][2];
__device__ __forceinline__ int perm16(int kk) { return 8 * ((kk >> 2) & 1) + (kk & 3) + 4 * (kk >> 3); }

struct EpiInProj {
    static constexpr bool PERM = true, PROBE_P = true, MIDK = false;
    bf16_t *Q, *Kb, *Vt, *PRW, *SG, *GATE; const f32x2* rope; bf16_t* KLO;
    __device__ __forceinline__ void operator()(AccRef acc, const pg8::Unit& u, int wr, int wc, int fr, int fq) const {
        const int pn = u.pn, b = u.pm / 9, sl = u.pm - 9 * b; const bool is_ctx = (sl == 0);
        const int rbase = wr * 64 + fr, c8 = wc * 32 + 8 * fq;
        if (pn < 4) {
            bf16_t* dst = (pn < 2) ? Q : Kb; const int cb = (pn & 1) * 256; const float sc = (pn < 2) ? QSCALE : 1.0f; const int hh = wc & 1;
            f32x4 rt01[2][4], rt23[2][4];
#pragma unroll
            for (int ai = 0; ai < 2; ++ai)
#pragma unroll
                for (int m = 0; m < 4; ++m) { const int rl = ai * 128 + m * 16 + rbase; rt01[ai][m] = (f32x4){1.f, 0.f, 1.f, 0.f}; rt23[ai][m] = rt01[ai][m];
                    if (!is_ctx) { const int t = (sl - 1) * 256 + rl; const int pos = hh ? (t & 63) : (t >> 6); const f32x4* rp = (const f32x4*)(rope + pos * 16 + 4 * fq); rt01[ai][m] = rp[0]; rt23[ai][m] = rp[1]; } }
#pragma unroll
            for (int ai = 0; ai < 2; ++ai)
#pragma unroll
                for (int m = 0; m < 4; ++m) { const int rl = ai * 128 + m * 16 + rbase; const size_t row = (size_t)u.pm * 256 + rl;
                    const f32x4 r01 = rt01[ai][m], r23 = rt23[ai][m];
#pragma unroll
                    for (int bj = 0; bj < 2; ++bj) { const f32x4 v0 = acc[ai][bj][m][0] * sc, v1 = acc[ai][bj][m][1] * sc;
                        const float o0 = v0[0] * r01[0] - v0[1] * r01[1], o1 = v0[1] * r01[0] + v0[0] * r01[1];
                        const float o2 = v0[2] * r01[2] - v0[3] * r01[3], o3 = v0[3] * r01[2] + v0[2] * r01[3];
                        const float o4 = v1[0] * r23[0] - v1[1] * r23[1], o5 = v1[1] * r23[0] + v1[0] * r23[1];
                        const float o6 = v1[2] * r23[2] - v1[3] * r23[3], o7 = v1[3] * r23[2] + v1[2] * r23[3];
                        u32x4 w; w.x = cvt_pk_bf16(o0, o1); w.y = cvt_pk_bf16(o2, o3); w.z = cvt_pk_bf16(o4, o5); w.w = cvt_pk_bf16(o6, o7);
                        *(u32x4*)(dst + row * 512 + cb + bj * 128 + c8) = w; } }
        } else if (pn < 6) {
#pragma unroll
            for (int ai = 0; ai < 2; ++ai)
#pragma unroll
                for (int m = 0; m < 4; ++m) { const int rl = ai * 128 + m * 16 + rbase; const int s = sl * 256 + rl; const int slot = (s & ~15) + perm16(s & 15);
#pragma unroll
                    for (int bj = 0; bj < 2; ++bj) { const int head = 2 * (pn - 4) + bj; bf16_t* vp = Vt + ((size_t)(b * 4 + head) * 128 + c8) * T_ALL + slot;
#pragma unroll
                        for (int n = 0; n < 2; ++n)
#pragma unroll
                            for (int i = 0; i < 4; ++i) vp[(size_t)(4 * n + i) * T_ALL] = (bf16_t)f2bf(acc[ai][bj][m][n][i]); } }
        } else if (SPLIT_K && (pn == 8 || pn == 9)) {
#pragma unroll
            for (int ai = 0; ai < 2; ++ai)
#pragma unroll
                for (int m = 0; m < 4; ++m) { const size_t row = (size_t)u.pm * 256 + ai * 128 + m * 16 + rbase;
#pragma unroll
                    for (int bj = 0; bj < 2; ++bj) { const f32x4 v0 = acc[ai][bj][m][0], v1 = acc[ai][bj][m][1];
                        u32x4 w; w.x = cvt_pk_bf16(v0[0], v0[1]); w.y = cvt_pk_bf16(v0[2], v0[3]); w.z = cvt_pk_bf16(v1[0], v1[1]); w.w = cvt_pk_bf16(v1[2], v1[3]);
                        *(u32x4*)(PRW + row * RW_COLS + (pn - 6) * 256 + bj * 128 + c8) = w;
                        u32x4 lo; lo.x = cvt_pk_bf16(v0[0] - bflo(w.x), v0[1] - bfhi(w.x)); lo.y = cvt_pk_bf16(v0[2] - bflo(w.y), v0[3] - bfhi(w.y));
                        lo.z = cvt_pk_bf16(v1[0] - bflo(w.z), v1[1] - bfhi(w.z)); lo.w = cvt_pk_bf16(v1[2] - bflo(w.w), v1[3] - bfhi(w.w));
                        *(u32x4*)(KLO + row * 512 + (pn - 8) * 256 + bj * 128 + c8) = lo; } }
        } else if (pn < 13) rows_bf16<0>(acc, PRW, RW_COLS, (pn - 6) * 256 + c8, (size_t)u.pm * 256 + rbase);
        else if (pn < 17) rows_bf16<1>(acc, SG, 1024, (pn - 13) * 256 + c8, (size_t)u.pm * 256 + rbase);
        else {
            const int gj = (pn - 17) >> 2, pnm = (pn - 17) & 3;
            bf16_t* gp = GATE + (((((size_t)u.pm * 4 + pnm) * 3 + gj) * 8 + (wr * 4 + wc)) * 16) * 512 + (fr + 16 * fq) * 8;
#pragma unroll
            for (int ai = 0; ai < 2; ++ai)
#pragma unroll
                for (int m = 0; m < 4; ++m)
#pragma unroll
                    for (int bj = 0; bj < 2; ++bj) { f32x4 v0 = acc[ai][bj][m][0], v1 = acc[ai][bj][m][1];
#pragma unroll
                        for (int i = 0; i < 4; ++i) { v0[i] = sigmoidf_(v0[i]); v1[i] = sigmoidf_(v1[i]); }
                        u32x4 w; w.x = cvt_pk_bf16(v0[0], v0[1]); w.y = cvt_pk_bf16(v0[2], v0[3]); w.z = cvt_pk_bf16(v1[0], v1[1]); w.w = cvt_pk_bf16(v1[2], v1[3]);
                        *(u32x4*)(gp + ((ai * 4 + m) * 2 + bj) * 512) = w; } }
    }
    template <int ACT> static __device__ __forceinline__ void rows_bf16(AccRef acc, bf16_t* dst, int ld, int col, size_t row0) {
#pragma unroll
        for (int ai = 0; ai < 2; ++ai)
#pragma unroll
            for (int m = 0; m < 4; ++m) { bf16_t* rp = dst + (row0 + ai * 128 + m * 16) * ld + col;
#pragma unroll
                for (int bj = 0; bj < 2; ++bj) { f32x4 v0 = acc[ai][bj][m][0], v1 = acc[ai][bj][m][1];
                    if (ACT == 1) {
#pragma unroll
                        for (int i = 0; i < 4; ++i) { v0[i] = gelu_tanh(v0[i]); v1[i] = gelu_tanh(v1[i]); } }
                    if (ACT == 2) {
#pragma unroll
                        for (int i = 0; i < 4; ++i) { v0[i] = sigmoidf_(v0[i]); v1[i] = sigmoidf_(v1[i]); } }
                    u32x4 w; w.x = cvt_pk_bf16(v0[0], v0[1]); w.y = cvt_pk_bf16(v0[2], v0[3]); w.z = cvt_pk_bf16(v1[0], v1[1]); w.w = cvt_pk_bf16(v1[2], v1[3]);
                    *(u32x4*)(rp + bj * 128) = w; } }
    }
};

struct EpiMerge { static constexpr bool PROBE_P = false;
    static constexpr bool PERM = true, MIDK = true;
    const bf16_t* GATE; bf16_t* M;
    static __device__ __forceinline__ f32x4 glo(u32x4 w) { return (f32x4){fmaxf(bflo(w.x), 1e-30f), fmaxf(bfhi(w.x), 1e-30f), fmaxf(bflo(w.y), 1e-30f), fmaxf(bfhi(w.y), 1e-30f)}; }
    static __device__ __forceinline__ f32x4 ghi(u32x4 w) { return (f32x4){fmaxf(bflo(w.z), 1e-30f), fmaxf(bfhi(w.z), 1e-30f), fmaxf(bflo(w.w), 1e-30f), fmaxf(bfhi(w.w), 1e-30f)}; }
    __device__ __forceinline__ void midk(f32x4 (&acc)[2][2][4][2], const pg8::Unit& u, int t, int tz) const {
        const int w2 = __builtin_amdgcn_readfirstlane(tz >> 6), l2 = tz & 63, wr = w2 >> 2, wc = w2 & 3, fr = l2 & 15, fq = l2 >> 4;
        const int j = (t == 8) ? 0 : 1;
        const bf16_t* gbase = GATE + (((((size_t)u.pm * 4 + u.pn) * 3 + j) * 8 + w2) * 16) * 512 + l2 * 8;
#pragma unroll
        for (int ai = 0; ai < 2; ++ai) { u32x4 ga[4][2], gb[4][2];
#pragma unroll
            for (int m = 0; m < 4; ++m)
#pragma unroll
                for (int bj = 0; bj < 2; ++bj) { const bf16_t* gp = gbase + ((ai * 4 + m) * 2 + bj) * 512; ga[m][bj] = *(const u32x4*)gp; gb[m][bj] = *(const u32x4*)(gp + 8 * 16 * 512); }
#pragma unroll
            for (int m = 0; m < 4; ++m)
#pragma unroll
                for (int bj = 0; bj < 2; ++bj) { const f32x4 a0 = glo(ga[m][bj]), a1 = ghi(ga[m][bj]), b0 = glo(gb[m][bj]), b1 = ghi(gb[m][bj]);
#pragma unroll
                    for (int i = 0; i < 4; ++i) { acc[ai][bj][m][0][i] *= a0[i] * fast_rcp(b0[i]); acc[ai][bj][m][1][i] *= a1[i] * fast_rcp(b1[i]); } } }
    }
    __device__ __forceinline__ void operator()(const f32x4 (&acc)[2][2][4][2], const pg8::Unit& u, int wr, int wc, int fr, int fq) const {
        const int rbase = wr * 64 + fr, c8 = u.pn * 256 + wc * 32 + 8 * fq;
        u32x4 gwv[2][4][2];
        { const bf16_t* gbase = GATE + (((((size_t)u.pm * 4 + u.pn) * 3 + 2) * 8 + (wr * 4 + wc)) * 16) * 512 + (fr + 16 * fq) * 8;
#pragma unroll
          for (int ai = 0; ai < 2; ++ai)
#pragma unroll
              for (int m = 0; m < 4; ++m)
#pragma unroll
                  for (int bj = 0; bj < 2; ++bj) gwv[ai][m][bj] = *(const u32x4*)(gbase + ((ai * 4 + m) * 2 + bj) * 512); }
#pragma unroll
        for (int ai = 0; ai < 2; ++ai)
#pragma unroll
            for (int m = 0; m < 4; ++m) { const size_t row = (size_t)u.pm * 256 + ai * 128 + m * 16 + rbase;
#pragma unroll
                for (int bj = 0; bj < 2; ++bj) { const int col = c8 + bj * 128;
                    const u32x4 gw = gwv[ai][m][bj];
                    const f32x4 v0 = acc[ai][bj][m][0] * glo(gw), v1 = acc[ai][bj][m][1] * ghi(gw);
                    u32x4 w; w.x = cvt_pk_bf16(v0[0], v0[1]); w.y = cvt_pk_bf16(v0[2], v0[3]); w.z = cvt_pk_bf16(v1[0], v1[1]); w.w = cvt_pk_bf16(v1[2], v1[3]);
                    *(u32x4*)(M + row * 1024 + col) = w; } }
    }
};

struct EpiWout { static constexpr bool PROBE_P = false, MIDK = false;
    static constexpr bool PERM = false;
    const float* xin; const float* cin; float* X; const float* mod; int layer0;
    __device__ __forceinline__ void operator()(AccRef acc, const pg8::Unit& u, int wr, int wc, int fr, int fq) const {
        const int b = u.pm / 9, sl = u.pm - 9 * b; const bool is_ctx = (sl == 0);
        const float* g1 = mod + (size_t)(is_ctx ? 16 : b) * 6144 + 2048;
        const int rbase = wr * 64 + fr, c4 = u.pn * 256 + wc * 32 + 4 * fq;
        f32x4 gv[2][2];
#pragma unroll
        for (int bj = 0; bj < 2; ++bj)
#pragma unroll
            for (int n = 0; n < 2; ++n) gv[bj][n] = *(const f32x4*)(g1 + c4 + bj * 128 + n * 16);
#pragma unroll
        for (int ai = 0; ai < 2; ++ai) { f32x4 xv[4][2][2];
#pragma unroll
            for (int m = 0; m < 4; ++m) { const int rl = ai * 128 + m * 16 + rbase; const size_t row = (size_t)u.pm * 256 + rl;
                const float* xp = layer0 ? (is_ctx ? cin + ((size_t)b * T_CTX + rl) * 1024 : xin + ((size_t)b * T_LAT + (sl - 1) * 256 + rl) * 1024) : X + row * 1024;
#pragma unroll
                for (int bj = 0; bj < 2; ++bj)
#pragma unroll
                    for (int n = 0; n < 2; ++n) xv[m][bj][n] = *(const f32x4*)(xp + c4 + bj * 128 + n * 16); }
#pragma unroll
            for (int m = 0; m < 4; ++m) { const size_t row = (size_t)u.pm * 256 + ai * 128 + m * 16 + rbase;
#pragma unroll
                for (int bj = 0; bj < 2; ++bj)
#pragma unroll
                    for (int n = 0; n < 2; ++n) { const int col = c4 + bj * 128 + n * 16; *(f32x4*)(X + row * 1024 + col) = DN_ALPHA * xv[m][bj][n] + gv[bj][n] * acc[ai][bj][m][n]; } } }
    }
};

struct EpiMoe1 { static constexpr bool PROBE_P = false, MIDK = false;
    static constexpr bool PERM = true;
    bf16_t* HID;
    __device__ __forceinline__ void operator()(AccRef acc, const pg8::Unit& u, int wr, int wc, int fr, int fq) const {
        const int rbase = wr * 64 + fr, c8 = u.pn * 128 + wc * 32 + 8 * fq;
#pragma unroll
        for (int ai = 0; ai < 2; ++ai)
#pragma unroll
            for (int m = 0; m < 4; ++m) { const size_t row = (size_t)u.g * EROWS + u.pm * 256 + ai * 128 + m * 16 + rbase;
                float h[8];
#pragma unroll
                for (int n = 0; n < 2; ++n)
#pragma unroll
                    for (int i = 0; i < 4; ++i) h[4 * n + i] = siluf_(acc[ai][0][m][n][i]) * acc[ai][1][m][n][i];
                u32x4 w; w.x = cvt_pk_bf16(h[0], h[1]); w.y = cvt_pk_bf16(h[2], h[3]); w.z = cvt_pk_bf16(h[4], h[5]); w.w = cvt_pk_bf16(h[6], h[7]);
                *(u32x4*)(HID + row * FF + c8) = w; }
    }
};

struct EpiMoe2 { static constexpr bool PROBE_P = false, MIDK = false;
    static constexpr bool PERM = true;
    bf16_t* YE; const float* GATEE;
    __device__ __forceinline__ void operator()(AccRef acc, const pg8::Unit& u, int wr, int wc, int fr, int fq) const {
        const int rbase = wr * 64 + fr, c8 = u.pn * 256 + wc * 32 + 8 * fq;
        float gtv[2][4];
#pragma unroll
        for (int ai = 0; ai < 2; ++ai)
#pragma unroll
            for (int m = 0; m < 4; ++m) gtv[ai][m] = GATEE[(size_t)u.g * EROWS + u.pm * 256 + ai * 128 + m * 16 + rbase];
#pragma unroll
        for (int ai = 0; ai < 2; ++ai)
#pragma unroll
            for (int m = 0; m < 4; ++m) { const size_t row = (size_t)u.g * EROWS + u.pm * 256 + ai * 128 + m * 16 + rbase; const float gt = gtv[ai][m];
#pragma unroll
                for (int bj = 0; bj < 2; ++bj) { const f32x4 v0 = acc[ai][bj][m][0] * gt, v1 = acc[ai][bj][m][1] * gt;
                    u32x4 w; w.x = cvt_pk_bf16(v0[0], v0[1]); w.y = cvt_pk_bf16(v0[2], v0[3]); w.z = cvt_pk_bf16(v1[0], v1[1]); w.w = cvt_pk_bf16(v1[2], v1[3]);
                    *(u32x4*)(YE + row * 1024 + c8 + bj * 128) = w; } }
    }
};
struct Frame {
    LAS unsigned char* lds;
    int tid, lane, wave, G, blk;
    float* out; unsigned char* ws;
    __device__ __forceinline__ const float* inp(int i) const {
        const u32x2 w = *(const LAS u32x2*)(lds + LDS_MISC + 64 + 8 * i);
        const unsigned lo = __builtin_amdgcn_readfirstlane(w.x), hi = __builtin_amdgcn_readfirstlane(w.y);
        const GAS float* p = (const GAS float*)(((unsigned long long)hi << 32) | lo);
        return (const float*)p;
    }
};
__device__ __forceinline__ void relaunder(Frame& F) { int tz = threadIdx.x; asm volatile("" : "+v"(tz)); F.tid = tz; F.lane = tz & 63; F.wave = __builtin_amdgcn_readfirstlane(tz >> 6); }
enum { I_X = 0, I_C, I_CTX, I_CCTX, I_WMOD, I_BMOD, I_WIN, I_DALAM, I_DANG, I_RWMU, I_RWW0, I_RWW2, I_RWA0, I_RWA2, I_RWKK, I_RWKA, I_RWRK, I_RWLNG, I_RWLNB, I_RWG2,
       I_SGNG, I_SGNB, I_SGW, I_SGB, I_WBR, I_WOUT, I_LN1G, I_LN1B, I_WROUTER, I_WEG, I_WEU, I_WED, I_LN2G, I_LN2B };

__device__ __forceinline__ float lo_part(float x) { return x - __builtin_bit_cast(float, f2bf(x) << 16); }
template <bool ROPEPERM, bool LO = false>
__device__ __forceinline__ void transpose_item(const float* W, int N, int k0, int n0, bf16_t* WT, int ldt, int drow0, LAS float* scr, int lane) {
    const int dc = ROPEPERM ? ((lane & 32) + 2 * (lane & 15) + ((lane >> 4) & 1)) : lane;
    float tv[64];
#pragma unroll
    for (int kk = 0; kk < 64; ++kk) tv[kk] = __builtin_nontemporal_load(W + (size_t)(k0 + kk) * N + n0 + lane);
#pragma unroll
    for (int kk = 0; kk < 64; ++kk) scr[kk * 65 + dc] = tv[kk];
    LDS_WAIT(); asm volatile("" ::: "memory");
    const int c = lane & 7;
#pragma unroll
    for (int j = 0; j < 8; ++j) { const int n = (lane >> 3) + 8 * j; const LAS float* s = scr + (8 * c) * 65 + n;
        u32x4 o;
        if (LO) { o.x = pk2(lo_part(s[0 * 65]), lo_part(s[1 * 65])); o.y = pk2(lo_part(s[2 * 65]), lo_part(s[3 * 65])); o.z = pk2(lo_part(s[4 * 65]), lo_part(s[5 * 65])); o.w = pk2(lo_part(s[6 * 65]), lo_part(s[7 * 65])); }
        else { o.x = pk2(s[0 * 65], s[1 * 65]); o.y = pk2(s[2 * 65], s[3 * 65]); o.z = pk2(s[4 * 65], s[5 * 65]); o.w = pk2(s[6 * 65], s[7 * 65]); }
        *(u32x4*)(WT + (size_t)(drow0 + n) * ldt + k0 + 8 * c) = o; }
    LDS_WAIT(); asm volatile("" ::: "memory");
}

__device__ __forceinline__ void convert_weights(Frame& F, int l, int gw, int NGW) {
    LAS float* scr = (LAS float*)(F.lds + F.wave * 16896);
    bf16_t* WIN = (bf16_t*)(F.ws + WS_WIN); bf16_t* WB = (bf16_t*)(F.ws + WS_WB); bf16_t* WOUT = (bf16_t*)(F.ws + WS_WOUT); bf16_t* G2T = (bf16_t*)(F.ws + WS_G2T);
    bf16_t* WE1 = (bf16_t*)(F.ws + WS_WE1); bf16_t* WE2 = (bf16_t*)(F.ws + WS_WE2); bf16_t* WLO = (bf16_t*)(F.ws + WS_WLO);
    const float* w_in = F.inp(I_WIN) + (size_t)l * DM * IN_COLS;
    const float* w_br = F.inp(I_WBR) + (size_t)l * MIXW * DM;
    const float* w_out = F.inp(I_WOUT) + (size_t)l * DM * DM;
    const float* g2 = F.inp(I_RWG2) + (size_t)l * 128 * 512;
    const float* weg = F.inp(I_WEG) + (size_t)l * NEXP * DM * FF;
    const float* weu = F.inp(I_WEU) + (size_t)l * NEXP * DM * FF;
    const float* wed = F.inp(I_WED) + (size_t)l * NEXP * FF * DM;
    constexpr int I_IN = 16 * 116, I_BR = 24 * 16, I_OUT = 16 * 16, I_G2 = 2 * 8, I_LO = 16 * 8, I_E1 = NEXP * 2 * 16 * 32, I_E2 = NEXP * 32 * 16;
    constexpr int NITEMS = I_IN + I_BR + I_OUT + I_G2 + I_LO + I_E1 + I_E2;
    for (int it = gw; it < NITEMS; it += NGW) {
        int r = it;
        if (r < I_IN) { const int kb = r / 116, nb = r % 116; if (nb < 16) transpose_item<true>(w_in, IN_COLS, 64 * kb, 64 * nb, WIN, DM, 64 * nb, scr, F.lane); else transpose_item<false>(w_in, IN_COLS, 64 * kb, 64 * nb, WIN, DM, 64 * nb, scr, F.lane); continue; } r -= I_IN;
        if (r < I_BR) { const int kb = r / 16, nb = r % 16; transpose_item<false>(w_br, DM, 64 * kb, 64 * nb, WB, MIXW, 64 * nb, scr, F.lane); continue; } r -= I_BR;
        if (r < I_OUT) { const int kb = r / 16, nb = r % 16; transpose_item<false>(w_out, DM, 64 * kb, 64 * nb, WOUT, DM, 64 * nb, scr, F.lane); continue; } r -= I_OUT;
        if (r < I_G2) { const int kb = r / 8, nb = r % 8; transpose_item<false>(g2, 512, 64 * kb, 64 * nb, G2T, 128, 64 * nb, scr, F.lane); continue; } r -= I_G2;
        if (r < I_LO) { const int kb = r / 8, nb = r % 8; if (SPLIT_K) transpose_item<false, true>(w_in, IN_COLS, 64 * kb, 2048 + 64 * nb, WLO, DM, 64 * nb, scr, F.lane); continue; } r -= I_LO;
        if (r < I_E1) { const int e = r / 1024, r2 = r % 1024, which = r2 / 512, r3 = r2 % 512, kb = r3 / 32, nb = r3 % 32; const int n0 = 64 * nb;
            const float* src = (which ? weu : weg) + (size_t)e * DM * FF; const int drow0 = e * 4096 + 256 * (n0 >> 7) + 128 * which + (n0 & 127);
            transpose_item<false>(src, FF, 64 * kb, n0, WE1, DM, drow0, scr, F.lane); continue; } r -= I_E1;
        { const int e = r / 512, r2 = r % 512, kb = r2 / 16, nb = r2 % 16; transpose_item<false>(wed + (size_t)e * FF * DM, DM, 64 * kb, 64 * nb, WE2, FF, e * 1024 + 64 * nb, scr, F.lane); }
    }
}

__device__ __forceinline__ void mod_partials(Frame& F) {
    LAS float* sl = (LAS float*)F.lds;
    float* MODP = (float*)(F.ws + R_MODP);
    for (int un = F.blk; un < 2 * 12 * 16; un += F.G) {
        const int l = un / 192, r = un % 192, cb = r / 16, kc = r % 16;
        __syncthreads();
        for (int i = F.tid; i < 17 * 64; i += 512) { const int rr = i >> 6, k = i & 63; const float cv = (rr < 16) ? F.inp(I_C)[rr * DM + kc * 64 + k] : F.inp(I_CCTX)[kc * 64 + k]; sl[i] = siluf_(cv); }
        __syncthreads();
        const int n = cb * 512 + F.tid; const float* w = F.inp(I_WMOD) + ((size_t)l * DM + kc * 64) * 6144 + n;
        float a[17];
#pragma unroll
        for (int rr = 0; rr < 17; ++rr) a[rr] = 0.f;
#pragma unroll 4
        for (int k = 0; k < 64; ++k) { const float wv = w[(size_t)k * 6144];
#pragma unroll
            for (int rr = 0; rr < 17; ++rr) a[rr] += sl[rr * 64 + k] * wv; }
#pragma unroll
        for (int rr = 0; rr < 17; ++rr) MODP[(((size_t)kc * 2 + l) * 17 + rr) * 6144 + n] = a[rr];
    }
    __syncthreads();
}
__device__ __forceinline__ void mod_reduce(Frame& F) {
    const float* MODP = (const float*)(F.ws + R_MODP); float* MODF = (float*)(F.ws + WS_MODF);
    for (int i = F.blk * 512 + F.tid; i < 2 * 17 * 6144; i += F.G * 512) { const int l = i / (17 * 6144), n = i % 6144;
        float s = F.inp(I_BMOD)[l * 6144 + n];
#pragma unroll
        for (int kc = 0; kc < 16; ++kc) s += MODP[(size_t)kc * 2 * 17 * 6144 + i];
        MODF[i] = s; }
}
__device__ __forceinline__ void small_tables(Frame& F) {
    if (F.blk == 0) {
        f32x2* rope = (f32x2*)(F.ws + WS_SMALL);
        for (int i = F.tid; i < 64 * 16; i += 512) { const int pos = i >> 4, j = i & 15; const float inv = powf(10000.0f, -(float)(2 * j) / 32.0f); const float ang = (float)pos * inv; rope[i] = (f32x2){cosf(ang), sinf(ang)}; }
    }
    if (F.blk == 1 && F.wave < 2) {
        const int l = F.wave; const float* dl = F.inp(I_DALAM) + l * 256;
        const float s01 = wave_sum(dl[F.lane] * dl[64 + F.lane]), s23 = wave_sum(dl[128 + F.lane] * dl[192 + F.lane]);
        const float lam_init = 0.8f - 0.6f * expf(-0.3f * (float)l);
        if (F.lane == 0) { float* sc = (float*)(F.ws + WS_SMALL + 16384); sc[2 * l] = expf(s01) - expf(s23) + lam_init; sc[2 * l + 1] = lam_init; }
    }
}

__device__ __forceinline__ const float* src_row(Frame& F, int row) { const int b = row / T_ALL, s = row - b * T_ALL; return s < T_CTX ? F.inp(I_CTX) + ((size_t)b * T_CTX + s) * DM : F.inp(I_X) + ((size_t)b * T_LAT + (s - T_CTX)) * DM; }
__device__ __forceinline__ const float* mod_row(Frame& F, int l, int row) { const int b = row / T_ALL, s = row - b * T_ALL; return (const float*)(F.ws + WS_MODF) + ((size_t)l * 17 + (s < T_CTX ? 16 : b)) * 6144; }
__device__ __forceinline__ void store_mod_bf16(bf16_t* dst, bf16_t* dlo, const f32x4 (&v)[4], const float* sh, const float* sc, int lane) {
    f32x4 s1v[4], h1v[4];
#pragma unroll
    for (int j = 0; j < 4; ++j) { const int c = 4 * lane + 256 * j; s1v[j] = *(const f32x4*)(sc + c); h1v[j] = *(const f32x4*)(sh + c); }
#pragma unroll
    for (int j = 0; j < 4; ++j) { const int c = 4 * lane + 256 * j; const f32x4 o = v[j] * (1.0f + s1v[j]) + h1v[j];
        u32x2 w; w.x = cvt_pk_bf16(o[0], o[1]); w.y = cvt_pk_bf16(o[2], o[3]); *(u32x2*)(dst + c) = w;
        if (SPLIT_K) { u32x2 l; l.x = cvt_pk_bf16(o[0] - bflo(w.x), o[1] - bfhi(w.x)); l.y = cvt_pk_bf16(o[2] - bflo(w.y), o[3] - bfhi(w.y)); *(u32x2*)(dlo + c) = l; } }
}
__device__ __forceinline__ void phase_h0(Frame& F) {
    bf16_t* H = (bf16_t*)(F.ws + WS_H); const int stride = F.G * 8;
    int row = F.blk * 8 + F.wave; f32x4 vn[4], vm[4];
#define H0_LD(dst, r_) do { if ((r_) < ROWS) { const float* src_ = src_row(F, (r_)); _Pragma("unroll") for (int j = 0; j < 4; ++j) dst[j] = *(const f32x4*)(src_ + 4 * F.lane + 256 * j); } } while (0)
    H0_LD(vn, row); H0_LD(vm, row + stride);
    for (; row < ROWS; row += stride) {
        f32x4 v[4];
#pragma unroll
        for (int j = 0; j < 4; ++j) { v[j] = vn[j]; vn[j] = vm[j]; }
        H0_LD(vm, row + 2 * stride);
        const float* md = mod_row(F, 0, row);
        store_mod_bf16(H + (size_t)row * DM, (bf16_t*)F.out + (size_t)row * DM, v, md, md + 1024, F.lane);
    }
#undef H0_LD
}
__device__ __forceinline__ void ln_row(f32x4 (&v)[4], const float* g, const float* bta, int lane) {
    float s = 0.f;
#pragma unroll
    for (int j = 0; j < 4; ++j) s += (v[j][0] + v[j][1]) + (v[j][2] + v[j][3]);
    const float mean = wave_sum(s) * (1.0f / DM); float q = 0.f;
#pragma unroll
    for (int j = 0; j < 4; ++j) { v[j] = v[j] - mean; q += (v[j][0] * v[j][0] + v[j][1] * v[j][1]) + (v[j][2] * v[j][2] + v[j][3] * v[j][3]); }
    const float rstd = 1.0f / sqrtf(wave_sum(q) * (1.0f / DM) + LN_EPS);
#pragma unroll
    for (int j = 0; j < 4; ++j) { const int c = 4 * lane + 256 * j; v[j] = v[j] * rstd * *(const f32x4*)(g + c) + *(const f32x4*)(bta + c); }
}
__device__ __forceinline__ void ln_row_v(f32x4 (&v)[4], const f32x4 (&gv)[4], const f32x4 (&bv)[4]) {
    float s = 0.f;
#pragma unroll
    for (int j = 0; j < 4; ++j) s += (v[j][0] + v[j][1]) + (v[j][2] + v[j][3]);
    const float mean = wave_sum(s) * (1.0f / DM); float q = 0.f;
#pragma unroll
    for (int j = 0; j < 4; ++j) { v[j] = v[j] - mean; q += (v[j][0] * v[j][0] + v[j][1] * v[j][1]) + (v[j][2] * v[j][2] + v[j][3] * v[j][3]); }
    const float rstd = 1.0f / sqrtf(wave_sum(q) * (1.0f / DM) + LN_EPS);
#pragma unroll
    for (int j = 0; j < 4; ++j) v[j] = v[j] * rstd * gv[j] + bv[j];
}
__device__ __forceinline__ void phase_ln1(Frame& F, int l, bool with_ctx) {
    LAS float* wrt = (LAS float*)F.lds;
    const float* wr = F.inp(I_WROUTER) + (size_t)l * DM * NEXP;
    __syncthreads();
    for (int i = F.tid; i < DM * NEXP; i += 512) { const int k = i >> 4, e = i & 15; wrt[e * DM + k] = wr[i]; }
    __syncthreads();
    float* X = (float*)(F.ws + WS_X); bf16_t* H = (bf16_t*)(F.ws + WS_H); float* AFF = (float*)(F.ws + WS_AFF);
    const float* g = F.inp(I_LN1G) + l * DM; const float* bt = F.inp(I_LN1B) + l * DM;
    const int stride = F.G * 8, nrows = with_ctx ? ROWS : NB * T_LAT; int it = F.blk * 8 + F.wave;
#define LN_ROW(i_) (with_ctx ? (i_) : ((i_) / T_LAT) * T_ALL + T_CTX + ((i_) % T_LAT))
#define LN_LD(dst, i_) do { if ((i_) < nrows) { const float* src_ = X + (size_t)LN_ROW(i_) * DM; _Pragma("unroll") for (int j = 0; j < 4; ++j) dst[j] = *(const f32x4*)(src_ + 4 * F.lane + 256 * j); } } while (0)
    f32x4 vn[4], vm[4];
    LN_LD(vn, it); LN_LD(vm, it + stride);
    for (; it < nrows; it += 2 * stride) {
        const bool hasB = it + stride < nrows;
        const int rowA = LN_ROW(it), rowB = hasB ? LN_ROW(it + stride) : rowA;
        f32x4 vA[4], vB[4];
#pragma unroll
        for (int j = 0; j < 4; ++j) { vA[j] = vn[j]; vB[j] = hasB ? vm[j] : vn[j]; }
        LN_LD(vn, it + 2 * stride); LN_LD(vm, it + 3 * stride);
        ln_row(vA, g, bt, F.lane); ln_row(vB, g, bt, F.lane);
        f32x2 hm2[4][4];
        { float* xa = X + (size_t)rowA * DM; float* xb = X + (size_t)rowB * DM; const float* mda = mod_row(F, l, rowA); const float* mdb = mod_row(F, l, rowB);
          f32x4 sca[4], sha[4], scb[4], shb[4];
#pragma unroll
          for (int j = 0; j < 4; ++j) { const int c = 4 * F.lane + 256 * j; sca[j] = *(const f32x4*)(mda + 4096 + c); sha[j] = *(const f32x4*)(mda + 3072 + c); scb[j] = *(const f32x4*)(mdb + 4096 + c); shb[j] = *(const f32x4*)(mdb + 3072 + c); }
#pragma unroll
          for (int j = 0; j < 4; ++j) { const int c = 4 * F.lane + 256 * j;
              *(f32x4*)(xa + c) = vA[j]; if (hasB) *(f32x4*)(xb + c) = vB[j];
              const f32x4 ha = vA[j] * (1.0f + sca[j]) + sha[j], hb = vB[j] * (1.0f + scb[j]) + shb[j];
              u32x2 w; w.x = cvt_pk_bf16(ha[0], ha[1]); w.y = cvt_pk_bf16(ha[2], ha[3]); *(u32x2*)(H + (size_t)rowA * DM + c) = w;
              if (hasB) { w.x = cvt_pk_bf16(hb[0], hb[1]); w.y = cvt_pk_bf16(hb[2], hb[3]); *(u32x2*)(H + (size_t)rowB * DM + c) = w; }
#pragma unroll
              for (int i2 = 0; i2 < 4; ++i2) hm2[j][i2] = (f32x2){ha[i2], hb[i2]}; } }
        f32x2 pe[NEXP];
        int lz = F.lane; asm volatile("" : "+v"(lz));
#pragma unroll
        for (int e = 0; e < NEXP; ++e) { f32x2 p = (f32x2){0.f, 0.f};
#pragma unroll
            for (int j = 0; j < 4; ++j) { const f32x4 w4 = *(const LAS f32x4*)(wrt + e * DM + 4 * lz + 256 * j);
#pragma unroll
                for (int i2 = 0; i2 < 4; ++i2) p += hm2[j][i2] * w4[i2]; }
            pe[e] = p; }
        float v16[16], v8[8], v4[4], v2[2], lg;
        { const bool h = (F.lane & 32) != 0;
#pragma unroll
          for (int j = 0; j < 16; ++j) { const float send = h ? pe[j].x : pe[j].y, keep = h ? pe[j].y : pe[j].x; v16[j] = keep + __shfl_xor(send, 32); } }
        { const bool h = (F.lane & 16) != 0;
#pragma unroll
          for (int j = 0; j < 8; ++j) { const float send = h ? v16[j] : v16[8 + j], keep = h ? v16[8 + j] : v16[j]; v8[j] = keep + __shfl_xor(send, 16); } }
        { const bool h = (F.lane & 8) != 0;
#pragma unroll
          for (int j = 0; j < 4; ++j) { const float send = h ? v8[j] : v8[4 + j], keep = h ? v8[4 + j] : v8[j]; v4[j] = keep + __shfl_xor(send, 8); } }
        { const bool h = (F.lane & 4) != 0;
#pragma unroll
          for (int j = 0; j < 2; ++j) { const float send = h ? v4[j] : v4[2 + j], keep = h ? v4[2 + j] : v4[j]; v2[j] = keep + __shfl_xor(send, 4); } }
        { const bool h = (F.lane & 2) != 0; const float send = h ? v2[0] : v2[1], keep = h ? v2[1] : v2[0]; lg = keep + __shfl_xor(send, 2); }
        lg += __shfl_xor(lg, 1);
        float mx = lg; mx = fmaxf(mx, __shfl_xor(mx, 2)); mx = fmaxf(mx, __shfl_xor(mx, 4)); mx = fmaxf(mx, __shfl_xor(mx, 8)); mx = fmaxf(mx, __shfl_xor(mx, 16));
        const float ex = expf(lg - mx); float den = ex;
        den += __shfl_xor(den, 2); den += __shfl_xor(den, 4); den += __shfl_xor(den, 8); den += __shfl_xor(den, 16);
        if ((F.lane & 1) == 0 && (F.lane < 32 || hasB)) AFF[(size_t)(F.lane < 32 ? rowA : rowB) * NEXP + ((F.lane >> 1) & 15)] = ex / den;
    }
#undef LN_LD
}

__device__ __forceinline__ void phase_topk(Frame& F, bool with_ctx) {
    LAS unsigned* cnt_sm = (LAS unsigned*)F.lds;
    LAS int* tok_sm = (LAS int*)(F.lds + 1024);
    const float* AFF = (const float*)(F.ws + WS_AFF); short* SLOT = (short*)(F.ws + WS_SLOT); float* GATEE = (float*)(F.ws + WS_GATEE);
    const bf16_t* H = (const bf16_t*)(F.ws + WS_H); bf16_t* XE = (bf16_t*)(F.ws + R_XE);
    const int nun = with_ctx ? 512 : 256;
    for (int un = F.blk; un < nun; un += F.G) {
        const int isc = un >> 8, b = (un >> 4) & 15, e = un & 15;
        const int Tn = isc ? T_CTX : T_LAT, cap = isc ? CAP_C : CAP_L; const int row0 = b * T_ALL + (isc ? 0 : T_CTX);
        unsigned key[4];
#pragma unroll
        for (int i = 0; i < 4; ++i) { const int t = 4 * F.tid + i; key[i] = (t < Tn) ? __builtin_bit_cast(unsigned, AFF[(size_t)(row0 + t) * NEXP + e]) : 0u; }
        unsigned v = 0u;
        for (int bit = 30; bit >= 0; --bit) {
            const unsigned tr = v | (1u << bit);
            int c = (key[0] >= tr) + (key[1] >= tr) + (key[2] >= tr) + (key[3] >= tr);
#pragma unroll
            for (int o = 1; o < 64; o <<= 1) c += __shfl_xor(c, o);
            LAS unsigned* slot = cnt_sm + (bit & 1) * 8;
            if (F.lane == 0) slot[F.wave] = (unsigned)c;
            __syncthreads();
            unsigned tot = 0;
#pragma unroll
            for (int w = 0; w < 8; ++w) tot += slot[w];
            if (tot >= (unsigned)cap) v = tr;
        }
        __syncthreads();
        const int eq = (key[0] == v) + (key[1] == v) + (key[2] == v) + (key[3] == v);
        const int gt = (key[0] > v) + (key[1] > v) + (key[2] > v) + (key[3] > v);
        int incl_eq = eq, incl_gt = gt;
#pragma unroll
        for (int o = 1; o < 64; o <<= 1) { const int a = __shfl_up(incl_eq, o), g2 = __shfl_up(incl_gt, o); if (F.lane >= o) { incl_eq += a; incl_gt += g2; } }
        if (F.lane == 63) { cnt_sm[16 + F.wave] = (unsigned)incl_eq; cnt_sm[24 + F.wave] = (unsigned)incl_gt; }
        __syncthreads();
        int base_eq = 0, base_gt = 0, tot_gt = 0;
#pragma unroll
        for (int w = 0; w < 8; ++w) { const int a = (int)cnt_sm[16 + w], g2 = (int)cnt_sm[24 + w]; if (w < F.wave) { base_eq += a; base_gt += g2; } tot_gt += g2; }
        const int need_eq = cap - tot_gt;
        int eq_before = base_eq + incl_eq - eq, gt_before = base_gt + incl_gt - gt;
#pragma unroll
        for (int i = 0; i < 4; ++i) { const int t = 4 * F.tid + i;
            const bool is_gt = key[i] > v, is_eq = key[i] == v; const bool sel = (t < Tn) && (is_gt || (is_eq && eq_before < need_eq));
            const int slot = gt_before + (eq_before < need_eq ? eq_before : need_eq);
            if (t < Tn) SLOT[(size_t)(row0 + t) * NEXP + e] = sel ? (short)slot : (short)-1;
            if (sel) { tok_sm[slot] = t; GATEE[(size_t)e * EROWS + (isc ? NB * CAP_L + b * CAP_C : b * CAP_L) + slot] = __builtin_bit_cast(float, key[i]); }
            gt_before += is_gt; eq_before += is_eq; }
        __syncthreads();
        const size_t xbase = (size_t)e * EROWS + (isc ? NB * CAP_L + b * CAP_C : b * CAP_L);
        for (int sl = F.wave; sl < cap; sl += 32) {
            u32x4 ra[4], rb[4];
#pragma unroll
            for (int q = 0; q < 4; ++q) { const int t = tok_sm[sl + 8 * q]; const u32x4* src = (const u32x4*)(H + (size_t)(row0 + t) * DM); ra[q] = src[F.lane]; rb[q] = src[64 + F.lane]; }
#pragma unroll
            for (int q = 0; q < 4; ++q) { u32x4* dst = (u32x4*)(XE + (xbase + sl + 8 * q) * DM); dst[F.lane] = ra[q]; dst[64 + F.lane] = rb[q]; } }
        __syncthreads();
    }
}

__device__ __forceinline__ void phase_ln2(Frame& F, int l, bool with_ctx, bool last) {
    float* X = (float*)(F.ws + WS_X); bf16_t* H = (bf16_t*)(F.ws + WS_H); const short* SLOT = (const short*)(F.ws + WS_SLOT); const bf16_t* YE = (const bf16_t*)(F.ws + R_YE);
    const float* g = F.inp(I_LN2G) + l * DM; const float* bt = F.inp(I_LN2B) + l * DM;
    const int stride = F.G * 8, nrows = with_ctx ? ROWS : NB * T_LAT; int it = F.blk * 8 + F.wave;
#define LN2_LD(dst, sl_, i_) do { if ((i_) < nrows) { const int r_ = LN_ROW(i_); sl_ = (F.lane < NEXP) ? (int)SLOT[(size_t)r_ * NEXP + F.lane] : -1; const float* src_ = X + (size_t)r_ * DM; \
        _Pragma("unroll") for (int j = 0; j < 4; ++j) dst[j] = *(const f32x4*)(src_ + 4 * F.lane + 256 * j); } } while (0)
    f32x4 lgv[4], lbv[4];
#pragma unroll
    for (int j = 0; j < 4; ++j) { lgv[j] = *(const f32x4*)(g + 4 * F.lane + 256 * j); lbv[j] = *(const f32x4*)(bt + 4 * F.lane + 256 * j); }
    f32x4 xn[4], xm[4]; int slotn = -1, slotm = -1;
    LN2_LD(xn, slotn, it); LN2_LD(xm, slotm, it + stride);
    for (; it < nrows; it += stride) {
        const int row = LN_ROW(it);
        const int b = row / T_ALL, s = row - b * T_ALL; const bool isc = s < T_CTX;
        const float* md = mod_row(F, l, row);
        f32x4 xc[4]; const int myslot = slotn;
#pragma unroll
        for (int j = 0; j < 4; ++j) { xc[j] = xn[j]; xn[j] = xm[j]; }
        slotn = slotm;
        LN2_LD(xm, slotm, it + 2 * stride);
        f32x4 f[4];
#pragma unroll
        for (int j = 0; j < 4; ++j) f[j] = (f32x4){0.f, 0.f, 0.f, 0.f};
        { unsigned msk = (unsigned)(__builtin_amdgcn_ballot_w64(myslot >= 0) & 0xFFFFull); const size_t ebase = (size_t)(isc ? NB * CAP_L + b * CAP_C : b * CAP_L);
#pragma unroll 1
          while (msk) {
              u32x2 wv[4][4];
#pragma unroll
              for (int k = 0; k < 4; ++k)
#pragma unroll
                  for (int j = 0; j < 4; ++j) wv[k][j] = (u32x2){0u, 0u};
#pragma unroll
              for (int k = 0; k < 4; ++k) { if (msk) { const int e = __builtin_ctz(msk); msk &= msk - 1; const int sl = __builtin_amdgcn_readlane(myslot, e);
                      const bf16_t* yr = YE + ((size_t)e * EROWS + ebase + sl) * DM;
#pragma unroll
                      for (int j = 0; j < 4; ++j) wv[k][j] = *(const u32x2*)(yr + 4 * F.lane + 256 * j); } }
#pragma unroll
              for (int k = 0; k < 4; ++k)
#pragma unroll
                  for (int j = 0; j < 4; ++j) f[j] += (f32x4){bflo(wv[k][j].x), bfhi(wv[k][j].x), bflo(wv[k][j].y), bfhi(wv[k][j].y)}; } }
        f32x4 v[4];
#pragma unroll
        for (int j = 0; j < 4; ++j) { const int c = 4 * F.lane + 256 * j; v[j] = DN_ALPHA * xc[j] + *(const f32x4*)(md + 5120 + c) * f[j]; }
        ln_row_v(v, lgv, lbv);
        if (last) {
            float* o = F.out + ((size_t)b * T_LAT + (s - T_CTX)) * DM;
#pragma unroll
            for (int j = 0; j < 4; ++j) *(f32x4*)(o + 4 * F.lane + 256 * j) = v[j];
        } else {
            const float* md1 = mod_row(F, l + 1, row);
            store_mod_bf16(H + (size_t)row * DM, (bf16_t*)F.out + (size_t)row * DM, v, md1, md1 + 1024, F.lane);
#pragma unroll
            for (int j = 0; j < 4; ++j) *(f32x4*)(X + (size_t)row * DM + 4 * F.lane + 256 * j) = v[j];
        }
    }
#undef LN2_LD
#undef LN_ROW
}
#ifdef PROBE_O1ONLY
#define PROBE_LAM(x) 0.0f
#else
#define PROBE_LAM(x) (x)
#endif
constexpr int AT_KS = 136, AT_VS = 72;
constexpr int AT_KB = 64 * AT_KS * 2, AT_VB = 128 * AT_VS * 2;
constexpr int AT_EX = 0, AT_STG = 65536, AT_SSTR = 132;
__device__ __forceinline__ void attn_unit(Frame& F, const bf16_t* Qb, const bf16_t* Kb, const bf16_t* Vt, bf16_t* Yall, const float* norm_g, float lam, float lam_init,
                                          int b, int h, int qrow0, int krow0, int nkt) {
    const int tid = F.tid, lane = F.lane, wave = F.wave, r32 = lane & 31, hi = lane >> 5, map = wave >> 2, qs = wave & 3;
    LAS unsigned char* lds = F.lds;
    const bf16_t* kg = Kb + (size_t)(krow0 + (tid >> 3)) * 512 + h * 128 + 16 * (tid & 7);
    const bf16_t* vg = Vt + ((size_t)(b * 4 + h) * 128 + (tid >> 2)) * T_ALL + 16 * (tid & 3);
    const int kst = ((tid >> 3) * AT_KS + 16 * (tid & 7)) * 2, vst = ((tid >> 2) * AT_VS + 16 * (tid & 3)) * 2;
    u32x4 kr0, kr1, vr0, vr1;
    kr0 = *(const u32x4*)kg; kr1 = *(const u32x4*)(kg + 8); vr0 = *(const u32x4*)vg; vr1 = *(const u32x4*)(vg + 8);
    bf16x8 qf[4];
    { const bf16_t* qp = Qb + (size_t)(qrow0 + qs * 32 + r32) * 512 + h * 128 + map * 64 + 8 * hi;
#pragma unroll
      for (int ks = 0; ks < 4; ++ks) qf[ks] = *(const bf16x8*)(qp + 16 * ks); }
    *(LAS u32x4*)(lds + kst) = kr0; *(LAS u32x4*)(lds + kst + 16) = kr1;
    *(LAS u32x4*)(lds + 2 * AT_KB + vst) = vr0; *(LAS u32x4*)(lds + 2 * AT_KB + vst + 16) = vr1;
    __syncthreads();
    f32x16 o[4];
#pragma unroll
    for (int d = 0; d < 4; ++d)
#pragma unroll
        for (int r = 0; r < 16; ++r) o[d][r] = 0.f;
    float m_run = -INFINITY, l_run = 0.f;
    f32x16 minit;
#pragma unroll
    for (int r = 0; r < 16; ++r) minit[r] = 0.f;
    const int koff = (r32 * AT_KS + map * 64 + 8 * hi) * 2, voff = (r32 * AT_VS + 8 * hi) * 2;
    for (int kt = 0; kt < nkt; ++kt) {
        const int buf = kt & 1;
        if (kt + 1 < nkt) { const bf16_t* kn = kg + (size_t)(kt + 1) * 64 * 512; const bf16_t* vn = vg + (kt + 1) * 64;
            kr0 = *(const u32x4*)kn; kr1 = *(const u32x4*)(kn + 8); vr0 = *(const u32x4*)vn; vr1 = *(const u32x4*)(vn + 8); }
        LAS unsigned char* kb = lds + buf * AT_KB + koff; LAS unsigned char* vb = lds + 2 * AT_KB + buf * AT_VB + voff;
        const bool first = (kt == 0);
        f32x16 p0, p1;
#pragma unroll
        for (int ks = 0; ks < 4; ++ks) { const bf16x8 ka = *(const LAS bf16x8*)(kb + 32 * ks), kc = *(const LAS bf16x8*)(kb + 32 * AT_KS * 2 + 32 * ks);
            if (ks == 0) { p0 = __builtin_amdgcn_mfma_f32_32x32x16_bf16(ka, qf[0], minit, 0, 0, 0); p1 = __builtin_amdgcn_mfma_f32_32x32x16_bf16(kc, qf[0], minit, 0, 0, 0); }
            else { p0 = __builtin_amdgcn_mfma_f32_32x32x16_bf16(ka, qf[ks], p0, 0, 0, 0); p1 = __builtin_amdgcn_mfma_f32_32x32x16_bf16(kc, qf[ks], p1, 0, 0, 0); } }
        float rm, rm2;
        asm volatile("s_nop 15\n\ts_nop 7\n\tv_max3_f32 %0, %1, %2, %3" : "=v"(rm) : "v"(p0[0]), "v"(p1[0]), "v"(p0[1]));
        asm volatile("v_max3_f32 %0, %1, %2, %3" : "=v"(rm2) : "v"(p1[1]), "v"(p0[2]), "v"(p1[2]));
#pragma unroll
        for (int r = 3; r < 15; r += 2) { asm volatile("v_max3_f32 %0, %0, %1, %2" : "+v"(rm) : "v"(p0[r]), "v"(p0[r + 1])); asm volatile("v_max3_f32 %0, %0, %1, %2" : "+v"(rm2) : "v"(p1[r]), "v"(p1[r + 1])); }
        asm volatile("v_max3_f32 %0, %0, %1, %2" : "+v"(rm) : "v"(p0[15]), "v"(p1[15]));
        asm volatile("v_max_f32 %0, %0, %1" : "+v"(rm) : "v"(rm2));
        rm = xhalf_max(rm);
        if (first || __builtin_amdgcn_ballot_w64(rm > 12.0f) != 0ull) {
            const float shift = first ? rm : fmaxf(rm, 0.f), alpha = first ? 0.f : fast_exp2(-shift);
            l_run *= alpha; m_run = (first ? 0.f : m_run) + shift;
#pragma unroll
            for (int d = 0; d < 4; ++d)
#pragma unroll
                for (int r = 0; r < 16; ++r) o[d][r] *= alpha;
#pragma unroll
            for (int r = 0; r < 16; ++r) { p0[r] -= shift; p1[r] -= shift; minit[r] = -m_run; }
        }
        float ls = 0.f;
#pragma unroll
        for (int r = 0; r < 16; ++r) { p0[r] = fast_exp2(p0[r]); p1[r] = fast_exp2(p1[r]); ls += p0[r] + p1[r]; }
        l_run += ls;
        u32x4 pw[4];
#pragma unroll
        for (int s2 = 0; s2 < 2; ++s2) {
            pw[s2] = (u32x4){cvt_pk_bf16(p0[8 * s2 + 0], p0[8 * s2 + 1]), cvt_pk_bf16(p0[8 * s2 + 2], p0[8 * s2 + 3]), cvt_pk_bf16(p0[8 * s2 + 4], p0[8 * s2 + 5]), cvt_pk_bf16(p0[8 * s2 + 6], p0[8 * s2 + 7])};
            pw[2 + s2] = (u32x4){cvt_pk_bf16(p1[8 * s2 + 0], p1[8 * s2 + 1]), cvt_pk_bf16(p1[8 * s2 + 2], p1[8 * s2 + 3]), cvt_pk_bf16(p1[8 * s2 + 4], p1[8 * s2 + 5]), cvt_pk_bf16(p1[8 * s2 + 6], p1[8 * s2 + 7])}; }
#pragma unroll
        for (int d = 0; d < 4; ++d)
#pragma unroll
            for (int s = 0; s < 4; ++s) { const bf16x8 va = *(const LAS bf16x8*)(vb + d * 32 * AT_VS * 2 + 32 * s);
                o[d] = __builtin_amdgcn_mfma_f32_32x32x16_bf16(va, __builtin_bit_cast(bf16x8, pw[s]), o[d], 0, 0, 0); }
        if (kt + 1 < nkt) { const int nb = buf ^ 1;
            *(LAS u32x4*)(lds + nb * AT_KB + kst) = kr0; *(LAS u32x4*)(lds + nb * AT_KB + kst + 16) = kr1;
            *(LAS u32x4*)(lds + 2 * AT_KB + nb * AT_VB + vst) = vr0; *(LAS u32x4*)(lds + 2 * AT_KB + nb * AT_VB + vst + 16) = vr1; }
        __syncthreads();
    }
    { const float inv = 1.0f / xhalf_sum(l_run);
#pragma unroll
      for (int d = 0; d < 4; ++d)
#pragma unroll
          for (int r = 0; r < 16; ++r) o[d][r] *= inv; }
    LAS float* ex = (LAS float*)(lds + AT_EX);
    if (map == 1) {
#pragma unroll
        for (int d = 0; d < 4; ++d)
#pragma unroll
            for (int r = 0; r < 16; ++r) ex[((qs * 64) + d * 16 + r) * 64 + lane] = o[d][r];
    }
    __syncthreads();
    if (map == 0) {
        float ss = 0.f;
#pragma unroll
        for (int d = 0; d < 4; ++d)
#pragma unroll
            for (int r = 0; r < 16; ++r) { const float v = o[d][r] - PROBE_LAM(lam) * ex[((qs * 64) + d * 16 + r) * 64 + lane]; o[d][r] = v; ss += v * v; }
        ss = xhalf_sum(ss);
        float sc = (1.0f / sqrtf(ss * (1.0f / 128.0f) + DA_EPS)) * (1.0f - lam_init);
#ifdef PROBE_O1ONLY
        sc = 16.0f;
#endif
        LAS bf16_t* stg = (LAS bf16_t*)(lds + AT_STG) + qs * 32 * AT_SSTR;
#pragma unroll
        for (int d = 0; d < 4; ++d)
#pragma unroll
            for (int g4 = 0; g4 < 4; ++g4) { const int dim = 32 * d + 8 * g4 + 4 * hi; const f32x4 ng = *(const f32x4*)(norm_g + dim);
                u32x2 w; w.x = cvt_pk_bf16(o[d][4 * g4] * sc * ng[0], o[d][4 * g4 + 1] * sc * ng[1]); w.y = cvt_pk_bf16(o[d][4 * g4 + 2] * sc * ng[2], o[d][4 * g4 + 3] * sc * ng[3]);
                *(LAS u32x2*)(stg + r32 * AT_SSTR + dim) = w; }
        LDS_WAIT();
#pragma unroll
        for (int it = 0; it < 8; ++it) { const int row = it * 4 + (lane >> 4), ch = lane & 15;
            const u32x2 a = *(const LAS u32x2*)(stg + row * AT_SSTR + ch * 8), c = *(const LAS u32x2*)(stg + row * AT_SSTR + ch * 8 + 4);
            *(u32x4*)(Yall + (size_t)(qrow0 + qs * 32 + row) * MIXW + h * 128 + ch * 8) = (u32x4){a.x, a.y, c.x, c.y}; }
    }
    __syncthreads();
}
__device__ __forceinline__ void phase_attn(Frame& F, int l, bool with_ctx) {
    const bf16_t* Qb = (const bf16_t*)(F.ws + R_Q); const bf16_t* Kb = (const bf16_t*)(F.ws + R_K); const bf16_t* Vt = (const bf16_t*)(F.ws + R_VT); bf16_t* Yall = (bf16_t*)F.out;
    const float* sc = (const float*)(F.ws + WS_SMALL + 16384); const float lam = sc[2 * l], lam_init = sc[2 * l + 1];
    const float* ng = F.inp(I_DANG) + l * 128;
    const int nun = 1024 + (with_ctx ? 128 : 0);
    for (int un = F.blk; un < nun; un += F.G) {
        if (un < 1024) {
            int uq = un;
            if (F.G == 256) { const int x8 = F.blk & 7, j32 = F.blk >> 3; uq = (un - F.blk) + ((x8 * 2 + (j32 >> 4)) << 4) + (j32 & 15); }
            const int b = uq >> 6, h = (uq >> 4) & 3, qb = uq & 15;
#ifdef PROBE_SKIPCTX_L1
            if (l == 1) attn_unit(F, Qb, Kb, Vt + T_CTX, Yall, ng, lam, lam_init, b, h, b * T_ALL + T_CTX + qb * 128, b * T_ALL + T_CTX, 32); else
#endif
            attn_unit(F, Qb, Kb, Vt, Yall, ng, lam, lam_init, b, h, b * T_ALL + T_CTX + qb * 128, b * T_ALL, 36);
        } else { const int u2 = un - 1024; const int b = u2 >> 3, h = (u2 >> 1) & 3, qb = u2 & 1;
            attn_unit(F, Qb, Kb, Vt, Yall, ng, lam, lam_init, b, h, b * T_ALL + qb * 128, b * T_ALL, 4); }
    }
}

constexpr int RW_CH = 32;
constexpr int RWL_FEAT = 0, RWL_XW = 49152, RWL_XA = 57856, RWL_PW = 66560, RWL_PA = 74752, RWL_YB = 82944;
__device__ __forceinline__ f32x4 ld_bf4(const bf16_t* p) { const u32x2 w = *(const u32x2*)p; return (f32x4){bflo(w.x), bfhi(w.x), bflo(w.y), bfhi(w.y)}; }
__device__ __forceinline__ f32x4 shift4(const bf16_t* cur, bool hp, bool hn, const float* mu0, const float* mu1) {
    const f32x4 p = ld_bf4(cur); const f32x4 pv = hp ? ld_bf4(cur - RW_COLS) : (f32x4){0.f, 0.f, 0.f, 0.f}; const f32x4 nx = hn ? ld_bf4(cur + RW_COLS) : (f32x4){0.f, 0.f, 0.f, 0.f};
    return p + *(const f32x4*)mu0 * (pv - p) + *(const f32x4*)mu1 * (nx - p);
}
__device__ __forceinline__ void rwkv_scan_unit(Frame& F, int l, int b, int hd, int z, bool emit_ctx) {
    const int tid = F.tid, lane = F.lane, wave = F.wave;
    LAS float* FEAT = (LAS float*)(F.lds + RWL_FEAT); LAS float* XW = (LAS float*)(F.lds + RWL_XW); LAS float* XA = (LAS float*)(F.lds + RWL_XA);
    LAS float* PW = (LAS float*)(F.lds + RWL_PW); LAS float* PA = (LAS float*)(F.lds + RWL_PA); LAS float* YB = (LAS float*)(F.lds + RWL_YB);
    const bf16_t* PRW = (const bf16_t*)(F.ws + R_PRW); const bf16_t* KLO = (const bf16_t*)(F.ws + R_KLO); float* Y = (float*)(F.ws + R_YFB) + (size_t)z * ROWS * 512; float* BON = (float*)(F.ws + WS_BONUS) + (size_t)z * ROWS * 8;
    const float* mu = F.inp(I_RWMU) + (size_t)l * 2 * RW_COLS; const float* mu0 = mu, *mu1 = mu + RW_COLS;
    const float* w0 = F.inp(I_RWW0) + ((size_t)l * 2 + z) * 512 + hd * 64; const float* a0 = F.inp(I_RWA0) + ((size_t)l * 2 + z) * 512 + hd * 64;
    const float* w2 = F.inp(I_RWW2) + ((size_t)l * 2 + z) * 64 * 512; const float* a2 = F.inp(I_RWA2) + ((size_t)l * 2 + z) * 64 * 512;
    const float* k_k = F.inp(I_RWKK) + l * 512 + hd * 64; const float* k_a = F.inp(I_RWKA) + l * 512 + hd * 64; const float* r_k = F.inp(I_RWRK) + l * 512 + hd * 64;
    float breg[16];
    { const float* src = (wave < 4 ? w2 : a2) + hd * 64 + 16 * (wave & 3) + (lane & 15);
#pragma unroll
      for (int ks = 0; ks < 16; ++ks) breg[ks] = src[(size_t)(4 * ks + (lane >> 4)) * 512]; }
    const int tt = tid >> 4, jq = tid & 15, j4 = 4 * jq;
    const f32x4 w0c = *(const f32x4*)(w0 + j4), a0c = *(const f32x4*)(a0 + j4), kkc = *(const f32x4*)(k_k + j4), kac = *(const f32x4*)(k_a + j4), rkc = *(const f32x4*)(r_k + j4);
    f32x4 S0 = (f32x4){0.f, 0.f, 0.f, 0.f}, S1 = S0;
    u32x2 raw[5][3];
#define RW_CHUNK_GEOM(ci_) const bool isc_ = (ci_) < 8; const int cc_ = isc_ ? (z ? 7 - (ci_) : (ci_)) : (z ? 63 - ((ci_) - 8) : ((ci_) - 8)); \
        const int len_ = isc_ ? T_CTX : T_LAT; const int rb_ = b * T_ALL + (isc_ ? 0 : T_CTX); const int t_ = cc_ * RW_CH + tt;
#define RW_LOADRAW(ci_) do { RW_CHUNK_GEOM(ci_) const int tp_ = t_ > 0 ? t_ - 1 : t_, tn_ = t_ < len_ - 1 ? t_ + 1 : t_; \
        const bf16_t* pc_ = PRW + (size_t)(rb_ + t_) * RW_COLS; const bf16_t* pp_ = PRW + (size_t)(rb_ + tp_) * RW_COLS; const bf16_t* pn_ = PRW + (size_t)(rb_ + tn_) * RW_COLS; \
        const int cg_[5] = {hd * 64 + j4, 512 + hd * 64 + j4, 1024 + hd * 64 + j4, 1536 + j4, 1600 + j4}; \
        _Pragma("unroll") for (int g_ = 0; g_ < 5; ++g_) { raw[g_][0] = *(const u32x2*)(pp_ + cg_[g_]); raw[g_][1] = *(const u32x2*)(pc_ + cg_[g_]); raw[g_][2] = *(const u32x2*)(pn_ + cg_[g_]); } } while (0)
    RW_LOADRAW(0);
    for (int ci = 0; ci < 72; ++ci) {
        const bool isc = ci < 8; const int cc = isc ? (z ? 7 - ci : ci) : (z ? 63 - (ci - 8) : (ci - 8));
        const int len = isc ? T_CTX : T_LAT; const int rb = b * T_ALL + (isc ? 0 : T_CTX); const int t0 = cc * RW_CH;
        const int t = t0 + tt; const float fp = t > 0 ? 1.f : 0.f, fn = t < len - 1 ? 1.f : 0.f;
        f32x4 sh[5];
        { const int cg[5] = {hd * 64 + j4, 512 + hd * 64 + j4, 1024 + hd * 64 + j4, 1536 + j4, 1600 + j4};
#pragma unroll
          for (int g = 0; g < 5; ++g) { const f32x4 pv = (f32x4){bflo(raw[g][0].x), bfhi(raw[g][0].x), bflo(raw[g][0].y), bfhi(raw[g][0].y)} * fp;
              const f32x4 p = (f32x4){bflo(raw[g][1].x), bfhi(raw[g][1].x), bflo(raw[g][1].y), bfhi(raw[g][1].y)};
              const f32x4 nx = (f32x4){bflo(raw[g][2].x), bfhi(raw[g][2].x), bflo(raw[g][2].y), bfhi(raw[g][2].y)} * fn;
              sh[g] = p + *(const f32x4*)(mu0 + cg[g]) * (pv - p) + *(const f32x4*)(mu1 + cg[g]) * (nx - p); } }
        const f32x4 r4 = sh[0], k4 = sh[1], v4 = sh[2];
        *(LAS f32x4*)(XW + tt * 68 + j4) = (f32x4){tanhf_(sh[3][0]), tanhf_(sh[3][1]), tanhf_(sh[3][2]), tanhf_(sh[3][3])}; *(LAS f32x4*)(XA + tt * 68 + j4) = sh[4];
        if (ci + 1 < 72) RW_LOADRAW(ci + 1);
        __syncthreads();
        { const LAS float* Xs = (wave < 4) ? XW : XA; LAS float* Ps = (wave < 4) ? PW : PA;
#pragma unroll
          for (int mt = 0; mt < 2; ++mt) { f32x4 acc = (f32x4){0.f, 0.f, 0.f, 0.f}, acc2 = acc;
#pragma unroll
              for (int ks = 0; ks < 16; ks += 2) { acc = __builtin_amdgcn_mfma_f32_16x16x4f32(Xs[(mt * 16 + (lane & 15)) * 68 + 4 * ks + (lane >> 4)], breg[ks], acc, 0, 0, 0);
                  acc2 = __builtin_amdgcn_mfma_f32_16x16x4f32(Xs[(mt * 16 + (lane & 15)) * 68 + 4 * (ks + 1) + (lane >> 4)], breg[ks + 1], acc2, 0, 0, 0); }
              acc += acc2;
#pragma unroll
              for (int rg = 0; rg < 4; ++rg) Ps[(mt * 16 + 4 * (lane >> 4) + rg) * 64 + 16 * (wave & 3) + (lane & 15)] = acc[rg]; } }
        __syncthreads();
        { const f32x4 pw = *(const LAS f32x4*)(PW + tt * 64 + j4) + w0c, pa = *(const LAS f32x4*)(PA + tt * 64 + j4) + a0c;
          f32x4 dec, av, kkr, kd, bb; float ss = 0.f, bo = 0.f;
#pragma unroll
          for (int i = 0; i < 4; ++i) { dec[i] = __expf(-0.6065306597126334f * sigmoidf_(pw[i])); av[i] = sigmoidf_(pa[i]); kkr[i] = k4[i] * kkc[i]; ss += kkr[i] * kkr[i];
              kd[i] = k4[i] * (1.0f + (av[i] - 1.0f) * kac[i]); bo += r4[i] * kd[i] * rkc[i]; }
          ss = sum16(ss); bo = sum16(bo);
          const float inv = 1.0f / fmaxf(sqrtf(ss), 1e-12f);
#pragma unroll
          for (int i = 0; i < 4; ++i) { kkr[i] *= inv; bb[i] = kkr[i] * av[i]; }
          *(LAS f32x4*)(FEAT + (0 * 32 + tt) * 64 + j4) = kkr; *(LAS f32x4*)(FEAT + (1 * 32 + tt) * 64 + j4) = dec; *(LAS f32x4*)(FEAT + (2 * 32 + tt) * 64 + j4) = bb;
          *(LAS f32x4*)(FEAT + (3 * 32 + tt) * 64 + j4) = kd; *(LAS f32x4*)(FEAT + (4 * 32 + tt) * 64 + j4) = r4; *(LAS f32x4*)(FEAT + (5 * 32 + tt) * 64 + j4) = v4;
          if (jq == 0) BON[(size_t)(rb + t) * 8 + hd] = bo; }
        __syncthreads();
        { const int ri = tid >> 3, c8 = 8 * (tid & 7);
#define RW_LOADF(ts_) kkA = *(const LAS f32x4*)(FEAT + (0 * 32 + (ts_)) * 64 + c8); kkB = *(const LAS f32x4*)(FEAT + (0 * 32 + (ts_)) * 64 + c8 + 4); \
          wdA = *(const LAS f32x4*)(FEAT + (1 * 32 + (ts_)) * 64 + c8); wdB = *(const LAS f32x4*)(FEAT + (1 * 32 + (ts_)) * 64 + c8 + 4); \
          bbA = *(const LAS f32x4*)(FEAT + (2 * 32 + (ts_)) * 64 + c8); bbB = *(const LAS f32x4*)(FEAT + (2 * 32 + (ts_)) * 64 + c8 + 4); \
          kdA = *(const LAS f32x4*)(FEAT + (3 * 32 + (ts_)) * 64 + c8); kdB = *(const LAS f32x4*)(FEAT + (3 * 32 + (ts_)) * 64 + c8 + 4); \
          rrA = *(const LAS f32x4*)(FEAT + (4 * 32 + (ts_)) * 64 + c8); rrB = *(const LAS f32x4*)(FEAT + (4 * 32 + (ts_)) * 64 + c8 + 4); vv = FEAT[(5 * 32 + (ts_)) * 64 + ri];
          f32x4 kkA, kkB, wdA, wdB, bbA, bbB, kdA, kdB, rrA, rrB; float vv;
#ifdef PROBE_REPLOOP
          const f32x4 S0s = S0, S1s = S1;
#pragma unroll 1
          for (int rep2 = 0; rep2 < 2; ++rep2) { S0 = S0s; S1 = S1s;
#endif
          { const int ts0 = z ? (RW_CH - 1) : 0; RW_LOADF(ts0) }
#pragma unroll 2
          for (int st = 0; st < RW_CH; ++st) { const int ts = z ? (RW_CH - 1 - st) : st; const int tn = (st + 1 < RW_CH) ? (z ? ts - 1 : ts + 1) : ts;
            const f32x4 ckA = kkA, ckB = kkB, cwA = wdA, cwB = wdB, cbA = bbA, cbB = bbB, cdA = kdA, cdB = kdB, crA = rrA, crB = rrB; const float cv = vv;
            RW_LOADF(tn)
            float sa = -(((S0[0] * ckA[0] + S0[1] * ckA[1]) + (S0[2] * ckA[2] + S0[3] * ckA[3])) + ((S1[0] * ckB[0] + S1[1] * ckB[1]) + (S1[2] * ckB[2] + S1[3] * ckB[3])));
            sa = sum8(sa);
            S0 = S0 * cwA + sa * cbA + cv * cdA; S1 = S1 * cwB + sa * cbB + cv * cdB;
            float y = ((S0[0] * crA[0] + S0[1] * crA[1]) + (S0[2] * crA[2] + S0[3] * crA[3])) + ((S1[0] * crB[0] + S1[1] * crB[1]) + (S1[2] * crB[2] + S1[3] * crB[3]));
            y = sum8(y);
            if ((tid & 7) == 0) YB[ts * 64 + ri] = y; }
#ifdef PROBE_REPLOOP
          }
#endif
#undef RW_LOADF
        }
        __syncthreads();
        if (!isc || emit_ctx) *(f32x4*)(Y + (size_t)(rb + t) * 512 + hd * 64 + j4) = *(const LAS f32x4*)(YB + tt * 64 + j4);
    }
    __syncthreads();
}

constexpr int RW2_FEAT = 0  , RW2_XW = 98304, RW2_XA = 107008, RW2_PW = 115712, RW2_PA = 123904, RW2_YB = 132096  , RW2_CT = 148480  ;
__device__ __forceinline__ void rwkv_scan_unit2(Frame& F, int l, int b, int hd, int z, bool emit_ctx) {
    const int tid = F.tid, wave = F.wave;
    LAS float* FEAT0 = (LAS float*)(F.lds + RW2_FEAT); LAS float* XW = (LAS float*)(F.lds + RW2_XW); LAS float* XA = (LAS float*)(F.lds + RW2_XA);
    LAS float* PW = (LAS float*)(F.lds + RW2_PW); LAS float* PA = (LAS float*)(F.lds + RW2_PA); LAS float* YB0 = (LAS float*)(F.lds + RW2_YB);
    const bf16_t* PRW = (const bf16_t*)(F.ws + R_PRW); float* Y = (float*)(F.ws + R_YFB) + (size_t)z * ROWS * 512; float* BON = (float*)(F.ws + WS_BONUS) + (size_t)z * ROWS * 8;
#define RW2_GEOM(ci_, cc_, len_, rb_) const bool isc_##cc_ = (ci_) < 8; const int cc_ = isc_##cc_ ? (z ? 7 - (ci_) : (ci_)) : (z ? 63 - ((ci_) - 8) : ((ci_) - 8)); \
        const int len_ = isc_##cc_ ? T_CTX : T_LAT; const int rb_ = b * T_ALL + (isc_##cc_ ? 0 : T_CTX);
    if (wave < 4) {
        const int cg8 = 8 * (tid & 7), ri0 = tid >> 3, ri1 = ri0 + 32;
        f32x4 A0 = (f32x4){0.f, 0.f, 0.f, 0.f}, B0 = A0, A1 = A0, B1 = A0;
        __syncthreads(); __syncthreads(); __syncthreads();
        for (int ci = 0; ci < 72; ++ci) {
            const LAS float* FT = FEAT0 + (ci & 1) * 12288; LAS float* YB = YB0 + (ci & 1) * 2048;
#define RW2_LD(ts_) kkA = *(const LAS f32x4*)(FT + (0 * 32 + (ts_)) * 64 + cg8); kkB = *(const LAS f32x4*)(FT + (0 * 32 + (ts_)) * 64 + cg8 + 4); \
            wdA = *(const LAS f32x4*)(FT + (1 * 32 + (ts_)) * 64 + cg8); wdB = *(const LAS f32x4*)(FT + (1 * 32 + (ts_)) * 64 + cg8 + 4); \
            bbA = *(const LAS f32x4*)(FT + (2 * 32 + (ts_)) * 64 + cg8); bbB = *(const LAS f32x4*)(FT + (2 * 32 + (ts_)) * 64 + cg8 + 4); \
            kdA = *(const LAS f32x4*)(FT + (3 * 32 + (ts_)) * 64 + cg8); kdB = *(const LAS f32x4*)(FT + (3 * 32 + (ts_)) * 64 + cg8 + 4); \
            rrA = *(const LAS f32x4*)(FT + (4 * 32 + (ts_)) * 64 + cg8); rrB = *(const LAS f32x4*)(FT + (4 * 32 + (ts_)) * 64 + cg8 + 4); v0 = FT[(5 * 32 + (ts_)) * 64 + ri0]; v1 = FT[(5 * 32 + (ts_)) * 64 + ri1];
            f32x4 kkA, kkB, wdA, wdB, bbA, bbB, kdA, kdB, rrA, rrB; float v0, v1;
            { const int ts0 = z ? (RW_CH - 1) : 0; RW2_LD(ts0) }
#pragma unroll 1
            for (int seg = 0; seg < 3; ++seg) {
                const int s_lo = seg == 0 ? 0 : (seg == 1 ? 11 : 22), s_hi = seg == 0 ? 11 : (seg == 1 ? 22 : RW_CH);
#pragma unroll 2
                for (int st = s_lo; st < s_hi; ++st) { const int ts = z ? (RW_CH - 1 - st) : st; const int tn = (st + 1 < RW_CH) ? (z ? ts - 1 : ts + 1) : ts;
                    const f32x4 ckA = kkA, ckB = kkB, cwA = wdA, cwB = wdB, cbA = bbA, cbB = bbB, cdA = kdA, cdB = kdB, crA = rrA, crB = rrB; const float cv0 = v0, cv1 = v1;
                    RW2_LD(tn)
                    float sa0 = -(((A0[0] * ckA[0] + A0[1] * ckA[1]) + (A0[2] * ckA[2] + A0[3] * ckA[3])) + ((B0[0] * ckB[0] + B0[1] * ckB[1]) + (B0[2] * ckB[2] + B0[3] * ckB[3])));
                    float sa1 = -(((A1[0] * ckA[0] + A1[1] * ckA[1]) + (A1[2] * ckA[2] + A1[3] * ckA[3])) + ((B1[0] * ckB[0] + B1[1] * ckB[1]) + (B1[2] * ckB[2] + B1[3] * ckB[3])));
                    sa0 = sum8(sa0); sa1 = sum8(sa1);
                    A0 = A0 * cwA + sa0 * cbA + cv0 * cdA; B0 = B0 * cwB + sa0 * cbB + cv0 * cdB; A1 = A1 * cwA + sa1 * cbA + cv1 * cdA; B1 = B1 * cwB + sa1 * cbB + cv1 * cdB;
                    float y0 = ((A0[0] * crA[0] + A0[1] * crA[1]) + (A0[2] * crA[2] + A0[3] * crA[3])) + ((B0[0] * crB[0] + B0[1] * crB[1]) + (B0[2] * crB[2] + B0[3] * crB[3]));
                    float y1 = ((A1[0] * crA[0] + A1[1] * crA[1]) + (A1[2] * crA[2] + A1[3] * crA[3])) + ((B1[0] * crB[0] + B1[1] * crB[1]) + (B1[2] * crB[2] + B1[3] * crB[3]));
                    y0 = sum8(y0); y1 = sum8(y1);
                    if ((tid & 7) == 0) { YB[ts * 64 + ri0] = y0; YB[ts * 64 + ri1] = y1; } }
                __syncthreads();
            }
#undef RW2_LD
        }
        __syncthreads();
    } else {
        int tzp = tid; asm volatile("" : "+v"(tzp));
        const int p = tzp - 256, tt = p >> 3, j8 = 8 * (p & 7), pw = wave - 4; const int lane = tzp & 63;
        const float* mu = F.inp(I_RWMU) + (size_t)l * 2 * RW_COLS; const float* mu0 = mu, *mu1 = mu + RW_COLS;
        const float* w0 = F.inp(I_RWW0) + ((size_t)l * 2 + z) * 512 + hd * 64; const float* a0 = F.inp(I_RWA0) + ((size_t)l * 2 + z) * 512 + hd * 64;
        const float* w2 = F.inp(I_RWW2) + ((size_t)l * 2 + z) * 64 * 512; const float* a2 = F.inp(I_RWA2) + ((size_t)l * 2 + z) * 64 * 512;
        const float* k_k = F.inp(I_RWKK) + l * 512 + hd * 64; const float* k_a = F.inp(I_RWKA) + l * 512 + hd * 64; const float* r_k = F.inp(I_RWRK) + l * 512 + hd * 64;
        float breg[2][16];
        { const float* src = (pw < 2 ? w2 : a2) + hd * 64 + 32 * (pw & 1) + (lane & 15) + (size_t)(lane >> 4) * 512;
#pragma unroll
          for (int ks = 0; ks < 16; ++ks) { breg[0][ks] = src[0]; breg[1][ks] = src[16]; src += 4 * 512; asm volatile("" : "+v"(src)); } }
        LAS float* CT = (LAS float*)(F.lds + RW2_CT);
        if (p < 64) { CT[p] = w0[p]; CT[64 + p] = a0[p]; CT[128 + p] = k_k[p]; CT[192 + p] = k_a[p]; CT[256 + p] = r_k[p]; }
        u32x4 raw[5][3];
#define RW2_LOADRAW(ci_) do { RW2_GEOM(ci_, ccL, lenL, rbL) const int tL = ccL * RW_CH + tt; const int tpL = tL > 0 ? tL - 1 : tL, tnL = tL < lenL - 1 ? tL + 1 : tL; \
            const bf16_t* pcL = PRW + (size_t)(rbL + tL) * RW_COLS; const bf16_t* ppL = PRW + (size_t)(rbL + tpL) * RW_COLS; const bf16_t* pnL = PRW + (size_t)(rbL + tnL) * RW_COLS; \
            const int cgL[5] = {hd * 64 + j8, 512 + hd * 64 + j8, 1024 + hd * 64 + j8, 1536 + j8, 1600 + j8}; \
            _Pragma("unroll") for (int g_ = 0; g_ < 5; ++g_) { raw[g_][0] = *(const u32x4*)(ppL + cgL[g_]); raw[g_][1] = *(const u32x4*)(pcL + cgL[g_]); raw[g_][2] = *(const u32x4*)(pnL + cgL[g_]); } } while (0)
        RW2_LOADRAW(0);
        for (int ci = -1; ci < 72; ++ci) {
            const int cn = ci + 1;
            if (ci >= 1) { const int cp = ci - 1; RW2_GEOM(cp, ccP, lenP, rbP) (void)lenP;
                if (!isc_ccP || emit_ctx) { const LAS float* YBp = YB0 + (cp & 1) * 2048;
#pragma unroll
                    for (int h2 = 0; h2 < 2; ++h2) *(f32x4*)(Y + (size_t)(rbP + ccP * RW_CH + tt) * 512 + hd * 64 + j8 + 4 * h2) = *(const LAS f32x4*)(YBp + tt * 64 + j8 + 4 * h2); } }
            f32x4 r8[2], k8[2], v8[2]; int rbN = 0, tN = 0;
            if (cn < 72) {
                RW2_GEOM(cn, ccN, lenN, rbN_) rbN = rbN_; tN = ccN * RW_CH + tt; const float fp = tN > 0 ? 1.f : 0.f, fn = tN < lenN - 1 ? 1.f : 0.f;
                const int cg[5] = {hd * 64 + j8, 512 + hd * 64 + j8, 1024 + hd * 64 + j8, 1536 + j8, 1600 + j8};
                f32x4 sh[5][2];
#pragma unroll
                for (int g = 0; g < 5; ++g)
#pragma unroll
                    for (int h2 = 0; h2 < 2; ++h2) { const unsigned pa_ = h2 ? raw[g][0].z : raw[g][0].x, pb_ = h2 ? raw[g][0].w : raw[g][0].y, ca_ = h2 ? raw[g][1].z : raw[g][1].x, cb_ = h2 ? raw[g][1].w : raw[g][1].y, na_ = h2 ? raw[g][2].z : raw[g][2].x, nb_ = h2 ? raw[g][2].w : raw[g][2].y;
                        const f32x4 pv = (f32x4){bflo(pa_), bfhi(pa_), bflo(pb_), bfhi(pb_)} * fp, pc = (f32x4){bflo(ca_), bfhi(ca_), bflo(cb_), bfhi(cb_)}, nx = (f32x4){bflo(na_), bfhi(na_), bflo(nb_), bfhi(nb_)} * fn;
                        sh[g][h2] = pc + *(const f32x4*)(mu0 + cg[g] + 4 * h2) * (pv - pc) + *(const f32x4*)(mu1 + cg[g] + 4 * h2) * (nx - pc); }
#pragma unroll
                for (int h2 = 0; h2 < 2; ++h2) { r8[h2] = sh[0][h2]; k8[h2] = sh[1][h2]; v8[h2] = sh[2][h2];
                    *(LAS f32x4*)(XW + tt * 68 + j8 + 4 * h2) = (f32x4){tanhf_(sh[3][h2][0]), tanhf_(sh[3][h2][1]), tanhf_(sh[3][h2][2]), tanhf_(sh[3][h2][3])}; *(LAS f32x4*)(XA + tt * 68 + j8 + 4 * h2) = sh[4][h2]; }
                if (cn + 1 < 72) RW2_LOADRAW(cn + 1);
            }
            __syncthreads();
            if (cn < 72) { const LAS float* Xs = (pw < 2) ? XW : XA; LAS float* Ps = (pw < 2) ? PW : PA;
#pragma unroll
                for (int n = 0; n < 2; ++n)
#pragma unroll
                    for (int mt = 0; mt < 2; ++mt) { f32x4 acc = (f32x4){0.f, 0.f, 0.f, 0.f}, acc2 = acc;
#pragma unroll
                        for (int ks = 0; ks < 16; ks += 2) { acc = __builtin_amdgcn_mfma_f32_16x16x4f32(Xs[(mt * 16 + (lane & 15)) * 68 + 4 * ks + (lane >> 4)], breg[n][ks], acc, 0, 0, 0);
                            acc2 = __builtin_amdgcn_mfma_f32_16x16x4f32(Xs[(mt * 16 + (lane & 15)) * 68 + 4 * (ks + 1) + (lane >> 4)], breg[n][ks + 1], acc2, 0, 0, 0); }
                        acc += acc2;
#pragma unroll
                        for (int rg = 0; rg < 4; ++rg) Ps[(mt * 16 + 4 * (lane >> 4) + rg) * 64 + 32 * (pw & 1) + 16 * n + (lane & 15)] = acc[rg]; } }
            __syncthreads();
            if (cn < 72) { LAS float* FT = FEAT0 + (cn & 1) * 12288;
                f32x4 dec[2], av[2], kkr[2], kd[2], bb[2]; float ss = 0.f, bo = 0.f;
#pragma unroll
                for (int h2 = 0; h2 < 2; ++h2) { const f32x4 pwv = *(const LAS f32x4*)(PW + tt * 64 + j8 + 4 * h2) + *(const LAS f32x4*)(CT + j8 + 4 * h2), pav = *(const LAS f32x4*)(PA + tt * 64 + j8 + 4 * h2) + *(const LAS f32x4*)(CT + 64 + j8 + 4 * h2);
                    const f32x4 kkc_ = *(const LAS f32x4*)(CT + 128 + j8 + 4 * h2), kac_ = *(const LAS f32x4*)(CT + 192 + j8 + 4 * h2), rkc_ = *(const LAS f32x4*)(CT + 256 + j8 + 4 * h2);
#pragma unroll
                    for (int i = 0; i < 4; ++i) { dec[h2][i] = __expf(-0.6065306597126334f * sigmoidf_(pwv[i])); av[h2][i] = sigmoidf_(pav[i]); kkr[h2][i] = k8[h2][i] * kkc_[i]; ss += kkr[h2][i] * kkr[h2][i];
                        kd[h2][i] = k8[h2][i] * (1.0f + (av[h2][i] - 1.0f) * kac_[i]); bo += r8[h2][i] * kd[h2][i] * rkc_[i]; } }
                ss = sum8(ss); bo = sum8(bo);
                const float inv = 1.0f / fmaxf(sqrtf(ss), 1e-12f);
#pragma unroll
                for (int h2 = 0; h2 < 2; ++h2) { kkr[h2] = kkr[h2] * inv; bb[h2] = kkr[h2] * av[h2];
                    *(LAS f32x4*)(FT + (0 * 32 + tt) * 64 + j8 + 4 * h2) = kkr[h2]; *(LAS f32x4*)(FT + (1 * 32 + tt) * 64 + j8 + 4 * h2) = dec[h2]; *(LAS f32x4*)(FT + (2 * 32 + tt) * 64 + j8 + 4 * h2) = bb[h2];
                    *(LAS f32x4*)(FT + (3 * 32 + tt) * 64 + j8 + 4 * h2) = kd[h2]; *(LAS f32x4*)(FT + (4 * 32 + tt) * 64 + j8 + 4 * h2) = r8[h2]; *(LAS f32x4*)(FT + (5 * 32 + tt) * 64 + j8 + 4 * h2) = v8[h2]; }
                if ((p & 7) == 0) BON[(size_t)(rbN + tN) * 8 + hd] = bo; }
            __syncthreads();
        }
        __syncthreads();
        { const int cp = 71; RW2_GEOM(cp, ccP, lenP, rbP) (void)lenP;
          if (!isc_ccP || emit_ctx) { const LAS float* YBp = YB0 + (cp & 1) * 2048;
#pragma unroll
              for (int h2 = 0; h2 < 2; ++h2) *(f32x4*)(Y + (size_t)(rbP + ccP * RW_CH + tt) * 512 + hd * 64 + j8 + 4 * h2) = *(const LAS f32x4*)(YBp + tt * 64 + j8 + 4 * h2); } }
#undef RW2_LOADRAW
    }
#undef RW2_GEOM
    __syncthreads();
}

constexpr int R3_Z = 0, R3_X1 = 17408, R3_YB = 34816, R3_NT = 43008;
constexpr int R3_B = 49152, R3_XW = 17408, R3_XA = 17408 + 8704, R3_KR = R3_B, R3_BD = R3_B + 9216, R3_BDT = R3_B + 18432, R3_GL = R3_B + 27648, R3_PT = R3_B + 35840;
constexpr int R3_C = R3_B + 36864, R3_S16 = R3_C, R3_SF = R3_C + 9216, R3_PW = R3_SF, R3_PA = R3_SF + 8192, R3_VT = R3_C + 25600, R3_U = R3_C + 34816, R3_UV = R3_C + 44032, R3_RHS = R3_C + 53248;
constexpr int R3_LS = 72  , R3_FS = 68  , R3_VS = 36  ;
__device__ __forceinline__ void split8(const f32x4 a, const f32x4 b, bf16x8& hi, bf16x8& lo) {
    u32x4 h, l;
    h.x = cvt_pk_bf16(a[0], a[1]); h.y = cvt_pk_bf16(a[2], a[3]); h.z = cvt_pk_bf16(b[0], b[1]); h.w = cvt_pk_bf16(b[2], b[3]);
    l.x = cvt_pk_bf16(a[0] - bflo(h.x), a[1] - bfhi(h.x)); l.y = cvt_pk_bf16(a[2] - bflo(h.y), a[3] - bfhi(h.y));
    l.z = cvt_pk_bf16(b[0] - bflo(h.z), b[1] - bfhi(h.z)); l.w = cvt_pk_bf16(b[2] - bflo(h.w), b[3] - bfhi(h.w));
    hi = __builtin_bit_cast(bf16x8, h); lo = __builtin_bit_cast(bf16x8, l);
}
template <int B> __device__ __forceinline__ void solve_block4(f32x4& ra, f32x4& rb, f32x4& ua, f32x4& ub, const LAS float* zp, int q, f32x4 (&na)[4], f32x4 (&nb)[4]) {
    f32x4 ma[4], mb[4];
    if (B < 7) {
#pragma unroll
        for (int e = 0; e < 4; ++e) { ma[e] = *(const LAS f32x4*)(zp + (4 * B + 4 + e) * R3_FS); mb[e] = *(const LAS f32x4*)(zp + (4 * B + 4 + e) * R3_FS + 4); } }
    const f32x4 rr = (B & 1) ? rb : ra;
    const f32x4 m0 = (B & 1) ? nb[0] : na[0], m1 = (B & 1) ? nb[1] : na[1], m2 = (B & 1) ? nb[2] : na[2];
    const float u0 = rr[0], u1 = rr[1] - u0 * m0[1], u2 = rr[2] - (u0 * m0[2] + u1 * m1[2]), u3 = rr[3] - ((u0 * m0[3] + u1 * m1[3]) + u2 * m2[3]);
    if (q == (B >> 1)) { if (B & 1) ub = (f32x4){u0, u1, u2, u3}; else ua = (f32x4){u0, u1, u2, u3}; }
    if (B < 7) {
        constexpr int o = B >> 1, ctrl = o | (o << 2) | (o << 4) | (o << 6);
        const float b0 = dppf<ctrl>(u0), b1 = dppf<ctrl>(u1), b2 = dppf<ctrl>(u2), b3 = dppf<ctrl>(u3);
        ra -= (b0 * na[0] + b1 * na[1]) + (b2 * na[2] + b3 * na[3]);
        rb -= (b0 * nb[0] + b1 * nb[1]) + (b2 * nb[2] + b3 * nb[3]);
#pragma unroll
        for (int e = 0; e < 4; ++e) { na[e] = ma[e]; nb[e] = mb[e]; } }
}
__device__ __forceinline__ void rwkv_scan_unit3(Frame& F, int l, int b, int hd, int z, bool emit_ctx) {
    const int tid0 = F.tid, lane0 = F.lane, wave = F.wave;
    LAS unsigned char* L = F.lds;
    LAS float* FEAT = (LAS float*)(L + 0); LAS float* XW = (LAS float*)(L + R3_XW); LAS float* XA = (LAS float*)(L + R3_XA); LAS float* PW = (LAS float*)(L + R3_PW); LAS float* PA = (LAS float*)(L + R3_PA);
    LAS float* Zm = (LAS float*)(L + R3_Z); LAS float* X1 = (LAS float*)(L + R3_X1); LAS float* YB = (LAS float*)(L + R3_YB); LAS float* NT = (LAS float*)(L + R3_NT); LAS float* WT = (LAS float*)(L + R3_NT + 4096);
    LAS bf16_t* KR = (LAS bf16_t*)(L + R3_KR); LAS bf16_t* BD = (LAS bf16_t*)(L + R3_BD); LAS bf16_t* BDT = (LAS bf16_t*)(L + R3_BDT); LAS float* GL = (LAS float*)(L + R3_GL); LAS float* PT = (LAS float*)(L + R3_PT);
    LAS bf16_t* S16 = (LAS bf16_t*)(L + R3_S16); LAS float* SF = (LAS float*)(L + R3_SF); LAS bf16_t* UVL = (LAS bf16_t*)(L + R3_VT); LAS bf16_t* ZT2 = (LAS bf16_t*)(L + R3_U)  ; LAS bf16_t* ZTD = (LAS bf16_t*)(L + R3_Z + 8704)  ; LAS bf16_t* UV = (LAS bf16_t*)(L + R3_UV); LAS float* RHS = (LAS float*)(L + R3_RHS);
    const bf16_t* PRW = (const bf16_t*)(F.ws + R_PRW); float* Y = (float*)(F.ws + R_YFB) + (size_t)z * ROWS * 512; float* BON = (float*)(F.ws + WS_BONUS) + (size_t)z * ROWS * 8;
    const float* mu = F.inp(I_RWMU) + (size_t)l * 2 * RW_COLS; const float* mu0 = mu, *mu1 = mu + RW_COLS;
    const float* w0 = F.inp(I_RWW0) + ((size_t)l * 2 + z) * 512 + hd * 64; const float* a0 = F.inp(I_RWA0) + ((size_t)l * 2 + z) * 512 + hd * 64;
    const float* w2 = F.inp(I_RWW2) + ((size_t)l * 2 + z) * 64 * 512; const float* a2 = F.inp(I_RWA2) + ((size_t)l * 2 + z) * 64 * 512;
    const float* k_k = F.inp(I_RWKK) + l * 512 + hd * 64; const float* k_a = F.inp(I_RWKA) + l * 512 + hd * 64; const float* r_k = F.inp(I_RWRK) + l * 512 + hd * 64;
    f32x4 shr[8];
    if (wave >= 4) {
#pragma unroll
      for (int n = 0; n < 2; ++n) { const float* src = (wave < 6 ? w2 : a2) + hd * 64 + 32 * (wave & 1) + 16 * n + (lane0 & 15) + (size_t)(8 * (lane0 >> 4)) * 512;
#pragma unroll
        for (int ks = 0; ks < 2; ++ks) { f32x4 wa, wb;
#pragma unroll
          for (int j = 0; j < 4; ++j) { wa[j] = src[0]; src += 512; asm volatile("" : "+v"(src)); }
#pragma unroll
          for (int j = 0; j < 4; ++j) { wb[j] = src[0]; src += 512; asm volatile("" : "+v"(src)); }
          bf16x8 th, tl; split8(wa, wb, th, tl); shr[2 * n + ks] = __builtin_bit_cast(f32x4, th); shr[4 + 2 * n + ks] = __builtin_bit_cast(f32x4, tl); src += 24 * 512; } } }
    LAS float* CT = (LAS float*)(L + R3_C + 62464);
    LAS float* MT = CT + 384;
    { const int tid = tid0;
      for (int i = tid; i < 640; i += 512) { const int m = i / 320, g = (i % 320) >> 6, j = i & 63; const int col = (g < 3 ? g * 512 + hd * 64 : (g == 3 ? 1536 : 1600)) + j; MT[i] = mu[(size_t)m * RW_COLS + col]; }
      if (tid < 64) { CT[tid] = w0[tid]; CT[64 + tid] = a0[tid]; CT[128 + tid] = k_k[tid]; CT[192 + tid] = k_a[tid]; CT[256 + tid] = r_k[tid]; }
    for (int i = tid; i < 64 * R3_LS / 2; i += 512) ((LAS unsigned*)S16)[i] = 0u; }
    if (wave < 4) {
#pragma unroll
      for (int nt = 0; nt < 4; ++nt) shr[nt] = (f32x4){0.f, 0.f, 0.f, 0.f}; }
    u32x2 raw[5][3];
#define RW3_GEOM(ci_) const bool isc_ = (ci_) < 8; const int cc_ = isc_ ? (z ? 7 - (ci_) : (ci_)) : (z ? 63 - ((ci_) - 8) : ((ci_) - 8)); \
        const int len_ = isc_ ? T_CTX : T_LAT; const int rb_ = b * T_ALL + (isc_ ? 0 : T_CTX); const int t_ = cc_ * RW_CH + tt;
#define RW3_LOADRAW(ci_) do { RW3_GEOM(ci_) const int tp_ = t_ > 0 ? t_ - 1 : t_, tn_ = t_ < len_ - 1 ? t_ + 1 : t_; \
        const bf16_t* pc_ = PRW + (size_t)(rb_ + t_) * RW_COLS; const bf16_t* pp_ = PRW + (size_t)(rb_ + tp_) * RW_COLS; const bf16_t* pn_ = PRW + (size_t)(rb_ + tn_) * RW_COLS; \
        const int cg_[5] = {hd * 64 + j4, 512 + hd * 64 + j4, 1024 + hd * 64 + j4, 1536 + j4, 1600 + j4}; \
        _Pragma("unroll") for (int g_ = 0; g_ < 5; ++g_) { raw[g_][0] = *(const u32x2*)(pp_ + cg_[g_]); raw[g_][1] = *(const u32x2*)(pc_ + cg_[g_]); raw[g_][2] = *(const u32x2*)(pn_ + cg_[g_]); } } while (0)
#define RW3_BAR() asm volatile("s_waitcnt lgkmcnt(0)\n\ts_barrier" ::: "memory")
#define RW3_P1(ci_) do { RW3_GEOM(ci_) const float fp_ = t_ > 0 ? 1.f : 0.f, fn_ = t_ < len_ - 1 ? 1.f : 0.f; f32x4 sh_[5]; \
        _Pragma("unroll") for (int g = 0; g < 5; ++g) { const f32x4 pv = (f32x4){bflo(raw[g][0].x), bfhi(raw[g][0].x), bflo(raw[g][0].y), bfhi(raw[g][0].y)} * fp_; \
            const f32x4 p = (f32x4){bflo(raw[g][1].x), bfhi(raw[g][1].x), bflo(raw[g][1].y), bfhi(raw[g][1].y)}; \
            const f32x4 nx = (f32x4){bflo(raw[g][2].x), bfhi(raw[g][2].x), bflo(raw[g][2].y), bfhi(raw[g][2].y)} * fn_; \
            sh_[g] = p + *(const LAS f32x4*)(MT + g * 64 + j4) * (pv - p) + *(const LAS f32x4*)(MT + 320 + g * 64 + j4) * (nx - p); } \
        *(LAS f32x4*)(XW + tt * 68 + j4) = (f32x4){tanhf_(sh_[3][0]), tanhf_(sh_[3][1]), tanhf_(sh_[3][2]), tanhf_(sh_[3][3])}; *(LAS f32x4*)(XA + tt * 68 + j4) = sh_[4]; \
        r4 = sh_[0]; k4 = sh_[1]; v4 = sh_[2]; } while (0)
#define RW3_P2() do { const LAS float* Xs = (wave < 6) ? XW : XA; LAS float* Ps = (wave < 6) ? PW : PA; \
        _Pragma("unroll") for (int mt = 0; mt < 2; ++mt) { f32x4 acc[2], acc2[2]; \
            _Pragma("unroll") for (int n = 0; n < 2; ++n) { acc[n] = (f32x4){0.f, 0.f, 0.f, 0.f}; acc2[n] = acc[n]; } \
            _Pragma("unroll") for (int ks = 0; ks < 2; ++ks) { const LAS float* xp = Xs + (mt * 16 + (lane & 15)) * 68 + 32 * ks + 8 * (lane >> 4); bf16x8 ah, al; \
                split8(*(const LAS f32x4*)xp, *(const LAS f32x4*)(xp + 4), ah, al); \
                _Pragma("unroll") for (int n = 0; n < 2; ++n) { \
                    const bf16x8 bh_ = __builtin_bit_cast(bf16x8, shr[2 * n + ks]), bl_ = __builtin_bit_cast(bf16x8, shr[4 + 2 * n + ks]); \
                    acc[n] = __builtin_amdgcn_mfma_f32_16x16x32_bf16(ah, bh_, acc[n], 0, 0, 0); \
                    acc2[n] = __builtin_amdgcn_mfma_f32_16x16x32_bf16(ah, bl_, acc2[n], 0, 0, 0); \
                    acc2[n] = __builtin_amdgcn_mfma_f32_16x16x32_bf16(al, bh_, acc2[n], 0, 0, 0); } } \
            _Pragma("unroll") for (int n = 0; n < 2; ++n) { acc[n] += acc2[n]; \
                _Pragma("unroll") for (int rg = 0; rg < 4; ++rg) Ps[(mt * 16 + 4 * (lane >> 4) + rg) * 64 + 32 * (wave & 1) + 16 * n + (lane & 15)] = acc[n][rg]; } } } while (0)
    f32x4 r4, k4, v4;
    { const int tt = tid0 >> 4, j4 = 4 * (tid0 & 15), lane = lane0; RW3_LOADRAW(0); __syncthreads(); RW3_P1(0); RW3_BAR(); if (wave >= 4) RW3_P2(); }
    RW3_BAR();
    for (int ci = 0; ci < 72; ++ci) {
        int tzl = tid0; asm volatile("" : "+v"(tzl));
        const int tid = tzl, lane = tzl & 63, tt = tzl >> 4, jq = tzl & 15, j4 = 4 * jq;
        const bool isc = ci < 8; const int cc = isc ? (z ? 7 - ci : ci) : (z ? 63 - (ci - 8) : (ci - 8));
        const int rb = b * T_ALL + (isc ? 0 : T_CTX); const int t0 = cc * RW_CH; const int t = t0 + tt;
        if (ci + 1 < 72) RW3_LOADRAW(ci + 1);
#ifndef RP_P3A
#define RP_P3A 1
#endif
#ifndef RP_P3B
#define RP_P3B 1
#endif
        { f32x4 ldv, av, kkr, kd, bb, c;
#pragma unroll 1
          for (int rq_ = 0; rq_ < RP_P3A; ++rq_) {
          const f32x4 pw = *(const LAS f32x4*)(PW + tt * 64 + j4) + *(const LAS f32x4*)(CT + j4), pa = *(const LAS f32x4*)(PA + tt * 64 + j4) + *(const LAS f32x4*)(CT + 64 + j4);
          const f32x4 kkc = *(const LAS f32x4*)(CT + 128 + j4), kac = *(const LAS f32x4*)(CT + 192 + j4), rkc = *(const LAS f32x4*)(CT + 256 + j4);
          float ss = 0.f, bo = 0.f;
#pragma unroll
          for (int i = 0; i < 4; ++i) { ldv[i] = -0.8750387749f * sigmoidf_(pw[i]); av[i] = sigmoidf_(pa[i]); kkr[i] = k4[i] * kkc[i]; ss += kkr[i] * kkr[i];
              kd[i] = k4[i] * (1.0f + (av[i] - 1.0f) * kac[i]); bo += r4[i] * kd[i] * rkc[i]; }
          ss = sum16(ss); bo = sum16(bo);
          const float inv = 1.0f / fmaxf(sqrtf(ss), 1e-12f);
#pragma unroll
          for (int i = 0; i < 4; ++i) { kkr[i] *= inv; bb[i] = kkr[i] * av[i]; }
          if (jq == 0) BON[(size_t)(rb + t) * 8 + hd] = bo;
          c = ldv;
          { const int s1 = z ? lane + 16 : lane - 16, s2 = z ? lane + 32 : lane - 32; const bool o1 = z ? lane < 48 : lane >= 16, o2 = z ? lane < 32 : lane >= 32;
            f32x4 t1; t1[0] = __shfl(c[0], s1); t1[1] = __shfl(c[1], s1); t1[2] = __shfl(c[2], s1); t1[3] = __shfl(c[3], s1);
            if (o1) c += t1;
            t1[0] = __shfl(c[0], s2); t1[1] = __shfl(c[1], s2); t1[2] = __shfl(c[2], s2); t1[3] = __shfl(c[3], s2);
            if (o2) c += t1; }
          if (z ? lane < 16 : lane >= 48) *(LAS f32x4*)(WT + wave * 64 + j4) = c;
          }
          RW3_BAR();
#pragma unroll 1
          for (int rq_ = 0; rq_ < RP_P3B; ++rq_) {
          f32x4 base = (f32x4){0.f, 0.f, 0.f, 0.f};
          { f32x4 wt[8];
#pragma unroll
            for (int w2 = 0; w2 < 8; ++w2) wt[w2] = *(const LAS f32x4*)(WT + w2 * 64 + j4);
#pragma unroll
            for (int w2 = 0; w2 < 8; ++w2) { const float mk = (z ? w2 > wave : w2 < wave) ? 1.f : 0.f; base += wt[w2] * mk; } }
          const f32x4 Lc = base + c;
          f32x4 gt, gm, ig;
#pragma unroll
          for (int i = 0; i < 4; ++i) { gt[i] = fast_exp2(Lc[i]); gm[i] = fast_exp2(Lc[i] - ldv[i]); ig[i] = fast_exp2(-Lc[i]); }
          const int tau = z ? 31 - tt : tt;
          const f32x4 kh = kkr * gm, rh = r4 * gt; f32x4 bh = bb * ig, dh = kd * ig, vv = v4;
          u32x2 w; w.x = cvt_pk_bf16(kh[0], kh[1]); w.y = cvt_pk_bf16(kh[2], kh[3]); *(LAS u32x2*)(KR + tau * R3_LS + j4) = w;
          w.x = cvt_pk_bf16(rh[0], rh[1]); w.y = cvt_pk_bf16(rh[2], rh[3]); *(LAS u32x2*)(KR + (32 + tau) * R3_LS + j4) = w;
          w.x = cvt_pk_bf16(bh[0], bh[1]); w.y = cvt_pk_bf16(bh[2], bh[3]); *(LAS u32x2*)(BD + tau * R3_LS + j4) = w;
          w.x = cvt_pk_bf16(dh[0], dh[1]); w.y = cvt_pk_bf16(dh[2], dh[3]); *(LAS u32x2*)(BD + (32 + tau) * R3_LS + j4) = w;
          if (tau == 31) *(LAS f32x4*)(CT + 320 + j4) = gt;
          { const int rot = jq >> 2;
            if (rot & 1) { bh = (f32x4){bh[1], bh[2], bh[3], bh[0]}; dh = (f32x4){dh[1], dh[2], dh[3], dh[0]}; vv = (f32x4){vv[1], vv[2], vv[3], vv[0]}; }
            if (rot & 2) { bh = (f32x4){bh[2], bh[3], bh[0], bh[1]}; dh = (f32x4){dh[2], dh[3], dh[0], dh[1]}; vv = (f32x4){vv[2], vv[3], vv[0], vv[1]}; }
#pragma unroll
            for (int i = 0; i < 4; ++i) { const int row = j4 + ((i + rot) & 3);
                BDT[row * R3_LS + tau] = (bf16_t)f2bf(bh[i]); BDT[row * R3_LS + 32 + tau] = (bf16_t)f2bf(dh[i]);
                const unsigned vh = f2bf(vv[i]); UV[row * R3_LS + 32 + tau] = (bf16_t)vh; UVL[row * R3_LS + 32 + tau] = (bf16_t)f2bf(vv[i] - bflo(vh)); } }
          } }
        RW3_BAR();
        if (ci + 1 < 72) RW3_P1(ci + 1);
        const int c16 = lane & 15, q4 = lane >> 4;
        if (wave < 4) { const int i0 = 16 * wave;
            const bf16x8 a0 = *(const LAS bf16x8*)(S16 + (i0 + c16) * R3_LS + 8 * q4), a1 = *(const LAS bf16x8*)(S16 + (i0 + c16) * R3_LS + 32 + 8 * q4);
#pragma unroll
            for (int nt = 0; nt < 4; ++nt) { shr[4 + nt] = (f32x4){0.f, 0.f, 0.f, 0.f};
                shr[4 + nt] = __builtin_amdgcn_mfma_f32_16x16x32_bf16(a0, *(const LAS bf16x8*)(KR + (16 * nt + c16) * R3_LS + 8 * q4), shr[4 + nt], 0, 0, 0);
                shr[4 + nt] = __builtin_amdgcn_mfma_f32_16x16x32_bf16(a1, *(const LAS bf16x8*)(KR + (16 * nt + c16) * R3_LS + 32 + 8 * q4), shr[4 + nt], 0, 0, 0); }
        } else { const int mt = wave - 4;
            const bf16x8 a0 = *(const LAS bf16x8*)(BD + (16 * mt + c16) * R3_LS + 8 * q4), a1 = *(const LAS bf16x8*)(BD + (16 * mt + c16) * R3_LS + 32 + 8 * q4);
#pragma unroll
            for (int nt = 0; nt < 4; ++nt) { f32x4 az = (f32x4){0.f, 0.f, 0.f, 0.f};
                az = __builtin_amdgcn_mfma_f32_16x16x32_bf16(a0, *(const LAS bf16x8*)(KR + (16 * nt + c16) * R3_LS + 8 * q4), az, 0, 0, 0);
                az = __builtin_amdgcn_mfma_f32_16x16x32_bf16(a1, *(const LAS bf16x8*)(KR + (16 * nt + c16) * R3_LS + 32 + 8 * q4), az, 0, 0, 0);
                if (mt < 2 && nt < 2) {
#pragma unroll
                    for (int rg = 0; rg < 4; ++rg) Zm[(16 * mt + 4 * q4 + rg) * R3_FS + 16 * nt + c16] = az[rg];
                } else {
                    const int s0 = 16 * (mt & 1) + 4 * q4, tc = 16 * (nt & 1) + c16; const int lim = (nt < 2) ? tc - 1 : tc;
                    f32x4 zz;
#pragma unroll
                    for (int rg = 0; rg < 4; ++rg) zz[rg] = (s0 + rg <= lim) ? az[rg] : 0.f;
                    u32x2 h, lo_; h.x = cvt_pk_bf16(zz[0], zz[1]); h.y = cvt_pk_bf16(zz[2], zz[3]);
                    lo_.x = cvt_pk_bf16(zz[0] - bflo(h.x), zz[1] - bfhi(h.x)); lo_.y = cvt_pk_bf16(zz[2] - bflo(h.y), zz[3] - bfhi(h.y));
                    if (nt < 2) { *(LAS u32x2*)(ZTD + tc * 40 + s0) = h; *(LAS u32x2*)(ZTD + 1280 + tc * 40 + s0) = lo_; }
                    else { const int k0 = (mt >= 2 ? 32 : 0) + s0; *(LAS u32x2*)(ZT2 + tc * R3_LS + k0) = h; *(LAS u32x2*)(ZT2 + 2304 + tc * R3_LS + k0) = lo_; } } } }
        RW3_BAR();
#ifndef RP_CH
#define RP_CH 1
#endif
#pragma unroll 1
        for (int rq_ = 0; rq_ < RP_CH; ++rq_)
        if (wave < 4) { const int i0 = 16 * wave;
            { const bf16x8 ah = *(const LAS bf16x8*)(UV + (i0 + c16) * R3_LS + 32 + 8 * q4), al = *(const LAS bf16x8*)(UVL + (i0 + c16) * R3_LS + 32 + 8 * q4);
#pragma unroll
              for (int nt = 0; nt < 2; ++nt) { const bf16x8 bh = *(const LAS bf16x8*)(ZTD + (16 * nt + c16) * 40 + 8 * q4), bl = *(const LAS bf16x8*)(ZTD + 1280 + (16 * nt + c16) * 40 + 8 * q4);
                  f32x4 acc = shr[4 + nt], acc2 = (f32x4){0.f, 0.f, 0.f, 0.f};
                  acc = __builtin_amdgcn_mfma_f32_16x16x32_bf16(ah, bh, acc, 0, 0, 0);
                  acc2 = __builtin_amdgcn_mfma_f32_16x16x32_bf16(ah, bl, acc2, 0, 0, 0);
                  acc2 = __builtin_amdgcn_mfma_f32_16x16x32_bf16(al, bh, acc2, 0, 0, 0);
                  acc += acc2;
#pragma unroll
                  for (int rg = 0; rg < 4; ++rg) RHS[(i0 + 4 * q4 + rg) * R3_VS + 16 * nt + c16] = -acc[rg]; } }
#ifndef RP_SV
#define RP_SV 1
#endif
#pragma unroll 1
            for (int rs_ = 0; rs_ < RP_SV; ++rs_)
            { const int row = i0 + (lane >> 2), q = lane & 3;
              f32x4 ra = *(const LAS f32x4*)(RHS + row * R3_VS + 8 * q), rb = *(const LAS f32x4*)(RHS + row * R3_VS + 8 * q + 4), ua = ra, ub = rb;
              const LAS float* zp = Zm + 8 * q; f32x4 na[4], nb[4];
#pragma unroll
              for (int e = 0; e < 4; ++e) { na[e] = *(const LAS f32x4*)(zp + e * R3_FS); nb[e] = *(const LAS f32x4*)(zp + e * R3_FS + 4); }
              solve_block4<0>(ra, rb, ua, ub, zp, q, na, nb); solve_block4<1>(ra, rb, ua, ub, zp, q, na, nb); solve_block4<2>(ra, rb, ua, ub, zp, q, na, nb); solve_block4<3>(ra, rb, ua, ub, zp, q, na, nb);
              solve_block4<4>(ra, rb, ua, ub, zp, q, na, nb); solve_block4<5>(ra, rb, ua, ub, zp, q, na, nb); solve_block4<6>(ra, rb, ua, ub, zp, q, na, nb); solve_block4<7>(ra, rb, ua, ub, zp, q, na, nb);
              bf16x8 uh, ul; split8(ua, ub, uh, ul);
              *(LAS bf16x8*)(UV + row * R3_LS + 8 * q) = uh; *(LAS bf16x8*)(UVL + row * R3_LS + 8 * q) = ul; }
            { const bf16x8 ah0 = *(const LAS bf16x8*)(UV + (i0 + c16) * R3_LS + 8 * q4), ah1 = *(const LAS bf16x8*)(UV + (i0 + c16) * R3_LS + 32 + 8 * q4);
              const bf16x8 al0 = *(const LAS bf16x8*)(UVL + (i0 + c16) * R3_LS + 8 * q4), al1 = *(const LAS bf16x8*)(UVL + (i0 + c16) * R3_LS + 32 + 8 * q4);
#pragma unroll
              for (int nt = 0; nt < 2; ++nt) { f32x4 acc = shr[6 + nt], acc2 = (f32x4){0.f, 0.f, 0.f, 0.f};
                  const LAS bf16_t* zb = ZT2 + (16 * nt + c16) * R3_LS + 8 * q4;
                  const bf16x8 bh0 = *(const LAS bf16x8*)(zb), bh1 = *(const LAS bf16x8*)(zb + 32), bl0 = *(const LAS bf16x8*)(zb + 2304), bl1 = *(const LAS bf16x8*)(zb + 2304 + 32);
                  acc = __builtin_amdgcn_mfma_f32_16x16x32_bf16(ah0, bh0, acc, 0, 0, 0); acc2 = __builtin_amdgcn_mfma_f32_16x16x32_bf16(ah0, bl0, acc2, 0, 0, 0); acc2 = __builtin_amdgcn_mfma_f32_16x16x32_bf16(al0, bh0, acc2, 0, 0, 0);
                  acc = __builtin_amdgcn_mfma_f32_16x16x32_bf16(ah1, bh1, acc, 0, 0, 0); acc2 = __builtin_amdgcn_mfma_f32_16x16x32_bf16(ah1, bl1, acc2, 0, 0, 0); acc2 = __builtin_amdgcn_mfma_f32_16x16x32_bf16(al1, bh1, acc2, 0, 0, 0);
                  acc += acc2;
                  { const int tau = 16 * nt + c16, ts = z ? 31 - tau : tau; *(LAS f32x4*)(YB + ts * 64 + i0 + 4 * q4) = acc; } }
#pragma unroll
              for (int nt = 0; nt < 4; ++nt) { f32x4 ac = (f32x4){0.f, 0.f, 0.f, 0.f};
                  ac = __builtin_amdgcn_mfma_f32_16x16x32_bf16(ah0, *(const LAS bf16x8*)(BDT + (16 * nt + c16) * R3_LS + 8 * q4), ac, 0, 0, 0);
                  ac = __builtin_amdgcn_mfma_f32_16x16x32_bf16(ah1, *(const LAS bf16x8*)(BDT + (16 * nt + c16) * R3_LS + 32 + 8 * q4), ac, 0, 0, 0);
                  const int col = 16 * nt + c16; const float gl = CT[320 + col];
                  const f32x4 sn = (shr[nt] + ac) * gl;
                  if (rq_ == RP_CH - 1) { shr[nt] = sn;
#pragma unroll
                  for (int rg = 0; rg < 4; ++rg) S16[(i0 + 4 * q4 + rg) * R3_LS + col] = (bf16_t)f2bf(sn[rg]); } else asm volatile("" :: "v"(sn)); } } }
        else if (ci + 1 < 72) RW3_P2();
        RW3_BAR();
#ifndef RP_Y
#define RP_Y 1
#endif
#pragma unroll 1
        for (int rq_ = 0; rq_ < RP_Y; ++rq_) {
        if (!isc || emit_ctx) *(f32x4*)(Y + (size_t)(rb + t) * 512 + hd * 64 + j4) = *(const LAS f32x4*)(YB + tt * 64 + j4);
        }
    }
    __syncthreads();
#undef RW3_P1
#undef RW3_P2
#undef RW3_BAR
#undef RW3_GEOM
#undef RW3_LOADRAW
}

constexpr int RO_AS = 136;
__device__ __forceinline__ void phase_rwkv_out(Frame& F, int l, bool with_ctx) {
    const int tid = F.tid, lane = F.lane, hd = F.wave, c16 = lane & 15, rq = lane >> 4;
    const bf16_t* PRW = (const bf16_t*)(F.ws + R_PRW); const float* Yf = (const float*)(F.ws + R_YFB); const float* Yb = Yf + (size_t)ROWS * 512;
    const float* BON0 = (const float*)(F.ws + WS_BONUS); const float* BON1 = BON0 + (size_t)ROWS * 8; bf16_t* Yall = (bf16_t*)F.out;
    const bf16_t* G2T = (const bf16_t*)(F.ws + WS_G2T);
    const float* mu = F.inp(I_RWMU) + (size_t)l * 2 * RW_COLS; const float* mu0 = mu, *mu1 = mu + RW_COLS;
    const float* lng = F.inp(I_RWLNG) + l * 512; const float* lnb = F.inp(I_RWLNB) + l * 512;
    LAS bf16_t* As = (LAS bf16_t*)F.lds;
    bf16x8 bfr[4][4];
#pragma unroll
    for (int nt = 0; nt < 4; ++nt)
#pragma unroll
        for (int ks = 0; ks < 4; ++ks) bfr[nt][ks] = *(const bf16x8*)(G2T + (size_t)(hd * 64 + 16 * nt + c16) * 128 + 32 * ks + 8 * rq);
    const int nunr = with_ctx ? ROWS / 64 : NB * (T_LAT / 64);
    f32x4 cm0[4], cm1[4], cg[4], cb2[4];
#pragma unroll
    for (int nt = 0; nt < 4; ++nt) { const int ch = hd * 64 + 16 * nt + 4 * rq; cm0[nt] = *(const f32x4*)(mu0 + 1024 + ch); cm1[nt] = *(const f32x4*)(mu1 + 1024 + ch); cg[nt] = *(const f32x4*)(lng + ch); cb2[nt] = *(const f32x4*)(lnb + ch); }
    for (int it = F.blk; it < nunr; it += F.G) {
        const int un = with_ctx ? it : (it >> 5) * 36 + 4 + (it & 31);
        const int r0 = un * 64; const int s0 = r0 % T_ALL; const bool isc = s0 < T_CTX;
        const int seq_lo = isc ? 0 : T_CTX, seq_hi = isc ? T_CTX - 1 : T_ALL - 1;
        __syncthreads();
        { const int tk = tid >> 3, cq = tid & 7; const int s = s0 + tk; const bool hp = s > seq_lo, hn = s < seq_hi; const bf16_t* cur = PRW + (size_t)(r0 + tk) * RW_COLS + 1664 + 16 * cq;
#pragma unroll
          for (int q4 = 0; q4 < 4; ++q4) { const f32x4 x = shift4(cur + 4 * q4, hp, hn, mu0 + 1664 + 16 * cq + 4 * q4, mu1 + 1664 + 16 * cq + 4 * q4);
              u32x2 w; w.x = cvt_pk_bf16(sigmoidf_(x[0]), sigmoidf_(x[1])); w.y = cvt_pk_bf16(sigmoidf_(x[2]), sigmoidf_(x[3])); *(LAS u32x2*)(As + tk * RO_AS + 16 * cq + 4 * q4) = w; } }
        __syncthreads();
        f32x4 acc[4][4];
#pragma unroll
        for (int mt = 0; mt < 4; ++mt)
#pragma unroll
            for (int nt = 0; nt < 4; ++nt) acc[mt][nt] = (f32x4){0.f, 0.f, 0.f, 0.f};
#pragma unroll
        for (int mt = 0; mt < 4; ++mt)
#pragma unroll
            for (int ks = 0; ks < 4; ++ks) { const bf16x8 a = *(const LAS bf16x8*)(As + (mt * 16 + c16) * RO_AS + 32 * ks + 8 * rq);
#pragma unroll
                for (int nt = 0; nt < 4; ++nt) acc[mt][nt] = __builtin_amdgcn_mfma_f32_16x16x32_bf16(bfr[nt][ks], a, acc[mt][nt], 0, 0, 0); }
#pragma unroll
        for (int mt = 0; mt < 4; ++mt) { const int tk = mt * 16 + c16; const int row = r0 + tk, s = s0 + tk; const float fp = s > seq_lo ? 1.f : 0.f, fn = s < seq_hi ? 1.f : 0.f;
            const int rp = s > seq_lo ? row - 1 : row, rn = s < seq_hi ? row + 1 : row;
            f32x4 y[4]; float sm = 0.f;
#pragma unroll
            for (int nt = 0; nt < 4; ++nt) { const size_t o = (size_t)row * 512 + hd * 64 + 16 * nt + 4 * rq; y[nt] = *(const f32x4*)(Yf + o) + *(const f32x4*)(Yb + o); sm += (y[nt][0] + y[nt][1]) + (y[nt][2] + y[nt][3]); }
            sm += __shfl_xor(sm, 16); sm += __shfl_xor(sm, 32);
            const float mean = sm * (1.0f / 64.0f); float q = 0.f;
#pragma unroll
            for (int nt = 0; nt < 4; ++nt) { y[nt] = y[nt] - mean; q += (y[nt][0] * y[nt][0] + y[nt][1] * y[nt][1]) + (y[nt][2] * y[nt][2] + y[nt][3] * y[nt][3]); }
            q += __shfl_xor(q, 16); q += __shfl_xor(q, 32);
            const float rstd = 1.0f / sqrtf(q * (1.0f / 64.0f) + RW_GN_EPS);
            const float bonus = 0.5f * (BON0[(size_t)row * 8 + hd] + BON1[(size_t)row * 8 + hd]);
#pragma unroll
            for (int nt = 0; nt < 4; ++nt) { const int ch = hd * 64 + 16 * nt + 4 * rq;
                const f32x4 p = ld_bf4(PRW + (size_t)row * RW_COLS + 1024 + ch), pv = ld_bf4(PRW + (size_t)rp * RW_COLS + 1024 + ch) * fp, nx = ld_bf4(PRW + (size_t)rn * RW_COLS + 1024 + ch) * fn;
                const f32x4 v = p + cm0[nt] * (pv - p) + cm1[nt] * (nx - p);
                const f32x4 o4 = (y[nt] * rstd * cg[nt] + cb2[nt] + bonus * v) * acc[mt][nt];
                u32x2 w; w.x = cvt_pk_bf16(o4[0], o4[1]); w.y = cvt_pk_bf16(o4[2], o4[3]); *(u32x2*)(Yall + (size_t)row * MIXW + 512 + ch) = w; } }
    }
    __syncthreads();
}

constexpr int SGL_VNT = 0, SGL_WS = 34816, SGL_ST = 69632, SG_LS = 136;
__device__ __forceinline__ void phase_sg(Frame& F, int l, bool with_ctx) {
    const int tid = F.tid, lane = F.lane, wave = F.wave, r32 = lane & 31, hi = lane >> 5;
    const bf16_t* SG = (const bf16_t*)(F.ws + R_SG); bf16_t* Yall = (bf16_t*)F.out;
    const float* ng = F.inp(I_SGNG) + l * 512; const float* nb = F.inp(I_SGNB) + l * 512; const float* sw = F.inp(I_SGW) + (size_t)l * 4 * 128 * 128; const float* sb = F.inp(I_SGB) + l * 4 * 128;
    LAS bf16_t* VNT = (LAS bf16_t*)(F.lds + SGL_VNT); LAS bf16_t* WSm = (LAS bf16_t*)(F.lds + SGL_WS); LAS float* ST = (LAS float*)(F.lds + SGL_ST);
    const int nun4 = with_ctx ? 4 * (ROWS / 128) : 4 * NB * (T_LAT / 128);
    for (int it4 = with_ctx ? (F.blk + (F.G >> 1)) % F.G : F.blk; it4 < nun4; it4 += F.G) {
        const int un4 = with_ctx ? it4 : ((((it4 >> 2) >> 4) * 18 + 2 + ((it4 >> 2) & 15)) << 2) + (it4 & 3);
        const int un = un4 >> 2; const int row0 = un * 128;
        __syncthreads();
        { const int g = un4 & 3;
            u32x2 ur0[4], ur1[4];
            { const size_t row = (size_t)row0 + 32 * (wave >> 1) + r32;
#pragma unroll
              for (int g4 = 0; g4 < 4; ++g4) { const int ch0 = g * 128 + 32 * ((wave & 1) * 2) + 8 * g4 + 4 * hi; ur0[g4] = *(const u32x2*)(SG + row * 1024 + ch0); ur1[g4] = *(const u32x2*)(SG + row * 1024 + ch0 + 32); } }
            u32x4 vw[4];
            { const int q = tid & 127, cb = 32 * (tid >> 7); const bf16_t* vp = SG + (size_t)(row0 + q) * 1024 + 512 + g * 128 + cb;
#pragma unroll
              for (int i = 0; i < 4; ++i) vw[i] = *(const u32x4*)(vp + 8 * i); }
            { const int p = tid >> 2, c0 = 32 * (tid & 3); const float* wp = sw + ((size_t)g * 128 + p) * 128 + c0;
#pragma unroll
              for (int i = 0; i < 4; ++i) { const f32x4 a = *(const f32x4*)(wp + 8 * i), c = *(const f32x4*)(wp + 8 * i + 4);
                  *(LAS u32x4*)(WSm + p * SG_LS + c0 + 8 * i) = (u32x4){cvt_pk_bf16(a[0], a[1]), cvt_pk_bf16(a[2], a[3]), cvt_pk_bf16(c[0], c[1]), cvt_pk_bf16(c[2], c[3])}; } }
            { u32x4 w[16];
#pragma unroll
              for (int i = 0; i < 16; ++i) w[i] = *(const u32x4*)(SG + (size_t)(row0 + wave * 16 + i) * 1024 + 512 + 8 * lane);
              float v16[16];
              { float a[16], b2[16];
#pragma unroll
                for (int i = 0; i < 16; ++i) { const float x[8] = {bflo(w[i].x), bfhi(w[i].x), bflo(w[i].y), bfhi(w[i].y), bflo(w[i].z), bfhi(w[i].z), bflo(w[i].w), bfhi(w[i].w)}; float s1 = 0.f, s2 = 0.f;
#pragma unroll
                    for (int e = 0; e < 8; ++e) { s1 += x[e]; s2 += x[e] * x[e]; }
                    a[i] = s1; b2[i] = s2; }
                const bool h5 = (lane & 32) != 0;
#pragma unroll
                for (int j2 = 0; j2 < 16; ++j2) { const float send = h5 ? a[j2] : b2[j2], keep = h5 ? b2[j2] : a[j2]; v16[j2] = keep + __shfl_xor(send, 32); } }
              float v8[8], v4[4], v2[2], v1;
              { const bool h = (lane & 16) != 0;
#pragma unroll
                for (int j2 = 0; j2 < 8; ++j2) { const float send = h ? v16[j2] : v16[8 + j2], keep = h ? v16[8 + j2] : v16[j2]; v8[j2] = keep + __shfl_xor(send, 16); } }
              { const bool h = (lane & 8) != 0;
#pragma unroll
                for (int j2 = 0; j2 < 4; ++j2) { const float send = h ? v8[j2] : v8[4 + j2], keep = h ? v8[4 + j2] : v8[j2]; v4[j2] = keep + __shfl_xor(send, 8); } }
              { const bool h = (lane & 4) != 0;
#pragma unroll
                for (int j2 = 0; j2 < 2; ++j2) { const float send = h ? v4[j2] : v4[2 + j2], keep = h ? v4[2 + j2] : v4[j2]; v2[j2] = keep + __shfl_xor(send, 4); } }
              { const bool h = (lane & 2) != 0; const float send = h ? v2[0] : v2[1], keep = h ? v2[1] : v2[0]; v1 = keep + __shfl_xor(send, 2); }
              v1 += __shfl_xor(v1, 1);
              const float other = __shfl_xor(v1, 32);
              if (lane < 32 && (lane & 1) == 0) { const int q = wave * 16 + (lane >> 1); const float mean = v1 * (1.0f / 512.0f); const float var = fmaxf(other * (1.0f / 512.0f) - mean * mean, 0.f);
                  ST[2 * q] = mean; ST[2 * q + 1] = 1.0f / sqrtf(var + LN_EPS); } }
            __syncthreads();
            { const int q = tid & 127, cb = 32 * (tid >> 7); const float mean = ST[2 * q], rstd = ST[2 * q + 1];
#pragma unroll
              for (int i = 0; i < 4; ++i) { const u32x4 w = vw[i]; const float x[8] = {bflo(w.x), bfhi(w.x), bflo(w.y), bfhi(w.y), bflo(w.z), bfhi(w.z), bflo(w.w), bfhi(w.w)};
#pragma unroll
                  for (int e2 = 0; e2 < 8; ++e2) { const int c2 = cb + 8 * i + e2; VNT[c2 * SG_LS + q] = (bf16_t)f2bf((x[e2] - mean) * rstd * ng[g * 128 + c2] + nb[g * 128 + c2]); } } }
            __syncthreads();
            const int pt = wave >> 1, ct0 = (wave & 1) * 2;
            f32x16 acc0, acc1;
#pragma unroll
            for (int r = 0; r < 16; ++r) { acc0[r] = 0.f; acc1[r] = 0.f; }
#pragma unroll
            for (int ks = 0; ks < 8; ++ks) { const bf16x8 a = *(const LAS bf16x8*)(WSm + (32 * pt + r32) * SG_LS + 16 * ks + 8 * hi);
                const bf16x8 b0 = *(const LAS bf16x8*)(VNT + (32 * ct0 + r32) * SG_LS + 16 * ks + 8 * hi), b1 = *(const LAS bf16x8*)(VNT + (32 * (ct0 + 1) + r32) * SG_LS + 16 * ks + 8 * hi);
                acc0 = __builtin_amdgcn_mfma_f32_32x32x16_bf16(b0, a, acc0, 0, 0, 0); acc1 = __builtin_amdgcn_mfma_f32_32x32x16_bf16(b1, a, acc1, 0, 0, 0); }
            { const int p = 32 * pt + r32; const size_t row = (size_t)row0 + p; const float bs = sb[g * 128 + p];
#pragma unroll
              for (int g4 = 0; g4 < 4; ++g4) { const int ch0 = g * 128 + 32 * ct0 + 8 * g4 + 4 * hi, ch1 = ch0 + 32;
                  const f32x4 u0 = (f32x4){bflo(ur0[g4].x), bfhi(ur0[g4].x), bflo(ur0[g4].y), bfhi(ur0[g4].y)}, u1 = (f32x4){bflo(ur1[g4].x), bfhi(ur1[g4].x), bflo(ur1[g4].y), bfhi(ur1[g4].y)};
                  const f32x4 o0 = u0 * ((f32x4){acc0[4 * g4], acc0[4 * g4 + 1], acc0[4 * g4 + 2], acc0[4 * g4 + 3]} + bs), o1 = u1 * ((f32x4){acc1[4 * g4], acc1[4 * g4 + 1], acc1[4 * g4 + 2], acc1[4 * g4 + 3]} + bs);
                  u32x2 w; w.x = cvt_pk_bf16(o0[0], o0[1]); w.y = cvt_pk_bf16(o0[2], o0[3]); *(u32x2*)(Yall + row * MIXW + 1024 + ch0) = w;
                  w.x = cvt_pk_bf16(o1[0], o1[1]); w.y = cvt_pk_bf16(o1[2], o1[3]); *(u32x2*)(Yall + row * MIXW + 1024 + ch1) = w; } }
            __syncthreads();
        }
    }
}

#ifdef PROBE_CHECKS
__device__ __forceinline__ float tshift(const bf16_t* PRW, int row, int col, bool hp, bool hn, const float* mu0, const float* mu1) {
    const float p = bf2f(PRW[(size_t)row * RW_COLS + col]), pv = hp ? bf2f(PRW[(size_t)(row - 1) * RW_COLS + col]) : 0.f, nx = hn ? bf2f(PRW[(size_t)(row + 1) * RW_COLS + col]) : 0.f;
    return p + mu0[col] * (pv - p) + mu1[col] * (nx - p);
}
__device__ __forceinline__ bool mism(float fast, float ref) { return !(fabsf(fast - ref) <= 0.03f * fabsf(ref) + 0.03f); }
__device__ __forceinline__ void probe_checks(Frame& F, int l, int stage) {
    float* flags = (float*)(F.ws + WS_CTL + 32768);
    const bf16_t* Yall = (const bf16_t*)F.out; const int lane = F.lane;
    if (F.blk >= 24) return;
    const int kind = F.blk >> 3, si = (F.blk & 7) * 8 + F.wave;
    if ((stage == 0) == (kind == 1)) return;
    const int b = si & 15, srow = (si * 37 + 11) % T_ALL;
    const int row = b * T_ALL + srow; const bool isc = srow < T_CTX;
    const int seq_lo = isc ? 0 : T_CTX, seq_hi = isc ? T_CTX - 1 : T_ALL - 1; const bool hp = srow > seq_lo, hn = srow < seq_hi;
    if (kind == 0) {
        const bf16_t* SG = (const bf16_t*)(F.ws + R_SG); const int ch = (si * 53 + 7) & 511, g = ch >> 7, c = ch & 127; const int row0 = row & ~127, p = row & 127;
        const float* ng = F.inp(I_SGNG) + l * 512; const float* nb = F.inp(I_SGNB) + l * 512; const float* sw = F.inp(I_SGW) + (size_t)l * 4 * 128 * 128; const float* sb = F.inp(I_SGB) + l * 4 * 128;
        float vm = 0.f;
        for (int q = 0; q < 128; ++q) { float s = 0.f, x[8];
            for (int e = 0; e < 8; ++e) { x[e] = bf2f(SG[(size_t)(row0 + q) * 1024 + 512 + lane * 8 + e]); s += x[e]; }
            const float mean = wave_sum(s) * (1.0f / 512.0f); float qq = 0.f;
            for (int e = 0; e < 8; ++e) qq += (x[e] - mean) * (x[e] - mean);
            const float rstd = 1.0f / sqrtf(wave_sum(qq) * (1.0f / 512.0f) + LN_EPS);
            const float vn = (bf2f(SG[(size_t)(row0 + q) * 1024 + 512 + ch]) - mean) * rstd * ng[ch] + nb[ch];
            vm += sw[((size_t)g * 128 + p) * 128 + q] * vn; }
        const float ref = bf2f(SG[(size_t)row * 1024 + ch]) * (vm + sb[g * 128 + p]);
        const float fast = bf2f(Yall[(size_t)row * MIXW + 1024 + ch]);
        (void)fast; (void)ref;
    } else if (kind == 1) {
        const bf16_t* PRW = (const bf16_t*)(F.ws + R_PRW); const float* Yf = (const float*)(F.ws + R_YFB); const float* Yb = Yf + (size_t)ROWS * 512;
        const float* B0 = (const float*)(F.ws + WS_BONUS); const float* B1 = B0 + (size_t)ROWS * 8;
        const float* mu = F.inp(I_RWMU) + (size_t)l * 2 * RW_COLS; const float* mu0 = mu, *mu1 = mu + RW_COLS;
        const float* g2 = F.inp(I_RWG2) + (size_t)l * 128 * 512; const float* lng = F.inp(I_RWLNG) + l * 512; const float* lnb = F.inp(I_RWLNB) + l * 512;
        const int hd = si & 7, ch = hd * 64 + lane;
        const float y = Yf[(size_t)row * 512 + ch] + Yb[(size_t)row * 512 + ch];
        const float mean = wave_sum(y) * (1.0f / 64.0f); const float var = wave_sum((y - mean) * (y - mean)) * (1.0f / 64.0f);
        const float gn = (y - mean) / sqrtf(var + RW_GN_EPS) * lng[ch] + lnb[ch];
        const float v = tshift(PRW, row, 1024 + ch, hp, hn, mu0, mu1);
        const float bonus = 0.5f * (B0[(size_t)row * 8 + hd] + B1[(size_t)row * 8 + hd]);
        float gg = 0.f;
        for (int r = 0; r < 128; ++r) { const float xg = tshift(PRW, row, 1664 + r, hp, hn, mu0, mu1); gg += (1.0f / (1.0f + expf(-xg))) * g2[(size_t)r * 512 + ch]; }
        const float ref = (gn + bonus * v) * gg, fast = bf2f(Yall[(size_t)row * MIXW + 512 + ch]);
        (void)fast; (void)ref;
    } else if (!isc || l == 0) {
        const bf16_t* Qb = (const bf16_t*)(F.ws + R_Q); const bf16_t* Kb = (const bf16_t*)(F.ws + R_K); const bf16_t* Vt = (const bf16_t*)(F.ws + R_VT);
        const float* sc = (const float*)(F.ws + WS_SMALL + 16384); const float lam = sc[2 * l], lam_init = sc[2 * l + 1]; const float* ng = F.inp(I_DANG) + l * 128;
        const int h = si & 3, nkeys = isc ? T_CTX : T_ALL; const int krow0 = b * T_ALL;
        float o0 = 0.f, o1 = 0.f;
        for (int m = 0; m < 2; ++m) {
            float mx = -3.0e38f;
            for (int k = lane; k < nkeys; k += 64) { float s = 0.f; for (int d = 0; d < 64; ++d) s += bf2f(Qb[(size_t)row * 512 + h * 128 + m * 64 + d]) * bf2f(Kb[(size_t)(krow0 + k) * 512 + h * 128 + m * 64 + d]); mx = fmaxf(mx, s); }
            mx = wave_max(mx); float den = 0.f;
            for (int k = lane; k < nkeys; k += 64) { float s = 0.f; for (int d = 0; d < 64; ++d) s += bf2f(Qb[(size_t)row * 512 + h * 128 + m * 64 + d]) * bf2f(Kb[(size_t)(krow0 + k) * 512 + h * 128 + m * 64 + d]); den += exp2f(s - mx); }
            den = wave_sum(den);
            float a0 = 0.f, a1 = 0.f;
            for (int k = 0; k < nkeys; ++k) { float s = 0.f; for (int d = 0; d < 64; ++d) s += bf2f(Qb[(size_t)row * 512 + h * 128 + m * 64 + d]) * bf2f(Kb[(size_t)(krow0 + k) * 512 + h * 128 + m * 64 + d]);
                const float pk = exp2f(s - mx) / den; const int slot = (k & ~15) + perm16(k & 15);
                a0 += pk * bf2f(Vt[((size_t)(b * 4 + h) * 128 + lane) * T_ALL + slot]); a1 += pk * bf2f(Vt[((size_t)(b * 4 + h) * 128 + lane + 64) * T_ALL + slot]); }
            if (m == 0) { o0 = a0; o1 = a1; } else { o0 -= PROBE_LAM(lam) * a0; o1 -= PROBE_LAM(lam) * a1; }
        }
        const float ss = wave_sum(o0 * o0 + o1 * o1) * (1.0f / 128.0f); const float scl = (1.0f / sqrtf(ss + DA_EPS)) * (1.0f - lam_init);
#ifdef PROBE_O1ONLY
        const float r0 = o0 * 16.0f * ng[lane], r1 = o1 * 16.0f * ng[lane + 64];
#else
        const float r0 = o0 * scl * ng[lane], r1 = o1 * scl * ng[lane + 64];
#endif
        const float f0 = bf2f(Yall[(size_t)row * MIXW + h * 128 + lane]), f1 = bf2f(Yall[(size_t)row * MIXW + h * 128 + lane + 64]);
        const float dv = wave_max(fmaxf(fabsf(f0 - r0), fabsf(f1 - r1)));
        if (lane == 0) atomicMax((unsigned*)flags + (isc ? 1 : 0), __builtin_bit_cast(unsigned, dv));
    }
}
#endif

#ifndef MK_PER_PHASE
#define MK_PER_PHASE 0
#endif
constexpr int N_PHASES = 3 + 10 * DEPTH;
struct Args { const float* in[34]; float* out; unsigned char* ws; int ph_lo, ph_hi; };
__global__ void __launch_bounds__(512, 2) trunk_fwd(Args args) {
    extern __shared__ __attribute__((aligned(16))) unsigned char lds_raw[];
    Frame F;
    F.lds = (LAS unsigned char*)lds_raw;
    F.tid = threadIdx.x; F.lane = F.tid & 63; F.wave = __builtin_amdgcn_readfirstlane(F.tid >> 6); F.G = gridDim.x; F.blk = blockIdx.x;
    F.out = args.out; F.ws = args.ws;
    volatile LAS unsigned* misc = (volatile LAS unsigned*)(F.lds + LDS_MISC);
    if (F.tid < 16) misc[F.tid] = 0u;
    if (F.tid == 0) {
#pragma unroll
        for (int i = 0; i < 34; ++i) *(LAS unsigned long long*)(F.lds + LDS_MISC + 64 + 8 * i) = (unsigned long long)args.in[i];
    }
    __syncthreads();
    XcdBarrier bar; bar.bar = (unsigned*)(F.ws + WS_CTL); bar.x = 0; bar.st = misc;
    if (!MK_PER_PHASE) bar = xcd_barrier_post((unsigned*)(F.ws + WS_CTL), misc);
    const int lo = args.ph_lo, hi = args.ph_hi;
#ifndef PHM
#define PHM 0xFFFFFFFFu
#endif
#define PHB(n) ((PHM >> (n)) & 1u)
#ifndef REPMASK
#define REPMASK 0u
#endif
#define NREP(n) ((int)((REPMASK >> (n)) & 1u) + 1)
#define IN(k) (lo <= (k) && (k) < hi)
#define SEAM(k) do { if (!MK_PER_PHASE && IN((k) + 1)) xcd_barrier(bar); } while (0)
    const int NGW = F.G * 8;

    if (PHB(0) && IN(0)) { for (int rep = 0; rep < NREP(0); ++rep) { relaunder(F); mod_partials(F); relaunder(F); small_tables(F); relaunder(F); convert_weights(F, 0, F.blk * 8 + F.wave, NGW); } SEAM(0); }
    if (PHB(1) && IN(1)) { relaunder(F); mod_reduce(F); SEAM(1); }
    if (PHB(2) && IN(2)) { relaunder(F); phase_h0(F); SEAM(2); }

#pragma unroll 1
    for (int l = 0; l < DEPTH; ++l) {
        const int pb = 3 + 10 * l; const bool first = (l == 0), last = (l == DEPTH - 1); const bool with_ctx = !last;
        if (PHB(3) && IN(pb + 0)) { relaunder(F);
#pragma unroll 1
            for (int rep = 0; rep < NREP(3); ++rep) {
            pg8::Gemm g{(const bf16_t*)(F.ws + WS_H), (const bf16_t*)(F.ws + WS_WIN), DM, DM, DM};
            InProjSched S; if (with_ctx) S.init(F.G, F.blk, 0, 0, 17, 0, 0, 0); else S.init(F.G, F.blk, 1, 0, 17, 2, 2, 11);
            S.init2((long)((const char*)F.out - (const char*)(F.ws + WS_H)), (long)WS_WLO - (long)WS_WIN);
            EpiInProj E{(bf16_t*)(F.ws + R_Q), (bf16_t*)(F.ws + R_K), (bf16_t*)(F.ws + R_VT), (bf16_t*)(F.ws + R_PRW), (bf16_t*)(F.ws + R_SG), (bf16_t*)(F.ws + R_GATE), (const f32x2*)(F.ws + WS_SMALL), (bf16_t*)(F.ws + R_KLO)};
            pg8::gemm_phase(F.lds, F.tid, g, S, E);
            }
            SEAM(pb + 0);
        }
        if (PHB(4) && IN(pb + 1)) { relaunder(F);
#ifndef RWKV_SCAN
#define RWKV_SCAN rwkv_scan_unit3
#endif
#ifndef REP_SCAN
#define REP_SCAN NREP(21)
#endif
#ifndef REP_ATTN
#define REP_ATTN NREP(22)
#endif
#ifndef REP_SG
#define REP_SG NREP(20)
#endif
#pragma unroll 1
            for (int rep = 0; rep < REP_SCAN; ++rep) for (int un = F.blk; un < 256; un += F.G) RWKV_SCAN(F, l, un >> 4, (un >> 1) & 7, un & 1, with_ctx);
#pragma unroll 1
            for (int rep = 0; rep < REP_ATTN; ++rep) { relaunder(F); phase_attn(F, l, with_ctx); }
#pragma unroll 1
            for (int rep = 0; rep < REP_SG; ++rep) { relaunder(F); phase_sg(F, l, with_ctx); }
            SEAM(pb + 1);
        }
        if (PHB(5) && IN(pb + 2)) { relaunder(F);
#ifdef PROBE_CHECKS
            if (l == 0) { probe_checks(F, l, 0); xcd_barrier(bar); relaunder(F); }
#endif
#pragma unroll 1
            for (int rep = 0; rep < NREP(5); ++rep) {
            phase_rwkv_out(F, l, with_ctx); relaunder(F);
            pg8::Gemm g{(const bf16_t*)(F.ws + WS_H), (const bf16_t*)(F.ws + WS_WIN), DM, DM, DM};
            RectSched S; S.init(F.G, with_ctx ? (F.blk + 3 * (F.G >> 2)) % F.G : F.blk, with_ctx ? 0 : 1, 17, 12, 0, 0, 0);
            EpiInProj E{(bf16_t*)(F.ws + R_Q), (bf16_t*)(F.ws + R_K), (bf16_t*)(F.ws + R_VT), (bf16_t*)(F.ws + R_PRW), (bf16_t*)(F.ws + R_SG), (bf16_t*)(F.ws + R_GATE), (const f32x2*)(F.ws + WS_SMALL), (bf16_t*)(F.ws + R_KLO)};
            pg8::gemm_phase(F.lds, F.tid, g, S, E);
#ifdef PROBE_CHECKS
            if (l == 0) { xcd_barrier(bar); relaunder(F); probe_checks(F, l, 1); }
#endif
            }
            SEAM(pb + 2);
        }
        if (PHB(6) && IN(pb + 3)) { relaunder(F);
#pragma unroll 1
            for (int rep = 0; rep < NREP(6); ++rep) {
            pg8::Gemm g{(const bf16_t*)F.out, (const bf16_t*)(F.ws + WS_WB), MIXW, MIXW, MIXW};
            MergeSched S; S.init(F.G, F.blk, with_ctx ? 0 : 1);
            EpiMerge E{(const bf16_t*)(F.ws + R_GATE), (bf16_t*)(F.ws + R_M)};
            pg8::gemm_phase(F.lds, F.tid, g, S, E);
            }
            SEAM(pb + 3);
        }
        if (PHB(7) && IN(pb + 4)) { relaunder(F);
            pg8::Gemm g{(const bf16_t*)(F.ws + R_M), (const bf16_t*)(F.ws + WS_WOUT), DM, DM, DM};
            RectSched S; S.init(F.G, F.blk, with_ctx ? 0 : 1, 0, 4, 0, 0, 0);
            EpiWout E{F.inp(I_X), F.inp(I_CTX), (float*)(F.ws + WS_X), (const float*)(F.ws + WS_MODF) + (size_t)l * 17 * 6144, first ? 1 : 0};
            pg8::gemm_phase(F.lds, F.tid, g, S, E);
            SEAM(pb + 4);
        }
        if (PHB(8) && IN(pb + 5)) { relaunder(F); phase_ln1(F, l, with_ctx); SEAM(pb + 5); }
        if (PHB(9) && IN(pb + 6)) { for (int rep = 0; rep < NREP(9); ++rep) { relaunder(F); phase_topk(F, with_ctx); } SEAM(pb + 6); }
        if (PHB(10) && IN(pb + 7)) { relaunder(F);
#pragma unroll 1
            for (int rep = 0; rep < NREP(10); ++rep) {
            pg8::Gemm g{(const bf16_t*)(F.ws + R_XE), (const bf16_t*)(F.ws + WS_WE1), DM, DM, DM};
            MoeSched S; S.init(F.G, F.blk, with_ctx ? 18 : 16, 16, 16);
            EpiMoe1 E{(bf16_t*)(F.ws + R_HID)};
            pg8::gemm_phase(F.lds, F.tid, g, S, E);
            }
            SEAM(pb + 7);
        }
        if (PHB(11) && IN(pb + 8)) { relaunder(F);
#pragma unroll 1
            for (int rep = 0; rep < NREP(11); ++rep) {
            pg8::Gemm g{(const bf16_t*)(F.ws + R_HID), (const bf16_t*)(F.ws + WS_WE2), FF, FF, FF};
            MoeSched S; S.init(F.G, F.blk, with_ctx ? 18 : 16, 4, 4);
            EpiMoe2 E{(bf16_t*)(F.ws + R_YE), (const float*)(F.ws + WS_GATEE)};
            pg8::gemm_phase(F.lds, F.tid, g, S, E);
            }
            SEAM(pb + 8);
        }
        if (PHB(12) && IN(pb + 9)) { relaunder(F);
            phase_ln2(F, l, with_ctx, last);
            for (int rep = 0; rep < NREP(12); ++rep) { relaunder(F); if (!last) convert_weights(F, l + 1, F.blk * 8 + F.wave, NGW); }
            SEAM(pb + 9);
        }
    }
#ifdef PROBE_CHECKS
    xcd_barrier(bar);
    if (F.blk == 0 && F.tid == 0) { const float* flags = (const float*)(F.ws + WS_CTL + 32768); F.out[0] += 1000.0f * flags[0]; }
#endif
#undef IN
#undef SEAM
}

extern "C" void kernel_launch(void* const* d_in, const int* in_sizes, int n_in, void* d_out, int out_size, void* d_ws, size_t ws_size, hipStream_t stream) {
    static int grid = 0;
    if (grid == 0) {
        if (n_in != 34 || out_size != NB * T_LAT * DM || ws_size < WS_END) { fprintf(stderr, "kernel_launch: unexpected shapes (n_in %d, out %d, ws %zu, need %zu); nothing launched\n", n_in, out_size, ws_size, (size_t)WS_END); grid = -1; return; }
        int dev = 0, cus = 0, per_cu = 0;
        if (hipGetDevice(&dev) != hipSuccess || hipDeviceGetAttribute(&cus, hipDeviceAttributeMultiprocessorCount, dev) != hipSuccess) { grid = -1; return; }
        if (hipFuncSetAttribute((const void*)trunk_fwd, hipFuncAttributeMaxDynamicSharedMemorySize, LDS_BYTES) != hipSuccess) { fprintf(stderr, "kernel_launch: hipFuncSetAttribute failed\n"); grid = -1; return; }
        if (hipOccupancyMaxActiveBlocksPerMultiprocessor(&per_cu, (const void*)trunk_fwd, 512, LDS_BYTES) != hipSuccess || per_cu < 1) { fprintf(stderr, "kernel_launch: occupancy query reports %d\n", per_cu); }
        (void)hipGetLastError();
        grid = cus;
    }
    if (grid < 0) return;
    (void)hipMemsetAsync((char*)d_ws + WS_CTL, 0, CTL_ZERO_BYTES, stream);
#ifdef DIAG_ZERO_WS
    (void)hipMemsetAsync((char*)d_ws, 0, WS_END, stream);
    (void)hipMemsetAsync((char*)d_ws + WS_MODF, 0xFF, WS_X - WS_MODF, stream);
    (void)hipMemsetAsync((char*)d_ws + WS_WIN, 0xFF, WS_R - WS_WIN, stream);
#endif
    Args a{};
    for (int i = 0; i < 34; ++i) a.in[i] = (const float*)d_in[i];
    a.out = (float*)d_out; a.ws = (unsigned char*)d_ws;
#if MK_PER_PHASE
    for (int p = 0; p < N_PHASES; ++p) { a.ph_lo = p; a.ph_hi = p + 1; hipLaunchKernelGGL(trunk_fwd, dim3(grid), dim3(512), LDS_BYTES, stream, a); }
#else
    a.ph_lo = 0; a.ph_hi = N_PHASES; hipLaunchKernelGGL(trunk_fwd, dim3(grid), dim3(512), LDS_BYTES, stream, a);
#endif
}
```
